# Optimizing an MI355X kernel written in HIP

```python
import math
import jax, jax.numpy as jnp
from jax import lax
import numpy as np

D_MODEL = 1024
BATCH = 16
SEQ = 4096
DEPTH = 1

MEM_LEN = 256
EPS = 1e-6
GM_WIDTH = D_MODEL
GM_CHUNK = 128
GM_GROUP_CH = 128
GM_GROUPS = GM_WIDTH // GM_GROUP_CH
S5_WIDTH = D_MODEL // 2
S5_GROUP_CH = 16
S5_GROUPS = S5_WIDTH // S5_GROUP_CH
S5_STATE = 64
CA_HEADS = 4
CA_HEAD_DIM = D_MODEL // CA_HEADS
FFN_HIDDEN = ((8 * D_MODEL + 3 * 256 - 1) // (3 * 256)) * 256
IN_COLS = 2 * GM_WIDTH + S5_WIDTH + 2 * D_MODEL
SPLIT_POINTS = (2 * GM_WIDTH, 2 * GM_WIDTH + S5_WIDTH, 2 * GM_WIDTH + S5_WIDTH + D_MODEL)

kernel_name = 'hybrid_gmlp_s5_memxattn_block'


def rms_norm(x, g):
    xf = x.astype(jnp.float32)
    y = xf * lax.rsqrt(jnp.mean(xf * xf, axis=-1, keepdims=True) + EPS)
    return (y * g.astype(jnp.float32)).astype(x.dtype)


def layer_norm(x, g, b):
    xf = x.astype(jnp.float32)
    mu = jnp.mean(xf, axis=-1, keepdims=True)
    xc = xf - mu
    y = xc * lax.rsqrt(jnp.mean(xc * xc, axis=-1, keepdims=True) + EPS)
    return (y * g.astype(jnp.float32) + b.astype(jnp.float32)).astype(x.dtype)


def gmlp_branch(z, ln_g, ln_b, w_s, b_s):
    bsz, seq, _ = z.shape
    z = jax.nn.gelu(z)
    u, v = jnp.split(z, 2, axis=-1)
    v = layer_norm(v, ln_g, ln_b)
    v = v.reshape(bsz, seq // GM_CHUNK, GM_CHUNK, GM_GROUPS, GM_GROUP_CH)
    mask = jnp.tril(jnp.ones((GM_CHUNK, GM_CHUNK), dtype=bool))
    w = jnp.where(mask[None], w_s, jnp.zeros((), w_s.dtype))
    sv = jnp.einsum('gts,bnsgc->bntgc', w, v) + b_s.T[:, :, None]
    return u * sv.reshape(bsz, seq, GM_WIDTH)


def _ssm_combine(e1, e2):
    a1r, a1i, b1r, b1i = e1
    a2r, a2i, b2r, b2i = e2
    ar = a2r * a1r - a2i * a1i
    ai = a2r * a1i + a2i * a1r
    br = a2r * b1r - a2i * b1i + b2r
    bi = a2r * b1i + a2i * b1r + b2i
    return (ar, ai, br, bi)


def s5_branch(u, lam_re, lam_im, log_step, b_re, b_im, c_re, c_im, d, w_glu):
    f32 = jnp.float32
    dt = u.dtype
    bsz, seq, _ = u.shape
    uf = u.astype(f32).reshape(bsz, seq, S5_GROUPS, S5_GROUP_CH)
    lr = lam_re.astype(f32)
    li = lam_im.astype(f32)
    step = jnp.exp(log_step.astype(f32))[:, None]
    mag = jnp.exp(lr * step)
    ab_re = mag * jnp.cos(li * step)
    ab_im = mag * jnp.sin(li * step)
    den = lr * lr + li * li
    nr = ab_re - 1.0
    co_re = (nr * lr + ab_im * li) / den
    co_im = (ab_im * lr - nr * li) / den
    br_ = b_re.astype(f32)
    bi_ = b_im.astype(f32)
    bb_re = co_re[..., None] * br_ - co_im[..., None] * bi_
    bb_im = co_re[..., None] * bi_ + co_im[..., None] * br_
    bu_re = jnp.einsum('bsgh,gph->bsgp', uf, bb_re)
    bu_im = jnp.einsum('bsgh,gph->bsgp', uf, bb_im)
    a_re = jnp.broadcast_to(ab_re, (seq, S5_GROUPS, S5_STATE))
    a_im = jnp.broadcast_to(ab_im, (seq, S5_GROUPS, S5_STATE))

    def scan_one(br, bi):
        _, _, sr, si = lax.associative_scan(_ssm_combine, (a_re, a_im, br, bi), axis=0)
        return sr, si

    s_re, s_im = jax.vmap(scan_one)(bu_re, bu_im)
    y = (jnp.einsum('bsgp,ghp->bsgh', s_re, c_re.astype(f32))
         - jnp.einsum('bsgp,ghp->bsgh', s_im, c_im.astype(f32))
         + d.astype(f32) * uf)
    y = jax.nn.gelu(y.reshape(bsz, seq, S5_WIDTH))
    y = y * jax.nn.sigmoid(y @ w_glu.astype(f32))
    return y.astype(dt)


def cross_attention(h, mem_n, w_q, w_kv, w_o):
    bsz, seq, _ = h.shape
    q = (h @ w_q).reshape(bsz, seq, CA_HEADS, CA_HEAD_DIM)
    k, v = jnp.split(mem_n @ w_kv, 2, axis=-1)
    k = k.reshape(bsz, -1, CA_HEADS, CA_HEAD_DIM)
    v = v.reshape(bsz, -1, CA_HEADS, CA_HEAD_DIM)
    s = jnp.einsum('bshd,bmhd->bhsm', q, k).astype(jnp.float32) * (CA_HEAD_DIM ** -0.5)
    p = jax.nn.softmax(s, axis=-1).astype(h.dtype)
    o = jnp.einsum('bhsm,bmhd->bshd', p, v).reshape(bsz, seq, D_MODEL)
    return o @ w_o


def swiglu(h, w_gu, w_down):
    g, u = jnp.split(h @ w_gu, 2, axis=-1)
    return (jax.nn.silu(g) * u) @ w_down


def setup_inputs(seed: int = 0) -> dict:
    key = jax.random.key(seed)
    ks = jax.random.split(key, 32)
    L = DEPTH
    f32 = jnp.float32

    def nrm(k, shape, scale):
        return jax.random.normal(k, shape, f32) * scale

    def gain(k, shape):
        return 1.0 + 0.01 * jax.random.normal(k, shape, f32)

    lam_re = -0.5 * jnp.exp(0.05 * jax.random.normal(ks[8], (L, S5_GROUPS, S5_STATE), f32))
    lam_im = (math.pi * jnp.arange(S5_STATE, dtype=f32))[None, None, :] + 0.01 * jax.random.normal(ks[9], (L, S5_GROUPS, S5_STATE), f32)
    log_step = jax.random.uniform(ks[10], (L, S5_GROUPS), f32, math.log(1e-3), math.log(1e-1))
    return {
        'x': jax.random.normal(ks[0], (BATCH, SEQ, D_MODEL), f32),
        'mem': jax.random.normal(ks[1], (BATCH, MEM_LEN, D_MODEL), f32),
        'g_mix_pre': gain(ks[2], (L, D_MODEL)),
        'w_in': nrm(ks[3], (L, D_MODEL, IN_COLS), D_MODEL ** -0.5),
        'gm_ln_g': gain(ks[4], (L, GM_WIDTH)),
        'gm_ln_b': nrm(ks[5], (L, GM_WIDTH), 0.01),
        'gm_w_s': nrm(ks[6], (L, GM_GROUPS, GM_CHUNK, GM_CHUNK), GM_CHUNK ** -0.5),
        'gm_b_s': gain(ks[7], (L, GM_GROUPS, GM_CHUNK)),
        's5_lam_re': lam_re,
        's5_lam_im': lam_im,
        's5_log_step': log_step,
        's5_b_re': nrm(ks[11], (L, S5_GROUPS, S5_STATE, S5_GROUP_CH), (2 * S5_GROUP_CH) ** -0.5),
        's5_b_im': nrm(ks[12], (L, S5_GROUPS, S5_STATE, S5_GROUP_CH), (2 * S5_GROUP_CH) ** -0.5),
        's5_c_re': nrm(ks[13], (L, S5_GROUPS, S5_GROUP_CH, S5_STATE), (2 * S5_STATE) ** -0.5),
        's5_c_im': nrm(ks[14], (L, S5_GROUPS, S5_GROUP_CH, S5_STATE), (2 * S5_STATE) ** -0.5),
        's5_d': nrm(ks[15], (L, S5_GROUPS, S5_GROUP_CH), 1.0),
        's5_w_glu': nrm(ks[16], (L, S5_WIDTH, S5_WIDTH), S5_WIDTH ** -0.5),
        'w_br_gm': nrm(ks[17], (L, GM_WIDTH, D_MODEL), GM_WIDTH ** -0.5),
        'w_br_s5': nrm(ks[18], (L, S5_WIDTH, D_MODEL), S5_WIDTH ** -0.5),
        'w_mix_out': nrm(ks[19], (L, D_MODEL, D_MODEL), D_MODEL ** -0.5),
        'g_mix_post': gain(ks[20], (L, D_MODEL)),
        'g_ca_pre': gain(ks[21], (L, D_MODEL)),
        'g_mem': gain(ks[22], (L, D_MODEL)),
        'ca_w_q': nrm(ks[23], (L, D_MODEL, D_MODEL), D_MODEL ** -0.5),
        'ca_w_kv': nrm(ks[24], (L, D_MODEL, 2 * D_MODEL), D_MODEL ** -0.5),
        'ca_w_o': nrm(ks[25], (L, D_MODEL, D_MODEL), D_MODEL ** -0.5),
        'g_ca_post': gain(ks[26], (L, D_MODEL)),
        'g_ffn_pre': gain(ks[27], (L, D_MODEL)),
        'ffn_w_gu': nrm(ks[28], (L, D_MODEL, 2 * FFN_HIDDEN), D_MODEL ** -0.5),
        'ffn_w_down': nrm(ks[29], (L, FFN_HIDDEN, D_MODEL), FFN_HIDDEN ** -0.5),
        'g_ffn_post': gain(ks[30], (L, D_MODEL)),
    }


def reference(x, mem, g_mix_pre, w_in, gm_ln_g, gm_ln_b, gm_w_s, gm_b_s,
              s5_lam_re, s5_lam_im, s5_log_step, s5_b_re, s5_b_im, s5_c_re, s5_c_im,
              s5_d, s5_w_glu, w_br_gm, w_br_s5, w_mix_out, g_mix_post,
              g_ca_pre, g_mem, ca_w_q, ca_w_kv, ca_w_o, g_ca_post,
              g_ffn_pre, ffn_w_gu, ffn_w_down, g_ffn_post):
    for l in range(DEPTH):
        h = rms_norm(x, g_mix_pre[l])
        z = h @ w_in[l]
        z_gm, z_s5, z_ga, z_gb = jnp.split(z, SPLIT_POINTS, axis=-1)
        y_gm = gmlp_branch(z_gm, gm_ln_g[l], gm_ln_b[l], gm_w_s[l], gm_b_s[l])
        y_s5 = s5_branch(z_s5, s5_lam_re[l], s5_lam_im[l], s5_log_step[l],
                         s5_b_re[l], s5_b_im[l], s5_c_re[l], s5_c_im[l], s5_d[l], s5_w_glu[l])
        merged = (jax.nn.sigmoid(z_ga) * (y_gm @ w_br_gm[l])
                  + jax.nn.sigmoid(z_gb) * (y_s5 @ w_br_s5[l]))
        x = x + rms_norm(merged @ w_mix_out[l], g_mix_post[l])
        hc = rms_norm(x, g_ca_pre[l])
        mem_n = rms_norm(mem, g_mem[l])
        x = x + rms_norm(cross_attention(hc, mem_n, ca_w_q[l], ca_w_kv[l], ca_w_o[l]), g_ca_post[l])
        hf = rms_norm(x, g_ffn_pre[l])
        x = x + rms_norm(swiglu(hf, ffn_w_gu[l], ffn_w_down[l]), g_ffn_post[l])
    return x
```

```cpp
#include <hip/hip_runtime.h>
#include <hip/hip_cooperative_groups.h>
#include <cstdint>
#include <cstdio>
namespace cg = cooperative_groups;

#ifndef MK_ONE_LAUNCH
#define MK_ONE_LAUNCH 1
#endif

#define LAS __attribute__((address_space(3)))
typedef unsigned short bf16_t;
typedef short bf16x8 __attribute__((ext_vector_type(8)));
typedef float f32x4 __attribute__((ext_vector_type(4)));
typedef float f32x2 __attribute__((ext_vector_type(2)));
typedef unsigned u32x4 __attribute__((ext_vector_type(4)));
typedef unsigned u32x2 __attribute__((ext_vector_type(2)));

constexpr int M_TOK = 65536, DM = 1024, NIN = 4608, FF = 2816, NMEM = 4096, SEQ = 4096;
constexpr float EPS = 1e-6f;
constexpr int NPHASE = 17;
constexpr size_t MiB = 1u << 20;
constexpr size_t WS_WIN = 1 * MiB, WS_WBR = 10 * MiB, WS_WMIX = 13 * MiB, WS_WGLU = 15 * MiB, WS_WQ = 16 * MiB, WS_WKV = 18 * MiB  , WS_WO = 23 * MiB,
                 WS_WGU = 25 * MiB, WS_WDN = 36 * MiB, WS_WSP = 42 * MiB, WS_A64 = 42 * MiB + 512 * 1024, WS_BT1 = 43 * MiB  , WS_BT2 = 53 * MiB,
                 WS_EBUF = 125 * MiB, WS_MEMN = 141 * MiB  , WS_KB = 150 * MiB, WS_VT = 158 * MiB, WS_UC = 166 * MiB, WS_S3 = 238 * MiB, WS_S4 = 366 * MiB, WS_S2 = 494 * MiB,
                 WS_S0 = 622 * MiB, WS_S1 = 814 * MiB, WS_END = 942 * MiB, WS_ACT = WS_S3;
constexpr int LDS_RING = 131072, LDS_XS = 131072, LDS_BYTES = 147456;

typedef __bf16 bf16v2 __attribute__((ext_vector_type(2)));
__device__ __forceinline__ unsigned cvt_pk_bf16(float lo, float hi) { const f32x2 f = {lo, hi}; const bf16v2 v = __builtin_convertvector(f, bf16v2); return __builtin_bit_cast(unsigned, v); }
__device__ __forceinline__ float bf_lo(unsigned w) { return __uint_as_float(w << 16); }
__device__ __forceinline__ float bf_hi(unsigned w) { return __uint_as_float(w & 0xffff0000u); }
__device__ __forceinline__ float fsigmoid(float x) { return __builtin_amdgcn_rcpf(1.f + __builtin_amdgcn_exp2f(-1.4426950408889634f * x)); }
__device__ __forceinline__ float gelu_t(float x) { const float y = 1.5957691216057308f * (x + 0.044715f * x * x * x); return x * fsigmoid(y); }
__device__ __forceinline__ float shx(float v, int lane, int o) { return __int_as_float(__builtin_amdgcn_ds_bpermute((lane ^ o) << 2, __float_as_int(v))); }
__device__ __forceinline__ float wave_sum(float v, int lane) {
#pragma unroll
    for (int o = 1; o < 64; o <<= 1) v += shx(v, lane, o);
    return v;
}
__device__ __forceinline__ void unpack8(const u32x4 w, float (&v)[8]) {
    v[0] = bf_lo(w.x); v[1] = bf_hi(w.x); v[2] = bf_lo(w.y); v[3] = bf_hi(w.y); v[4] = bf_lo(w.z); v[5] = bf_hi(w.z); v[6] = bf_lo(w.w); v[7] = bf_hi(w.w);
}
__device__ __forceinline__ u32x4 pack8(const float (&v)[8]) {
    u32x4 w; w.x = cvt_pk_bf16(v[0], v[1]); w.y = cvt_pk_bf16(v[2], v[3]); w.z = cvt_pk_bf16(v[4], v[5]); w.w = cvt_pk_bf16(v[6], v[7]); return w;
}

namespace pg8 {
constexpr int BM = 256, BK = 64, HALF = 128, HTB = HALF * BK * 2, NXCD = 8, WGM = 8;
__host__ __device__ __forceinline__ int lds_byte(int r, int c) { const int st = (r >> 4) * 2 + (c >> 5), rr = r & 15, cc = c & 31, ob = rr * 64 + cc * 2; return st * 1024 + (ob ^ (((ob >> 9) & 1) << 5)); }
__host__ __device__ __forceinline__ void stage_rc(int b, int& R, int& C) { const int st = b / 1024, sb = b % 1024, swz = sb ^ (((sb >> 9) & 1) << 5); R = (st >> 1) * 16 + swz / 64; C = (st & 1) * 32 + (swz % 64) / 2; }
__host__ __device__ __forceinline__ int perm32(int rho) { const int n = rho >> 4, i = rho & 15; return 8 * (i >> 2) + 4 * n + (i & 3); }

enum Kind { K_IN = 0, K_KPROJ, K_VTPROJ, K_S5E, K_S5Y, K_GLU, K_BR, K_MIX, K_Q, K_SMAX, K_PV, K_OPROJ, K_GU, K_DOWN };

struct Unit { const char* A; const char* B; int lda, cha, ldb, nt, pn, kind, orow, ocol; };
struct Desc {
    const char* A; const char* B; int lda, cha, ldb, nt, nM, nN, nZ0; long zsA0, zsA1, zsB0, zsB1; int kind, orz0, orz1, ocz0;
    __device__ __forceinline__ void fill(int w, Unit& u) const {
        const int per = nM * nN, z = w / per, r = w % per;
        const int nig = WGM * nN, gid = r / nig, fm = gid * WGM, gsz = (nM - fm) < WGM ? (nM - fm) : WGM;
        const int pm = fm + ((r % nig) % gsz), pn = (r % nig) / gsz;
        const int z0 = z % nZ0, z1 = z / nZ0;
        u.pn = pn;
        u.A = A + z0 * zsA0 + z1 * zsA1 + (long)pm * BM * lda * 2;
        u.B = B + z0 * zsB0 + z1 * zsB1 + (long)pn * BM * ldb * 2;
        u.lda = lda; u.cha = cha; u.ldb = ldb; u.nt = nt; u.kind = kind;
        u.orow = pm * BM + z0 * orz0 + z1 * orz1; u.ocol = pn * BM + z0 * ocz0;
    }
};
__device__ __forceinline__ Desc mk_desc(const void* A, const void* B, int lda, int ldb, int K, int Mrows, int Ncols, int kind) {
    Desc d; d.A = (const char*)A; d.B = (const char*)B; d.lda = lda; d.cha = 16; d.ldb = ldb; d.nt = K / BK; d.nM = Mrows / BM; d.nN = Ncols / BM; d.nZ0 = 1;
    d.zsA0 = d.zsA1 = d.zsB0 = d.zsB1 = 0; d.kind = kind; d.orz0 = d.orz1 = d.ocz0 = 0; return d;
}
__device__ __forceinline__ Desc phase_desc(int ph, int sub, unsigned char* ws) {
    Desc d;
    if (ph == 1) { d = mk_desc(ws + WS_S0, ws + WS_WIN, 1024, 1024, 1024, M_TOK, NIN, K_IN);
    } else if (ph == 2) {
        if (sub == 0) { d = mk_desc(ws + WS_UC, ws + WS_BT1, 1152, 1152, 1024, 1024, 256, K_S5E); d.nZ0 = 32; d.zsA0 = 1024L * 1152 * 2; d.zsB0 = 128L * 1152 * 2; d.orz0 = 1024; }
        else if (sub == 1) d = mk_desc(ws + WS_MEMN, ws + WS_WKV, 1152, 1152, 1024, NMEM, 1024, K_KPROJ);
        else d = mk_desc(ws + WS_WKV + 1024L * 1152 * 2, ws + WS_MEMN, 1152, 1152, 1024, 1024, NMEM, K_VTPROJ);
    } else if (ph == 4) { d = mk_desc(ws + WS_UC, ws + WS_BT2, 1152, 1152, 1152, 1024, 1024, K_S5Y); d.nZ0 = 32; d.zsA0 = 1024L * 1152 * 2; d.zsB0 = 1024L * 1152 * 2; d.orz0 = 1024;
    } else if (ph == 5) { d = mk_desc(ws + WS_S1, ws + WS_WGLU, 16, 512, 512, M_TOK, 512, K_GLU); d.cha = M_TOK * 16;
    } else if (ph == 6) { d = mk_desc(ws + WS_S0, ws + WS_WBR, 1536, 1536, 1536, M_TOK, 1024, K_BR);
    } else if (ph == 7) { d = mk_desc(ws + WS_S1, ws + WS_WMIX, 1024, 1024, 1024, M_TOK, 1024, K_MIX);
    } else if (ph == 9) { d = mk_desc(ws + WS_S0, ws + WS_WQ, 1024, 1024, 1024, M_TOK, 1024, K_Q);
    } else if (ph == 10) { d = mk_desc(ws + WS_S1, ws + WS_KB, 1024, 1024, 256, SEQ, 256, K_SMAX);
        d.nZ0 = 4; d.zsA0 = 256 * 2; d.zsA1 = (long)SEQ * 1024 * 2; d.zsB0 = 256 * 2; d.zsB1 = 256L * 1024 * 2; d.orz1 = SEQ; d.ocz0 = 256;
    } else if (ph == 11) { d = mk_desc(ws + WS_S0, ws + WS_VT, 1024, NMEM, 256, SEQ, 256, K_PV);
        d.nZ0 = 4; d.zsA0 = 256 * 2; d.zsA1 = (long)SEQ * 1024 * 2; d.zsB0 = 256L * NMEM * 2; d.zsB1 = 256 * 2; d.orz1 = SEQ; d.ocz0 = 256;
    } else if (ph == 12) { d = mk_desc(ws + WS_S1, ws + WS_WO, 1024, 1024, 1024, M_TOK, 1024, K_OPROJ);
    } else if (ph == 14) { d = mk_desc(ws + WS_S1, ws + WS_WGU, 1024, 1024, 1024, M_TOK, 2 * FF, K_GU);
    } else { d = mk_desc(ws + WS_ACT, ws + WS_WDN, FF, FF, FF, M_TOK, 1024, K_DOWN); }
    return d;
}
__device__ __forceinline__ int phase_units(int ph, int sub) {
    switch (ph) {
        case 1: return (M_TOK / BM) * (NIN / BM);
        case 2: return sub == 0 ? 32 * 4 : 64;
        case 4: return 32 * 16;
        case 5: return (M_TOK / BM) * 2;
        case 10: case 11: return 64 * 16;
        case 14: return (M_TOK / BM) * (2 * FF / BM);
        default: return (M_TOK / BM) * 4;
    }
}
struct Sched {
    unsigned char* ws; int ph, n0, n1, total, G, c;
    __device__ __forceinline__ bool next(int i, Unit& u) const {
        const long L = (long)i * G + c; if (L >= total) return false;
        int wgid = (int)L; { const int q = total / NXCD, r = total % NXCD, xcd = wgid % NXCD, off = wgid / NXCD; wgid = (xcd < r ? xcd * (q + 1) : r * (q + 1) + (xcd - r) * q) + off; }
        int sub = 0; if (wgid >= n0) { sub = 1; wgid -= n0; if (wgid >= n1) { sub = 2; wgid -= n1; } }
        const Desc d = phase_desc(ph, sub, ws); d.fill(wgid, u);
        return true;
    }
};
struct Drv { unsigned vA0, vA1, vB0, vB1, kA, hA, hB; };
__device__ __forceinline__ Drv derive(const Unit& u, int tid) {
    int R0, C0, R1, C1; stage_rc(tid * 16, R0, C0); stage_rc(tid * 16 + 8192, R1, C1);
    const int Rb0 = (R0 & ~31) + perm32(R0 & 31), Rb1 = (R1 & ~31) + perm32(R1 & 31);
    Drv d;
    d.vA0 = (unsigned)(R0 * u.lda + (C0 >> 4) * u.cha + (C0 & 15)) * 2u; d.vA1 = (unsigned)(R1 * u.lda + (C1 >> 4) * u.cha + (C1 & 15)) * 2u;
    d.vB0 = (unsigned)(Rb0 * u.ldb + C0) * 2u; d.vB1 = (unsigned)(Rb1 * u.ldb + C1) * 2u;
    d.kA = (unsigned)(8 * u.cha); d.hA = (unsigned)(HALF * 2 * u.lda); d.hB = (unsigned)(HALF * 2 * u.ldb);
    return d;
}

struct Epi {
    unsigned char* ws; LAS unsigned char* lds;
    __device__ __forceinline__ void get8(const f32x4 (&acc)[2][2][4][2], int ai, int bj, int m, float (&v)[8]) const {
        const f32x4 a = acc[ai][bj][m][0], b = acc[ai][bj][m][1];
        v[0] = a[0]; v[1] = a[1]; v[2] = a[2]; v[3] = a[3]; v[4] = b[0]; v[5] = b[1]; v[6] = b[2]; v[7] = b[3];
    }
    __device__ __forceinline__ void mid(f32x4 (&acc)[2][2][4][2], const Unit& u, int wr, int wc, int fr, int fq) const {
        const bf16_t* GA = (const bf16_t*)(ws + WS_S3); const bf16_t* GB = (const bf16_t*)(ws + WS_S4);
        int rb = u.orow + wr * 64 + fr; asm volatile("" : "+v"(rb));
#pragma unroll
        for (int ai = 0; ai < 2; ++ai)
#pragma unroll
            for (int m = 0; m < 4; ++m) {
                const size_t row = (size_t)(rb + ai * HALF + m * 16);
#pragma unroll
                for (int bj = 0; bj < 2; ++bj) {
                    const int col = u.ocol + bj * HALF + wc * 32 + 8 * fq;
                    float a[8], b[8]; unpack8(*(const u32x4*)(GA + row * DM + col), a); unpack8(*(const u32x4*)(GB + row * DM + col), b);
#pragma unroll
                    for (int j = 0; j < 8; ++j) { const float r = a[j] * __builtin_amdgcn_rcpf(fmaxf(b[j], 1e-30f)); asm volatile("v_mul_f32 %0, %0, %1" : "+v"(acc[ai][bj][m][j >> 2][j & 3]) : "v"(r)); }
                }
                asm volatile("" ::: "memory");
            }
    }
    __device__ __forceinline__ void operator()(const f32x4 (&acc)[2][2][4][2], const Unit& u, int wr, int wc, int fr, int fq) const {
        const int kind = u.kind;
        if (kind == K_SMAX) {
            LAS f32x2* XS = (LAS f32x2*)(lds + LDS_XS);
            int rls = wr * 64 + fr; asm volatile("" : "+v"(rls));
            bf16_t* P = (bf16_t*)(ws + WS_S0);
#pragma unroll
            for (int ai = 0; ai < 2; ++ai)
#pragma unroll
                for (int m = 0; m < 4; ++m) {
                    float mx = -3.0e38f;
#pragma unroll
                    for (int bj = 0; bj < 2; ++bj)
#pragma unroll
                        for (int n = 0; n < 2; ++n)
#pragma unroll
                            for (int j = 0; j < 4; ++j) mx = fmaxf(mx, acc[ai][bj][m][n][j]);
                    mx = fmaxf(mx, shx(mx, fr + 16 * fq, 16)); mx = fmaxf(mx, shx(mx, fr + 16 * fq, 32));
                    float s = 0.f;
#pragma unroll
                    for (int bj = 0; bj < 2; ++bj)
#pragma unroll
                        for (int n = 0; n < 2; ++n)
#pragma unroll
                            for (int j = 0; j < 4; ++j) s += __builtin_amdgcn_exp2f((acc[ai][bj][m][n][j] - mx) * 1.4426950408889634f);
                    s += shx(s, fr + 16 * fq, 16); s += shx(s, fr + 16 * fq, 32);
                    if (fq == 0) XS[(rls + ai * HALF + m * 16) * 4 + wc] = (f32x2){mx, s};
                }
            asm volatile("s_waitcnt lgkmcnt(0)" ::: "memory"); __builtin_amdgcn_s_barrier(); asm volatile("" ::: "memory");
#pragma unroll
            for (int ai = 0; ai < 2; ++ai)
#pragma unroll
                for (int m = 0; m < 4; ++m) {
                    const int rl = rls + ai * HALF + m * 16;
                    const f32x2 p0 = XS[rl * 4 + 0], p1 = XS[rl * 4 + 1], p2 = XS[rl * 4 + 2], p3 = XS[rl * 4 + 3];
                    const f32x2 me = XS[rl * 4 + wc];
                    const float MX = fmaxf(fmaxf(p0.x, p1.x), fmaxf(p2.x, p3.x));
                    const float L = p0.y * __builtin_amdgcn_exp2f((p0.x - MX) * 1.4426950408889634f) + p1.y * __builtin_amdgcn_exp2f((p1.x - MX) * 1.4426950408889634f) +
                                    p2.y * __builtin_amdgcn_exp2f((p2.x - MX) * 1.4426950408889634f) + p3.y * __builtin_amdgcn_exp2f((p3.x - MX) * 1.4426950408889634f);
                    const float f = 1.0f / L; (void)me;
                    const size_t row = (size_t)(u.orow + rl);
#pragma unroll
                    for (int bj = 0; bj < 2; ++bj) {
                        float v[8]; get8(acc, ai, bj, m, v);
#pragma unroll
                        for (int j = 0; j < 8; ++j) v[j] = __builtin_amdgcn_exp2f((v[j] - MX) * 1.4426950408889634f) * f;
                        *(u32x4*)(P + row * DM + u.ocol + bj * HALF + wc * 32 + 8 * fq) = pack8(v);
                    }
                }
            asm volatile("s_waitcnt lgkmcnt(0)" ::: "memory"); __builtin_amdgcn_s_barrier(); asm volatile("" ::: "memory");
            return;
        }
        if (kind == K_GU) {
            bf16_t* ACT = (bf16_t*)(ws + WS_ACT);
            int rb = u.orow + wr * 64 + fr; asm volatile("" : "+v"(rb));
#pragma unroll
            for (int ai = 0; ai < 2; ++ai)
#pragma unroll
                for (int m = 0; m < 4; ++m) {
                    const size_t row = (size_t)(rb + ai * HALF + m * 16);
                    float g[8], w[8]; get8(acc, ai, 0, m, g); get8(acc, ai, 1, m, w);
#pragma unroll
                    for (int j = 0; j < 8; ++j) g[j] = g[j] * fsigmoid(g[j]) * w[j];
                    *(u32x4*)(ACT + row * FF + u.pn * HALF + wc * 32 + 8 * fq) = pack8(g);
                }
            return;
        }
        if (kind == K_S5E) {
            float* E = (float*)(ws + WS_EBUF);
            int rb = u.orow + wr * 64 + fr; asm volatile("" : "+v"(rb));
            int cb = wc * 32 + 8 * fq; asm volatile("" : "+v"(cb));
#pragma unroll
            for (int ai = 0; ai < 2; ++ai)
#pragma unroll
                for (int m = 0; m < 4; ++m) {
                    const size_t row = (size_t)(rb + ai * HALF + m * 16);
                    float* p = E + row * 128 + cb;
                    *(f32x4*)p = acc[ai][0][m][0]; *(f32x4*)(p + 4) = acc[ai][0][m][1];
                }
            return;
        }
        if (kind == K_IN) {
            const int pn = u.pn;
            if (pn < 8) tiles<1>(acc, u.orow, wr, wc, fr, fq, (bf16_t*)(ws + (pn < 4 ? WS_S1 : WS_S2)), DM, (pn & 3) * BM, nullptr);
            else if (pn < 10) tiles<3>(acc, u.orow, wr, wc, fr, fq, (bf16_t*)(ws + WS_UC), 0, (pn - 8) * BM, nullptr);
            else tiles<2>(acc, u.orow, wr, wc, fr, fq, (bf16_t*)(ws + (pn < 14 ? WS_S3 : WS_S4)), DM, ((pn - 10) & 3) * BM, nullptr);
        } else if (kind == K_KPROJ) tiles<0>(acc, u.orow, wr, wc, fr, fq, (bf16_t*)(ws + WS_KB), DM, u.ocol, nullptr);
        else if (kind == K_VTPROJ) tiles<0>(acc, u.orow, wr, wc, fr, fq, (bf16_t*)(ws + WS_VT), NMEM, u.ocol, nullptr);
        else if (kind == K_S5Y) tiles<1>(acc, u.orow, wr, wc, fr, fq, (bf16_t*)(ws + WS_S1), 1024, u.ocol, nullptr);
        else if (kind == K_GLU) tiles<4>(acc, u.orow, wr, wc, fr, fq, (bf16_t*)(ws + WS_S0) + 1024, 1536, u.ocol, (const bf16_t*)(ws + WS_S1));
        else if (kind == K_BR) tiles<5>(acc, u.orow, wr, wc, fr, fq, (bf16_t*)(ws + WS_S1), DM, u.ocol, (const bf16_t*)(ws + WS_S4));
        else if (kind == K_MIX) tiles<0>(acc, u.orow, wr, wc, fr, fq, (bf16_t*)(ws + WS_S2), DM, u.ocol, nullptr);
        else if (kind == K_Q) tiles<6>(acc, u.orow, wr, wc, fr, fq, (bf16_t*)(ws + WS_S1), DM, u.ocol, nullptr);
        else if (kind == K_PV) tiles<0>(acc, u.orow, wr, wc, fr, fq, (bf16_t*)(ws + WS_S1), DM, u.ocol, nullptr);
        else tiles<0>(acc, u.orow, wr, wc, fr, fq, (bf16_t*)(ws + WS_S0), DM, u.ocol, nullptr);
    }
    template <int MODE>
    __device__ __forceinline__ void tiles(const f32x4 (&acc)[2][2][4][2], int orow, int wr, int wc, int fr, int fq, bf16_t* base, int ld, int colbase, const bf16_t* aux) const {
        int rb = orow + wr * 64 + fr; asm volatile("" : "+v"(rb));
        int cb = colbase + wc * 32 + 8 * fq; asm volatile("" : "+v"(cb));
#pragma unroll
        for (int ai = 0; ai < 2; ++ai)
#pragma unroll
            for (int m = 0; m < 4; ++m) {
                const int rowi = rb + ai * HALF + m * 16; const size_t row = (size_t)rowi;
#pragma unroll
                for (int bj = 0; bj < 2; ++bj) {
                    const int col = cb + bj * HALF;
                    float v[8]; get8(acc, ai, bj, m, v);
                    bf16_t* dst = base + row * ld + col;
                    if (MODE == 1) {
#pragma unroll
                        for (int j = 0; j < 8; ++j) v[j] = gelu_t(v[j]);
                    } else if (MODE == 2) {
#pragma unroll
                        for (int j = 0; j < 8; ++j) v[j] = fsigmoid(v[j]);
                    } else if (MODE == 3) {
                        const int g = col >> 4, h0 = col & 15;
                        dst = base + ((size_t)(g * 1024 + (rowi >> 6))) * 1152 + (rowi & 63) * 16 + h0;
                    } else if (MODE == 4) {
                        const int g = col >> 4, h0 = col & 15;
                        float y[8]; unpack8(*(const u32x4*)(aux + ((size_t)g * M_TOK + row) * 16 + h0), y);
#pragma unroll
                        for (int j = 0; j < 8; ++j) v[j] = y[j] * fsigmoid(v[j]);
                    } else if (MODE == 5) {
                        float b[8]; unpack8(*(const u32x4*)(aux + row * DM + col), b);
#pragma unroll
                        for (int j = 0; j < 8; ++j) v[j] *= b[j];
                    } else if (MODE == 6) {
#pragma unroll
                        for (int j = 0; j < 8; ++j) v[j] *= 0.0625f;
                    }
                    *(u32x4*)dst = pack8(v);
                }
                asm volatile("" ::: "memory");
            }
    }
};

__device__ __forceinline__ void gemm_phase(LAS unsigned char* lds, const Sched& S, const Epi& E, const int tid) {
    const int wid = __builtin_amdgcn_readfirstlane(tid >> 6), lane = tid & 63, wr = wid >> 2, wc = wid & 3, fr = lane & 15, fq = lane >> 4;
    const unsigned ldsw = (unsigned)wid * 1024u;
    const int aoff = lds_byte(wr * 64 + fr, fq * 8), boff = lds_byte(wc * 32 + fr, fq * 8);
#define PG8_SA(b, h) (((b) * 2 + (h)) * HTB)
#define PG8_SB(b, h) ((4 + (b) * 2 + (h)) * HTB)
#define PG8_STAGE(bufoff, gbase, v0, v1) do { \
        __builtin_amdgcn_global_load_lds((const unsigned*)((const char*)(gbase) + (v0)), (LAS unsigned*)(lds + (bufoff) + ldsw), 16, 0, 0); \
        __builtin_amdgcn_global_load_lds((const unsigned*)((const char*)(gbase) + (v1)), (LAS unsigned*)(lds + (bufoff) + ldsw + 8192), 16, 0, 0); } while (0)
#define PG8_LDA(dst, b, h) do { _Pragma("unroll") for (int m = 0; m < 4; ++m) _Pragma("unroll") for (int k = 0; k < 2; ++k) dst[m][k] = *(const LAS bf16x8*)(lds + PG8_SA(b, h) + aoff + m * 2048 + k * 1024); } while (0)
#define PG8_LDB(dst, b, h) do { _Pragma("unroll") for (int n = 0; n < 2; ++n) _Pragma("unroll") for (int k = 0; k < 2; ++k) dst[n][k] = *(const LAS bf16x8*)(lds + PG8_SB(b, h) + boff + n * 2048 + k * 1024); } while (0)
#define PG8_MMA(ai, bj, At, Bt) do { __builtin_amdgcn_s_setprio(1); _Pragma("unroll") for (int m = 0; m < 4; ++m) _Pragma("unroll") for (int n = 0; n < 2; ++n) _Pragma("unroll") for (int k = 0; k < 2; ++k) \
        acc[ai][bj][m][n] = __builtin_amdgcn_mfma_f32_16x16x32_bf16(Bt[n][k], At[m][k], acc[ai][bj][m][n], 0, 0, 0); __builtin_amdgcn_s_setprio(0); } while (0)
#define PG8_WAIT_V(n) asm volatile("s_waitcnt vmcnt(" #n ")" ::: "memory")
#define PG8_WAIT_L(n) asm volatile("s_waitcnt lgkmcnt(" #n ")" ::: "memory")
#define PG8_BAR __builtin_amdgcn_s_barrier()
#define PG8_SCHED __builtin_amdgcn_sched_barrier(0)
    Unit cur, nxt; int ui = 0;
    if (!S.next(0, cur)) return;
    nxt = cur;
    f32x4 acc[2][2][4][2];
#pragma unroll
    for (int a = 0; a < 2; ++a)
#pragma unroll
        for (int b = 0; b < 2; ++b)
#pragma unroll
            for (int m = 0; m < 4; ++m)
#pragma unroll
                for (int n = 0; n < 2; ++n) acc[a][b][m][n] = (f32x4){0.f, 0.f, 0.f, 0.f};
    bf16x8 At[4][2], B0[2][2], B1[2][2];
    const Drv dc = derive(cur, tid);
    const char* cA = cur.A; const char* cB = cur.B;
    PG8_STAGE(PG8_SB(0, 0), cB, dc.vB0, dc.vB1); PG8_STAGE(PG8_SB(0, 1), cB + dc.hB, dc.vB0, dc.vB1); PG8_STAGE(PG8_SA(0, 0), cA, dc.vA0, dc.vA1); PG8_STAGE(PG8_SA(0, 1), cA + dc.hA, dc.vA0, dc.vA1);
    if (wr == 1) PG8_BAR;
    PG8_WAIT_V(2); PG8_BAR;
    PG8_STAGE(PG8_SB(1, 0), cB + 128, dc.vB0, dc.vB1); PG8_STAGE(PG8_SA(1, 0), cA + dc.kA, dc.vA0, dc.vA1); PG8_STAGE(PG8_SB(1, 1), cB + dc.hB + 128, dc.vB0, dc.vB1);
    PG8_WAIT_V(6); PG8_BAR;
    for (;;) {
        const bool has_next = S.next(ui + 1, nxt);
        const char* nA = cA; const char* nB = cB;
        if (has_next) { nA = nxt.A; nB = nxt.B; }
        const int nt = cur.nt;
        for (int t = 0; t < nt; t += 2) {
            const bool last = (t == nt - 2);
            if (cur.kind == K_BR && t == 16) E.mid(acc, cur, wr, wc, fr, fq);
            const char* a1 = cA + (size_t)(t + 1) * dc.kA;
            const char* a2 = last ? nA : cA + (size_t)(t + 2) * dc.kA; const char* b2 = last ? nB : cB + (size_t)(t + 2) * 128;
            const unsigned xA0 = dc.vA0, xA1 = dc.vA1, xB0 = dc.vB0, xB1 = dc.vB1, xk = dc.kA, xhA = dc.hA, xhB = dc.hB;
            const char* a3 = a2 + xk; const char* b3 = b2 + 128;
            PG8_LDB(B0, 0, 0); PG8_LDB(B1, 0, 1); PG8_SCHED; PG8_LDA(At, 0, 0); PG8_STAGE(PG8_SA(1, 1), a1 + dc.hA, dc.vA0, dc.vA1);
            PG8_WAIT_V(8); PG8_WAIT_L(0); PG8_BAR; PG8_MMA(0, 0, At, B0); PG8_MMA(0, 1, At, B1); PG8_BAR; PG8_SCHED;
            PG8_LDA(At, 0, 1); PG8_STAGE(PG8_SB(0, 0), b2, xB0, xB1); PG8_STAGE(PG8_SB(0, 1), b2 + xhB, xB0, xB1); PG8_STAGE(PG8_SA(0, 0), a2, xA0, xA1);
            PG8_WAIT_V(8); PG8_WAIT_L(0); PG8_BAR; PG8_MMA(1, 0, At, B0); PG8_MMA(1, 1, At, B1); PG8_BAR; PG8_SCHED;
            PG8_LDB(B0, 1, 0); PG8_LDB(B1, 1, 1); PG8_SCHED; PG8_LDA(At, 1, 0); PG8_STAGE(PG8_SA(0, 1), a2 + xhA, xA0, xA1);
            PG8_WAIT_V(8); PG8_WAIT_L(0); PG8_BAR; PG8_MMA(0, 0, At, B0); PG8_MMA(0, 1, At, B1); PG8_BAR; PG8_SCHED;
            PG8_LDA(At, 1, 1); PG8_STAGE(PG8_SB(1, 0), b3, xB0, xB1); PG8_STAGE(PG8_SB(1, 1), b3 + xhB, xB0, xB1); PG8_STAGE(PG8_SA(1, 0), a3, xA0, xA1);
            PG8_WAIT_V(8); PG8_WAIT_L(0); PG8_BAR; PG8_MMA(1, 0, At, B0); PG8_MMA(1, 1, At, B1); PG8_BAR; PG8_SCHED;
        }
        if (wr == 0) PG8_BAR;
        E(acc, cur, wr, wc, fr, fq);
        if (!has_next) break;
#pragma unroll
        for (int a = 0; a < 2; ++a)
#pragma unroll
            for (int b = 0; b < 2; ++b)
#pragma unroll
                for (int m = 0; m < 4; ++m)
#pragma unroll
                    for (int n = 0; n < 2; ++n) acc[a][b][m][n] = (f32x4){0.f, 0.f, 0.f, 0.f};
        cur = nxt; cA = nA; cB = nB; ++ui;
        if (wr == 1) PG8_BAR;
    }
    PG8_WAIT_V(0);
    PG8_BAR;
#undef PG8_SA
#undef PG8_SB
#undef PG8_STAGE
#undef PG8_LDA
#undef PG8_LDB
#undef PG8_MMA
#undef PG8_WAIT_V
#undef PG8_WAIT_L
#undef PG8_BAR
#undef PG8_SCHED
}
}

__device__ __forceinline__ void transpose_item(const float* W, int N, bf16_t* WT, int ldt, int col_off, int rmode, LAS float* scr, int item, int lane) {
    const int nblk = N / 32, kb = item / nblk, nb = item % nblk, k0 = 64 * kb, n0 = 32 * nb;
#pragma unroll 8
    for (int i = 0; i < 32; ++i) { const int kk = 2 * i + (lane >> 5); scr[kk * 33 + (lane & 31)] = W[(size_t)(k0 + kk) * N + n0 + (lane & 31)]; }
    asm volatile("s_waitcnt lgkmcnt(0)" ::: "memory");
    int r0 = n0;
    if (rmode == 1) { const int isu = n0 >= FF, nn = isu ? n0 - FF : n0; r0 = 256 * (nn >> 7) + (nn & 127) + (isu ? 128 : 0); }
    const int c = lane & 7;
#pragma unroll
    for (int j = 0; j < 4; ++j) { const int n = (lane >> 3) + 8 * j; const LAS float* s = scr + (8 * c) * 33 + n;
        u32x4 o; o.x = cvt_pk_bf16(s[0 * 33], s[1 * 33]); o.y = cvt_pk_bf16(s[2 * 33], s[3 * 33]); o.z = cvt_pk_bf16(s[4 * 33], s[5 * 33]); o.w = cvt_pk_bf16(s[6 * 33], s[7 * 33]);
        *(u32x4*)(WT + (size_t)(r0 + n) * ldt + col_off + k0 + 8 * c) = o; }
    asm volatile("s_waitcnt lgkmcnt(0)" ::: "memory");
}
__device__ __forceinline__ void rms_row_to_bf16(const float* xrow, const float* g, bf16_t* orow, int lane) {
    f32x4 v[4]; float s = 0.f;
#pragma unroll
    for (int j = 0; j < 2; ++j) { v[2 * j] = *(const f32x4*)(xrow + 512 * j + 8 * lane); v[2 * j + 1] = *(const f32x4*)(xrow + 512 * j + 8 * lane + 4); }
#pragma unroll
    for (int j = 0; j < 4; ++j) s += (v[j][0] * v[j][0] + v[j][1] * v[j][1]) + (v[j][2] * v[j][2] + v[j][3] * v[j][3]);
    const float rstd = 1.f / sqrtf(wave_sum(s, lane) * (1.f / DM) + EPS);
#pragma unroll
    for (int j = 0; j < 2; ++j) {
        const f32x4 g0 = *(const f32x4*)(g + 512 * j + 8 * lane), g1 = *(const f32x4*)(g + 512 * j + 8 * lane + 4);
        const f32x4 a = v[2 * j] * rstd * g0, b = v[2 * j + 1] * rstd * g1;
        u32x4 w; w.x = cvt_pk_bf16(a[0], a[1]); w.y = cvt_pk_bf16(a[2], a[3]); w.z = cvt_pk_bf16(b[0], b[1]); w.w = cvt_pk_bf16(b[2], b[3]);
        *(u32x4*)(orow + 512 * j + 8 * lane) = w;
    }
}
__device__ __forceinline__ void rowpass(const bf16_t* m, const float* gpost, const float* xin, float* xout, const float* gpre, bf16_t* hout, int gw, int NGW, int lane) {
    for (int row = gw; row < M_TOK; row += NGW) {
        const size_t ro = (size_t)row * DM;
        float mv[2][8]; float ss = 0.f;
#pragma unroll
        for (int j = 0; j < 2; ++j) { unpack8(*(const u32x4*)(m + ro + 512 * j + 8 * lane), mv[j]);
#pragma unroll
            for (int i = 0; i < 8; ++i) ss += mv[j][i] * mv[j][i]; }
        const float rstd = 1.f / sqrtf(wave_sum(ss, lane) * (1.f / DM) + EPS);
        float x1[2][8]; float s2 = 0.f;
#pragma unroll
        for (int j = 0; j < 2; ++j) {
            const int c = 512 * j + 8 * lane;
            const f32x4 xa = *(const f32x4*)(xin + ro + c), xb = *(const f32x4*)(xin + ro + c + 4), ga = *(const f32x4*)(gpost + c), gb = *(const f32x4*)(gpost + c + 4);
#pragma unroll
            for (int i = 0; i < 4; ++i) { x1[j][i] = xa[i] + mv[j][i] * rstd * ga[i]; x1[j][4 + i] = xb[i] + mv[j][4 + i] * rstd * gb[i]; }
#pragma unroll
            for (int i = 0; i < 8; ++i) s2 += x1[j][i] * x1[j][i];
            *(f32x4*)(xout + ro + c) = (f32x4){x1[j][0], x1[j][1], x1[j][2], x1[j][3]}; *(f32x4*)(xout + ro + c + 4) = (f32x4){x1[j][4], x1[j][5], x1[j][6], x1[j][7]};
        }
        if (hout) {
            const float r2 = 1.f / sqrtf(wave_sum(s2, lane) * (1.f / DM) + EPS);
#pragma unroll
            for (int j = 0; j < 2; ++j) {
                const int c = 512 * j + 8 * lane;
                const f32x4 ga = *(const f32x4*)(gpre + c), gb = *(const f32x4*)(gpre + c + 4);
                float h[8];
#pragma unroll
                for (int i = 0; i < 4; ++i) { h[i] = x1[j][i] * r2 * ga[i]; h[4 + i] = x1[j][4 + i] * r2 * gb[i]; }
                *(u32x4*)(hout + ro + c) = pack8(h);
            }
        }
    }
}

__device__ __forceinline__ void s5_tables(LAS unsigned char* lds, unsigned char* ws, const float* lam_re, const float* lam_im, const float* log_step, const float* b_re,
                                          const float* b_im, const float* c_re, const float* c_im, const float* dvec, int g, int part, int tid) {
    LAS f32x2* AP = (LAS f32x2*)lds;
    LAS f32x2* BB = (LAS f32x2*)(lds + 33280);
    LAS f32x2* CC = (LAS f32x2*)(lds + 41472);
    LAS float* KT = (LAS float*)(lds + 49664);
    const float step = expf(log_step[g]);
    for (int i = tid; i < 64 * 65; i += 512) {
        const int p = i / 65, tau = i % 65;
        const float lr = lam_re[g * 64 + p], li = lam_im[g * 64 + p];
        const float mag = expf(lr * step * (float)tau);
        const double ang = (double)li * (double)step * (double)tau;
        const double kq = rint(ang * 0.15915494309189535);
        const float r = (float)(ang - kq * 6.283185307179586);
        AP[p * 65 + tau] = (f32x2){mag * cosf(r), mag * sinf(r)};
    }
    for (int i = tid; i < 64 * 16; i += 512) {
        const int p = i >> 4, h = i & 15;
        const float lr = lam_re[g * 64 + p], li = lam_im[g * 64 + p];
        const float x = lr * step, mag = expf(x), em1 = expm1f(x);
        const double ang = (double)li * (double)step; const double kq = rint(ang * 0.15915494309189535);
        const float r = (float)(ang - kq * 6.283185307179586);
        const float sh = sinf(0.5f * r), cm1 = -2.f * sh * sh, sn = sinf(r), cs = 1.f + cm1;
        const float nr = em1 * cs + cm1, ni = mag * sn;
        const float den = lr * lr + li * li;
        const float co_re = (nr * lr + ni * li) / den, co_im = (ni * lr - nr * li) / den;
        const float br = b_re[(g * 64 + p) * 16 + h], bi = b_im[(g * 64 + p) * 16 + h];
        BB[p * 16 + h] = (f32x2){co_re * br - co_im * bi, co_re * bi + co_im * br};
        const int hh = i >> 6, pp = i & 63;
        CC[hh * 64 + pp] = (f32x2){c_re[(g * 16 + hh) * 64 + pp], c_im[(g * 16 + hh) * 64 + pp]};
    }
    __syncthreads();
    for (int it = 0; it < 2; ++it) {
        const int tau = tid & 63, hp = (tid >> 6) + 8 * it;
        float a[16];
#pragma unroll
        for (int h = 0; h < 16; ++h) a[h] = 0.f;
        for (int p = 0; p < 64; ++p) {
            const f32x2 c = CC[hp * 64 + p], ap = AP[p * 65 + tau];
            const float xr = c.x * ap.x - c.y * ap.y, xi = c.x * ap.y + c.y * ap.x;
#pragma unroll
            for (int h = 0; h < 16; ++h) { const f32x2 b = BB[p * 16 + h]; a[h] += xr * b.x - xi * b.y; }
        }
        if (tau == 0) {
#pragma unroll
            for (int h = 0; h < 16; ++h) if (h == hp) a[h] += dvec[g * 16 + hp];
        }
#pragma unroll
        for (int h = 0; h < 16; ++h) KT[(tau * 16 + hp) * 16 + h] = a[h];
    }
    __syncthreads();
    bf16_t* BT2 = (bf16_t*)(ws + WS_BT2) + (size_t)g * 1024 * 1152;
    for (int i = tid; i < 128 * 144; i += 512) {
        const int rl = i / 144, cc = i % 144, t = 8 * part + (rl >> 4), hp = rl & 15;
        float v[8];
        if (cc < 128) {
            const int s = cc >> 1, h0 = (cc & 1) * 8;
            if (s <= t) {
#pragma unroll
                for (int j = 0; j < 8; ++j) v[j] = KT[((t - s) * 16 + hp) * 16 + h0 + j];
            } else {
#pragma unroll
                for (int j = 0; j < 8; ++j) v[j] = 0.f;
            }
        } else {
            const int p0 = (cc - 128) * 4;
#pragma unroll
            for (int j = 0; j < 4; ++j) { const f32x2 c = CC[hp * 64 + p0 + j], ap = AP[(p0 + j) * 65 + t + 1];
                v[2 * j] = c.x * ap.x - c.y * ap.y; v[2 * j + 1] = -(c.x * ap.y + c.y * ap.x); }
        }
        *(u32x4*)(BT2 + (size_t)(t * 16 + hp) * 1152 + cc * 8) = pack8(v);
    }
    bf16_t* BT1 = (bf16_t*)(ws + WS_BT1) + (size_t)g * 128 * 1152;
    for (int i = tid; i < 16 * 128; i += 512) {
        const int rl = i >> 7, cc = i & 127, p = 8 * part + (rl >> 1), ri = rl & 1, s = cc >> 1, h0 = (cc & 1) * 8;
        const f32x2 ap = AP[p * 65 + 63 - s];
        float v[8];
#pragma unroll
        for (int j = 0; j < 8; ++j) { const f32x2 b = BB[p * 16 + h0 + j]; v[j] = ri ? (ap.x * b.y + ap.y * b.x) : (ap.x * b.x - ap.y * b.y); }
        *(u32x4*)(BT1 + (size_t)(2 * p + ri) * 1152 + cc * 8) = pack8(v);
    }
    if (part == 0 && tid < 64) ((f32x2*)(ws + WS_A64))[g * 64 + tid] = AP[tid * 65 + 64];
    __syncthreads();
}

__device__ __forceinline__ void spatial_phase(LAS unsigned char* lds, unsigned char* ws, const float* ln_g, const float* ln_b, const float* b_s, int vcu, int G, const int tid) {
    const int wid = __builtin_amdgcn_readfirstlane(tid >> 6), lane = tid & 63, fr = lane & 15, fq = lane >> 4;
    LAS f32x2* ST = (LAS f32x2*)lds;
    LAS bf16_t* VT = (LAS bf16_t*)(lds + 1024);
    const bf16_t* U = (const bf16_t*)(ws + WS_S1); const bf16_t* V = (const bf16_t*)(ws + WS_S2); bf16_t* YC = (bf16_t*)(ws + WS_S0);
    const bf16_t* WSP = (const bf16_t*)(ws + WS_WSP);
    for (int unit = vcu; unit < M_TOK / 128; unit += G) {
        const size_t r0 = (size_t)unit * 128;
        for (int j = 0; j < 16; ++j) {
            const bf16_t* p = V + (r0 + 16 * wid + j) * DM;
            float a[8], b[8]; unpack8(*(const u32x4*)(p + 8 * lane), a); unpack8(*(const u32x4*)(p + 512 + 8 * lane), b);
            float s = 0.f, s2 = 0.f;
#pragma unroll
            for (int i = 0; i < 8; ++i) { s += a[i] + b[i]; s2 += a[i] * a[i] + b[i] * b[i]; }
            s = wave_sum(s, lane); s2 = wave_sum(s2, lane);
            const float mean = s * (1.f / DM), var = fmaxf(s2 * (1.f / DM) - mean * mean, 0.f);
            if (lane == 0) ST[16 * wid + j] = (f32x2){mean, 1.f / sqrtf(var + EPS)};
        }
        __syncthreads();
        for (int g = 0; g < 8; ++g) {
#pragma unroll
            for (int it = 0; it < 4; ++it) {
                const int idx = wid * 4 + it, s = (idx & 1) * 64 + lane, cb = idx >> 1, c0 = cb * 8;
                float v[8]; unpack8(*(const u32x4*)(V + (r0 + s) * DM + g * 128 + c0), v);
                const f32x2 st = ST[s];
                const f32x4 g0 = *(const f32x4*)(ln_g + g * 128 + c0), g1 = *(const f32x4*)(ln_g + g * 128 + c0 + 4), e0 = *(const f32x4*)(ln_b + g * 128 + c0), e1 = *(const f32x4*)(ln_b + g * 128 + c0 + 4);
#pragma unroll
                for (int i = 0; i < 8; ++i) {
                    const int c = c0 + i, rho = (c & ~31) + 16 * ((c >> 2) & 1) + 4 * ((c & 31) >> 3) + (c & 3);
                    const float gm = i < 4 ? g0[i] : g1[i - 4], be = i < 4 ? e0[i] : e1[i - 4];
                    const float val = (v[i] - st.x) * st.y * gm + be;
                    VT[rho * 136 + s] = (bf16_t)(cvt_pk_bf16(val, 0.f) & 0xffffu);
                }
            }
            __syncthreads();
            f32x4 acc[4][2];
#pragma unroll
            for (int b = 0; b < 4; ++b) { acc[b][0] = (f32x4){0.f, 0.f, 0.f, 0.f}; acc[b][1] = (f32x4){0.f, 0.f, 0.f, 0.f}; }
            const int kmax = (16 * wid + 15) >> 5;
            for (int kk = 0; kk <= kmax; ++kk) {
                const bf16x8 wf = *(const bf16x8*)(WSP + ((size_t)(g * 128 + 16 * wid + fr)) * 128 + 32 * kk + 8 * fq);
#pragma unroll
                for (int b = 0; b < 4; ++b)
#pragma unroll
                    for (int n = 0; n < 2; ++n) {
                        const bf16x8 vf = *(const LAS bf16x8*)(VT + (b * 32 + 16 * n + fr) * 136 + 32 * kk + 8 * fq);
                        acc[b][n] = __builtin_amdgcn_mfma_f32_16x16x32_bf16(vf, wf, acc[b][n], 0, 0, 0);
                    }
            }
            const int t = 16 * wid + fr; const float bias = b_s[g * 128 + t];
#pragma unroll
            for (int b = 0; b < 4; ++b) {
                const int col = g * 128 + b * 32 + 8 * fq;
                float u8[8]; unpack8(*(const u32x4*)(U + (r0 + t) * DM + col), u8);
                float o[8];
#pragma unroll
                for (int j = 0; j < 4; ++j) { o[j] = (acc[b][0][j] + bias) * u8[j]; o[4 + j] = (acc[b][1][j] + bias) * u8[4 + j]; }
                *(u32x4*)(YC + (r0 + t) * 1536 + col) = pack8(o);
            }
            __syncthreads();
        }
    }
}

struct Args { const float* in[31]; float* out; unsigned char* ws; int ph_lo, ph_hi; };

__global__ void __launch_bounds__(512, 2) mk_fwd(Args args) {
    extern __shared__ __attribute__((aligned(16))) unsigned char lds_raw[];
    LAS unsigned char* lds = (LAS unsigned char*)lds_raw;
    const int G = gridDim.x, bx = blockIdx.x;
    const int vcu = (G % 8 == 0) ? (bx % 8) * (G / 8) + bx / 8 : bx;

    for (int ph = args.ph_lo; ph < args.ph_hi; ++ph) {
        int tid = threadIdx.x; asm volatile("" : "+v"(tid));
        size_t wz = 0; asm volatile("" : "+s"(wz)); unsigned char* ws = args.ws + wz;
        const __attribute__((address_space(4))) char* kp = (const __attribute__((address_space(4))) char*)__builtin_amdgcn_kernarg_segment_ptr() + wz;
#define IN(i) ((const float*)(*(const __attribute__((address_space(1))) float* const __attribute__((address_space(4)))*)(kp + 8 * (i))))
        const int lane = tid & 63, wave = __builtin_amdgcn_readfirstlane(tid >> 6);
        const int gw = vcu * 8 + wave, NGW = G * 8;
        pg8::Epi E; E.ws = ws; E.lds = lds;
        bool is_gemm = false;
        if (ph == 0) {
            for (int u = bx; u < 256; u += G) s5_tables(lds, ws, IN(8), IN(9), IN(10), IN(11), IN(12), IN(13), IN(14), IN(15), u >> 3, u & 7, tid);
            LAS float* scr = (LAS float*)(lds + wave * 16384);
            constexpr int I_IN = 16 * (NIN / 32), I_BG = 16 * 32, I_BS = 8 * 32, I_MX = 16 * 32, I_GL = 8 * 16, I_Q = 16 * 32, I_KV = 16 * 64, I_O = 16 * 32, I_GU = 16 * (2 * FF / 32), I_DN = (FF / 64) * 32;
            constexpr int NIT = I_IN + I_BG + I_BS + I_MX + I_GL + I_Q + I_KV + I_O + I_GU + I_DN;
            for (int it = gw; it < NIT; it += NGW) {
                int r = it;
                if (r < I_IN) { transpose_item(IN(3), NIN, (bf16_t*)(ws + WS_WIN), 1024, 0, 0, scr, r, lane); continue; } r -= I_IN;
                if (r < I_BG) { transpose_item(IN(17), 1024, (bf16_t*)(ws + WS_WBR), 1536, 0, 0, scr, r, lane); continue; } r -= I_BG;
                if (r < I_BS) { transpose_item(IN(18), 1024, (bf16_t*)(ws + WS_WBR), 1536, 1024, 0, scr, r, lane); continue; } r -= I_BS;
                if (r < I_MX) { transpose_item(IN(19), 1024, (bf16_t*)(ws + WS_WMIX), 1024, 0, 0, scr, r, lane); continue; } r -= I_MX;
                if (r < I_GL) { transpose_item(IN(16), 512, (bf16_t*)(ws + WS_WGLU), 512, 0, 0, scr, r, lane); continue; } r -= I_GL;
                if (r < I_Q) { transpose_item(IN(23), 1024, (bf16_t*)(ws + WS_WQ), 1024, 0, 0, scr, r, lane); continue; } r -= I_Q;
                if (r < I_KV) { transpose_item(IN(24), 2048, (bf16_t*)(ws + WS_WKV), 1152, 0, 0, scr, r, lane); continue; } r -= I_KV;
                if (r < I_O) { transpose_item(IN(25), 1024, (bf16_t*)(ws + WS_WO), 1024, 0, 0, scr, r, lane); continue; } r -= I_O;
                if (r < I_GU) { transpose_item(IN(28), 2 * FF, (bf16_t*)(ws + WS_WGU), 1024, 0, 1, scr, r, lane); continue; } r -= I_GU;
                transpose_item(IN(29), 1024, (bf16_t*)(ws + WS_WDN), FF, 0, 0, scr, r, lane);
            }
            {
                const float* w = IN(6); bf16_t* o = (bf16_t*)(ws + WS_WSP);
                for (int i = vcu * 512 + tid; i < 8 * 128 * 128 / 8; i += G * 512) {
                    const int e = i * 8, s0 = e & 127, t = (e >> 7) & 127;
                    const f32x4 a = *(const f32x4*)(w + e), b = *(const f32x4*)(w + e + 4);
                    float v[8] = {a[0], a[1], a[2], a[3], b[0], b[1], b[2], b[3]};
#pragma unroll
                    for (int j = 0; j < 8; ++j) if (s0 + j > t) v[j] = 0.f;
                    *(u32x4*)(o + e) = pack8(v);
                }
            }
            for (int m = gw; m < M_TOK; m += NGW) rms_row_to_bf16(IN(0) + (size_t)m * DM, IN(2), (bf16_t*)(ws + WS_S0) + (size_t)m * DM, lane);
            for (int m = gw; m < NMEM; m += NGW) rms_row_to_bf16(IN(1) + (size_t)m * DM, IN(22), (bf16_t*)(ws + WS_MEMN) + (size_t)m * 1152, lane);
        } else if (ph == 1 || ph == 2) { is_gemm = true;
        } else if (ph == 3) {
            const int gt = vcu * 512 + tid;
            if (gt < 16 * 32 * 64) {
                const int p = gt & 63, g = (gt >> 6) & 31, b = gt >> 11;
                const f32x2 a = ((const f32x2*)(ws + WS_A64))[g * 64 + p];
                const float* Eb = (const float*)(ws + WS_EBUF); bf16_t* UC = (bf16_t*)(ws + WS_UC);
                float cr = 0.f, ci = 0.f;
#pragma unroll 8
                for (int k = 0; k < 64; ++k) {
                    const size_t row = (size_t)g * 1024 + b * 64 + k;
                    const f32x2 e = *(const f32x2*)(Eb + row * 128 + 2 * p);
                    *(unsigned*)(UC + row * 1152 + 1024 + 2 * p) = cvt_pk_bf16(cr, ci);
                    const float nr = a.x * cr - a.y * ci + e.x, ni = a.x * ci + a.y * cr + e.y; cr = nr; ci = ni;
                }
            }
        } else if (ph == 4 || ph == 5 || ph == 6 || ph == 7) { is_gemm = true;
        } else if (ph == 8) {
            rowpass((const bf16_t*)(ws + WS_S2), IN(20), IN(0), args.out, IN(21), (bf16_t*)(ws + WS_S0), gw, NGW, lane);
        } else if (ph == 9 || ph == 10 || ph == 11 || ph == 12) { is_gemm = true;
        } else if (ph == 13) {
            rowpass((const bf16_t*)(ws + WS_S0), IN(26), args.out, args.out, IN(27), (bf16_t*)(ws + WS_S1), gw, NGW, lane);
        } else if (ph == 14 || ph == 15) { is_gemm = true;
        } else if (ph == 16) {
            rowpass((const bf16_t*)(ws + WS_S0), IN(30), args.out, args.out, nullptr, nullptr, gw, NGW, lane);
        }
        if (is_gemm) {
            pg8::Sched S; S.ws = ws; S.ph = ph; S.G = G; S.c = bx;
            S.n0 = pg8::phase_units(ph, 0); S.n1 = ph == 2 ? pg8::phase_units(2, 1) : 0; S.total = S.n0 + S.n1 + (ph == 2 ? pg8::phase_units(2, 2) : 0);
            pg8::gemm_phase(lds, S, E, tid);
            if (ph == 2) { __syncthreads(); spatial_phase(lds, ws, IN(4), IN(5), IN(7), vcu, G, tid); }
        }
        if (ph + 1 < args.ph_hi) { cg::this_grid().sync(); }
    }
}

extern "C" void kernel_launch(void* const* d_in, const int* in_sizes, int n_in, void* d_out, int out_size, void* d_ws, size_t ws_size, hipStream_t stream) {
    static int grid = 0;
    if (grid == 0) {
        if (n_in != 31 || in_sizes[0] != M_TOK * DM || out_size != M_TOK * DM || ws_size < WS_END) { fprintf(stderr, "kernel_launch: unexpected problem (n_in %d, ws %zu)\n", n_in, ws_size); grid = -1; return; }
        int dev = 0, cus = 0, per_cu = 0;
        hipGetDevice(&dev); hipDeviceGetAttribute(&cus, hipDeviceAttributeMultiprocessorCount, dev);
        hipFuncSetAttribute((const void*)mk_fwd, hipFuncAttributeMaxDynamicSharedMemorySize, LDS_BYTES);
        hipOccupancyMaxActiveBlocksPerMultiprocessor(&per_cu, (const void*)mk_fwd, 512, LDS_BYTES);
        if (per_cu < 1) { fprintf(stderr, "kernel_launch: occupancy query says %d blocks per CU\n", per_cu); per_cu = 1; }
        (void)hipGetLastError();
        grid = cus;
    }
    if (grid < 0) return;
    Args a{};
    for (int i = 0; i < 31; ++i) a.in[i] = (const float*)d_in[i];
    a.out = (float*)d_out; a.ws = (unsigned char*)d_ws;
#if MK_ONE_LAUNCH
    a.ph_lo = 0; a.ph_hi = NPHASE;
    void* kargs[] = {&a};
    hipError_t e = hipLaunchCooperativeKernel((const void*)mk_fwd, dim3(grid), dim3(512), kargs, LDS_BYTES, stream);
    if (e != hipSuccess) fprintf(stderr, "cooperative launch failed: %s (grid %d)\n", hipGetErrorString(e), grid);

#else
    for (int ph = 0; ph < NPHASE; ++ph) {
        a.ph_lo = ph; a.ph_hi = ph + 1;
        hipLaunchKernelGGL(mk_fwd, dim3(grid), dim3(512), LDS_BYTES, stream, a);
    }
#endif
}
```

```cpp
#include <hip/hip_runtime.h>
#include <hip/hip_cooperative_groups.h>
#include <cstdint>
#include <cstdio>
namespace cg = cooperative_groups;

#ifndef MK_ONE_LAUNCH
#define MK_ONE_LAUNCH 1
#endif

#define LAS __attribute__((address_space(3)))
typedef unsigned short bf16_t;
typedef short bf16x8 __attribute__((ext_vector_type(8)));
typedef float f32x4 __attribute__((ext_vector_type(4)));
typedef float f32x2 __attribute__((ext_vector_type(2)));
typedef unsigned u32x4 __attribute__((ext_vector_type(4)));
typedef unsigned u32x2 __attribute__((ext_vector_type(2)));

constexpr int M_TOK = 65536, DM = 1024, NIN = 4608, FF = 2816, NMEM = 4096, SEQ = 4096;
constexpr float EPS = 1e-6f;
constexpr int NPHASE = 17;
constexpr size_t MiB = 1u << 20;
constexpr size_t WS_WIN = 1 * MiB, WS_WBR = 10 * MiB, WS_WMIX = 13 * MiB, WS_WGLU = 15 * MiB, WS_WQ = 16 * MiB, WS_WKV = 18 * MiB  , WS_WO = 23 * MiB,
                 WS_WGU = 25 * MiB, WS_WDN = 36 * MiB, WS_WSP = 42 * MiB, WS_A64 = 42 * MiB + 256 * 1024, WS_RS1 = 42 * MiB + 320 * 1024  , WS_RS2 = 42 * MiB + 576 * 1024  , WS_KB = 43 * MiB, WS_VB = 51 * MiB  ;
constexpr size_t WS_SA = 59 * MiB, WS_SB = 187 * MiB, WS_SC = 315 * MiB, WS_SD = 443 * MiB;
constexpr size_t WS_ACT = 571 * MiB;
constexpr size_t WS_BT1 = 571 * MiB  , WS_BT2 = 581 * MiB, WS_EBUF = 653 * MiB, WS_MEMN = 669 * MiB  , WS_UC = 678 * MiB,
                 WS_U = 750 * MiB  , WS_V = 878 * MiB, WS_S5T = 1006 * MiB  , WS_END = 1010 * MiB;
constexpr size_t WS_X1B = WS_SB, WS_X2B = WS_SA;
constexpr size_t WS_MB = 942 * MiB, WS_NB = 974 * MiB;
constexpr int KTS = 257;
constexpr int S5T_BYTES = 49664 + 64 * KTS * 4;
constexpr int LDS_RING = 131072, LDS_XS = 131072, LDS_BYTES = 147456;

typedef __bf16 bf16v2 __attribute__((ext_vector_type(2)));
__device__ __forceinline__ unsigned cvt_pk_bf16(float lo, float hi) { const f32x2 f = {lo, hi}; const bf16v2 v = __builtin_convertvector(f, bf16v2); return __builtin_bit_cast(unsigned, v); }
__device__ __forceinline__ float bf_lo(unsigned w) { return __uint_as_float(w << 16); }
__device__ __forceinline__ float bf_hi(unsigned w) { return __uint_as_float(w & 0xffff0000u); }
__device__ __forceinline__ float fsigmoid(float x) { return __builtin_amdgcn_rcpf(1.f + __builtin_amdgcn_exp2f(-1.4426950408889634f * x)); }
__device__ __forceinline__ float gelu_t(float x) { const float y = 1.5957691216057308f * (x + 0.044715f * x * x * x); return x * fsigmoid(y); }
__device__ __forceinline__ float shx(float v, int lane, int o) { return __int_as_float(__builtin_amdgcn_ds_bpermute((lane ^ o) << 2, __float_as_int(v))); }
__device__ __forceinline__ float wave_sum(float v, int lane) {
#pragma unroll
    for (int o = 1; o < 64; o <<= 1) v += shx(v, lane, o);
    return v;
}
__device__ __forceinline__ void unpack8(const u32x4 w, float (&v)[8]) {
    v[0] = bf_lo(w.x); v[1] = bf_hi(w.x); v[2] = bf_lo(w.y); v[3] = bf_hi(w.y); v[4] = bf_lo(w.z); v[5] = bf_hi(w.z); v[6] = bf_lo(w.w); v[7] = bf_hi(w.w);
}
__device__ __forceinline__ u32x4 pack8(const float (&v)[8]) {
    u32x4 w; w.x = cvt_pk_bf16(v[0], v[1]); w.y = cvt_pk_bf16(v[2], v[3]); w.z = cvt_pk_bf16(v[4], v[5]); w.w = cvt_pk_bf16(v[6], v[7]); return w;
}

namespace pg8 {
constexpr int BM = 256, BK = 64, HALF = 128, HTB = HALF * BK * 2, NXCD = 8, WGM = 8;
__host__ __device__ __forceinline__ int lds_byte(int r, int c) { const int st = (r >> 4) * 2 + (c >> 5), rr = r & 15, cc = c & 31, ob = rr * 64 + cc * 2; return st * 1024 + (ob ^ (((ob >> 9) & 1) << 5)); }
__host__ __device__ __forceinline__ void stage_rc(int b, int& R, int& C) { const int st = b / 1024, sb = b % 1024, swz = sb ^ (((sb >> 9) & 1) << 5); R = (st >> 1) * 16 + swz / 64; C = (st & 1) * 32 + (swz % 64) / 2; }
__host__ __device__ __forceinline__ int perm32(int rho) { const int n = rho >> 4, i = rho & 15; return 8 * (i >> 2) + 4 * n + (i & 3); }

enum Kind { K_IN = 0, K_KVPROJ, K_MB, K_NB, K_S5E, K_S5Y, K_GLU, K_BR, K_MIX, K_SMAX, K_OPROJ, K_GU, K_DOWN };

struct Unit { const char* A; const char* B; int lda, cha, ldb, nt, pn, kind, orow, ocol; };
struct Desc {
    const char* A; const char* B; int lda, cha, ldb, nt, nM, nN, nZ0; long zsA0, zsA1, zsB0, zsB1; int kind, orz0, orz1, ocz0;
    __device__ __forceinline__ void fill(int w, Unit& u) const {
        const int per = nM * nN, z = w / per, r = w % per;
        const int nig = WGM * nN, gid = r / nig, fm = gid * WGM, gsz = (nM - fm) < WGM ? (nM - fm) : WGM;
        const int pm = fm + ((r % nig) % gsz), pn = (r % nig) / gsz;
        const int z0 = z % nZ0, z1 = z / nZ0;
        fill_pz(pm, pn, z0, z1, u);
    }
    __device__ __forceinline__ void fill_pz(int pm, int pn, int z0, int z1, Unit& u) const {
        u.pn = pn;
        u.A = A + z0 * zsA0 + z1 * zsA1 + (long)pm * BM * lda * 2;
        u.B = B + z0 * zsB0 + z1 * zsB1 + (long)pn * BM * ldb * 2;
        u.lda = lda; u.cha = cha; u.ldb = ldb; u.nt = nt; u.kind = kind;
        u.orow = pm * BM + z0 * orz0 + z1 * orz1; u.ocol = pn * BM + z0 * ocz0;
    }
};
__device__ __forceinline__ Desc mk_desc(const void* A, const void* B, int lda, int ldb, int K, int Mrows, int Ncols, int kind) {
    Desc d; d.A = (const char*)A; d.B = (const char*)B; d.lda = lda; d.cha = 16; d.ldb = ldb; d.nt = K / BK; d.nM = Mrows / BM; d.nN = Ncols / BM; d.nZ0 = 1;
    d.zsA0 = d.zsA1 = d.zsB0 = d.zsB1 = 0; d.kind = kind; d.orz0 = d.orz1 = d.ocz0 = 0; return d;
}
__device__ __forceinline__ Desc phase_desc(int ph, int sub, unsigned char* ws) {
    Desc d;
    if (ph == 1) { d = mk_desc(ws + WS_SA, ws + WS_WIN, 1024, 1024, 1024, M_TOK, NIN, K_IN);
    } else if (ph == 2) {
        if (sub == 0) { d = mk_desc(ws + WS_UC, ws + WS_BT1, 1152, 1152, 1024, 1024, 256, K_S5E); d.nZ0 = 32; d.zsA0 = 1024L * 1152 * 2; d.zsB0 = 128L * 1152 * 2; d.orz0 = 1024; }
        else d = mk_desc(ws + WS_MEMN, ws + WS_WKV, 1152, 1152, 1024, NMEM, 2048, K_KVPROJ);
    } else if (ph == 3) {
        if (sub == 0) { d = mk_desc(ws + WS_KB, ws + WS_WQ, 1024, 1024, 256, 256, 1024, K_MB); d.nZ0 = 4; d.zsA0 = 256 * 2; d.zsA1 = 256L * 1024 * 2; d.zsB0 = 256 * 2; d.orz0 = 256; d.orz1 = 1024; }
        else { d = mk_desc(ws + WS_WO, ws + WS_VB, 1024, 1024, 256, 1024, 256, K_NB); d.nZ0 = 4; d.zsA0 = 256 * 2; d.zsB0 = 256 * 2; d.zsB1 = 256L * 1024 * 2; d.orz1 = 1024; d.ocz0 = 256; }
    } else if (ph == 4) { d = mk_desc(ws + WS_UC, ws + WS_BT2, 1152, 1152, 1152, 1024, 1024, K_S5Y); d.nZ0 = 32; d.zsA0 = 1024L * 1152 * 2; d.zsB0 = 1024L * 1152 * 2; d.orz0 = 1024;
    } else if (ph == 5) { d = mk_desc(ws + WS_U, ws + WS_WGLU, 16, 512, 512, M_TOK, 512, K_GLU); d.cha = M_TOK * 16;
    } else if (ph == 6) { d = mk_desc(ws + WS_SA, ws + WS_WBR, 1024, 1536, 1536, M_TOK, 1024, K_BR);
    } else if (ph == 7) { d = mk_desc(ws + WS_SC, ws + WS_WMIX, 1024, 1024, 1024, M_TOK, 1024, K_MIX);
    } else if (ph == 9) {
        d = mk_desc(ws + WS_SB, ws + WS_MB, 1024, 1024, 1024, SEQ, 1024, K_SMAX); d.zsA1 = (long)SEQ * 1024 * 2; d.zsB1 = 1024L * 1024 * 2; d.orz1 = SEQ;
    } else if (ph == 10) {
        d = mk_desc(ws + WS_SC, ws + WS_NB, 1024, 1024, 1024, SEQ, 1024, K_OPROJ); d.zsA1 = (long)SEQ * 1024 * 2; d.zsB1 = 1024L * 1024 * 2; d.orz1 = SEQ;
    } else if (ph == 14) { d = mk_desc(ws + WS_SA, ws + WS_WGU, 1024, 1024, 1024, M_TOK, 2 * FF, K_GU);
    } else { d = mk_desc(ws + WS_ACT, ws + WS_WDN, FF, FF, FF, M_TOK, 1024, K_DOWN); }
    return d;
}
__device__ __forceinline__ int phase_units(int ph, int sub) {
    switch (ph) {
        case 1: return (M_TOK / BM) * (NIN / BM);
        case 2: return sub == 0 ? 32 * 4 : (sub == 1 ? 128 : 0);
        case 3: return sub < 2 ? 256 : 0;
        case 4: return 32 * 16;
        case 5: return (M_TOK / BM) * 2;
        case 14: return (M_TOK / BM) * (2 * FF / BM);
        default: return (M_TOK / BM) * 4;
    }
}
struct Sched {
    unsigned char* ws; int ph, n0, n1, total, G, c, panel;
    __device__ __forceinline__ bool next(int i, Unit& u) const {
        if (panel >= 0) {
            if (i >= total) return false;
            const Desc d = phase_desc(ph, 0, ws);
            if (ph == 9 || ph == 10) d.fill_pz(panel & 15, i, 0, panel >> 4, u); else d.fill_pz(panel, i, 0, 0, u);
            return true;
        }
        const long L = (long)i * G + c; if (L >= total) return false;
        int wgid = (int)L; { const int q = total / NXCD, r = total % NXCD, xcd = wgid % NXCD, off = wgid / NXCD; wgid = (xcd < r ? xcd * (q + 1) : r * (q + 1) + (xcd - r) * q) + off; }
        int sub = 0; if (wgid >= n0) { sub = 1; wgid -= n0; if (wgid >= n1) { sub = 2; wgid -= n1; } }
        const Desc d = phase_desc(ph, sub, ws); d.fill(wgid, u);
        return true;
    }
};
struct Drv { unsigned vA0, vA1, vB0, vB1, kA, hA, hB; };
__device__ __forceinline__ Drv derive(const Unit& u, int tid) {
    int R0, C0, R1, C1; stage_rc(tid * 16, R0, C0); stage_rc(tid * 16 + 8192, R1, C1);
    const int Rb0 = (R0 & ~31) + perm32(R0 & 31), Rb1 = (R1 & ~31) + perm32(R1 & 31);
    Drv d;
    d.vA0 = (unsigned)(R0 * u.lda + (C0 >> 4) * u.cha + (C0 & 15)) * 2u; d.vA1 = (unsigned)(R1 * u.lda + (C1 >> 4) * u.cha + (C1 & 15)) * 2u;
    d.vB0 = (unsigned)(Rb0 * u.ldb + C0) * 2u; d.vB1 = (unsigned)(Rb1 * u.ldb + C1) * 2u;
    d.kA = (unsigned)(8 * u.cha); d.hA = (unsigned)(HALF * 2 * u.lda); d.hB = (unsigned)(HALF * 2 * u.ldb);
    return d;
}

struct Epi {
    unsigned char* ws; LAS unsigned char* lds;
    __device__ __forceinline__ void get8(const f32x4 (&acc)[2][2][4][2], int ai, int bj, int m, float (&v)[8]) const {
        const f32x4 a = acc[ai][bj][m][0], b = acc[ai][bj][m][1];
        v[0] = a[0]; v[1] = a[1]; v[2] = a[2]; v[3] = a[3]; v[4] = b[0]; v[5] = b[1]; v[6] = b[2]; v[7] = b[3];
    }
    __device__ __forceinline__ void mid(f32x4 (&acc)[2][2][4][2], const Unit& u, int wr, int wc, int fr, int fq) const {
        const bf16_t* GA = (const bf16_t*)(ws + WS_SC); const bf16_t* GB = (const bf16_t*)(ws + WS_SD);
        int rb = u.orow + wr * 64 + fr; asm volatile("" : "+v"(rb));
        int cb = u.ocol + wc * 32 + 8 * fq; asm volatile("" : "+v"(cb));
#pragma unroll
        for (int ai = 0; ai < 2; ++ai) {
            u32x4 ga[4][2], gb[4][2];
#pragma unroll
            for (int m = 0; m < 4; ++m)
#pragma unroll
                for (int bj = 0; bj < 2; ++bj) { const size_t o = (size_t)(rb + ai * HALF + m * 16) * DM + cb + bj * HALF; ga[m][bj] = *(const u32x4*)(GA + o); gb[m][bj] = *(const u32x4*)(GB + o); }
#pragma unroll
            for (int m = 0; m < 4; ++m)
#pragma unroll
                for (int bj = 0; bj < 2; ++bj) {
                    float a[8], b[8]; unpack8(ga[m][bj], a); unpack8(gb[m][bj], b);
#pragma unroll
                    for (int j = 0; j < 8; ++j) { const float r = a[j] * __builtin_amdgcn_rcpf(fmaxf(b[j], 1e-30f)); asm volatile("v_mul_f32 %0, %0, %1" : "+v"(acc[ai][bj][m][j >> 2][j & 3]) : "v"(r)); }
                }
            asm volatile("" ::: "memory");
        }
    }
    __device__ __forceinline__ void operator()(const f32x4 (&acc)[2][2][4][2], const Unit& u, int wr, int wc, int fr, int fq) const {
        const int kind = u.kind;
        if (kind == K_SMAX) {
            LAS f32x2* XS = (LAS f32x2*)(lds + LDS_XS);
            int rls = wr * 64 + fr; asm volatile("" : "+v"(rls));
            bf16_t* P = (bf16_t*)(ws + WS_SC); const float* RS = (const float*)(ws + WS_RS1);
            int rbs = u.orow + wr * 64 + fr; asm volatile("" : "+v"(rbs));
            float rsv[2][4];
#pragma unroll
            for (int ai = 0; ai < 2; ++ai)
#pragma unroll
                for (int m = 0; m < 4; ++m) rsv[ai][m] = RS[rbs + ai * HALF + m * 16] * 1.4426950408889634f;
#pragma unroll
            for (int ai = 0; ai < 2; ++ai)
#pragma unroll
                for (int m = 0; m < 4; ++m) {
                    const float rs = rsv[ai][m];
                    float mx = -3.0e38f;
#pragma unroll
                    for (int bj = 0; bj < 2; ++bj)
#pragma unroll
                        for (int n = 0; n < 2; ++n)
#pragma unroll
                            for (int j = 0; j < 4; ++j) mx = fmaxf(mx, acc[ai][bj][m][n][j]);
                    mx = fmaxf(mx, shx(mx, fr + 16 * fq, 16)); mx = fmaxf(mx, shx(mx, fr + 16 * fq, 32));
                    float s = 0.f;
#pragma unroll
                    for (int bj = 0; bj < 2; ++bj)
#pragma unroll
                        for (int n = 0; n < 2; ++n)
#pragma unroll
                            for (int j = 0; j < 4; ++j) s += __builtin_amdgcn_exp2f((acc[ai][bj][m][n][j] - mx) * rs);
                    s += shx(s, fr + 16 * fq, 16); s += shx(s, fr + 16 * fq, 32);
                    if (fq == 0) XS[(rls + ai * HALF + m * 16) * 4 + wc] = (f32x2){mx * rs, s};
                }
            asm volatile("s_waitcnt lgkmcnt(0)" ::: "memory"); __builtin_amdgcn_s_barrier(); asm volatile("" ::: "memory");
#pragma unroll
            for (int ai = 0; ai < 2; ++ai)
#pragma unroll
                for (int m = 0; m < 4; ++m) {
                    const int rl = rls + ai * HALF + m * 16;
                    const f32x2 p0 = XS[rl * 4 + 0], p1 = XS[rl * 4 + 1], p2 = XS[rl * 4 + 2], p3 = XS[rl * 4 + 3];
                    const f32x2 me = XS[rl * 4 + wc];
                    const float MX = fmaxf(fmaxf(p0.x, p1.x), fmaxf(p2.x, p3.x));
                    const float L = p0.y * __builtin_amdgcn_exp2f(p0.x - MX) + p1.y * __builtin_amdgcn_exp2f(p1.x - MX) + p2.y * __builtin_amdgcn_exp2f(p2.x - MX) + p3.y * __builtin_amdgcn_exp2f(p3.x - MX);
                    const float f = 1.0f / L; (void)me;
                    const size_t row = (size_t)(u.orow + rl);
                    const float rs = rsv[ai][m];
#pragma unroll
                    for (int bj = 0; bj < 2; ++bj) {
                        float v[8]; get8(acc, ai, bj, m, v);
#pragma unroll
                        for (int j = 0; j < 8; ++j) v[j] = __builtin_amdgcn_exp2f(v[j] * rs - MX) * f;
                        *(u32x4*)(P + row * DM + u.ocol + bj * HALF + wc * 32 + 8 * fq) = pack8(v);
                    }
                }
            asm volatile("s_waitcnt lgkmcnt(0)" ::: "memory"); __builtin_amdgcn_s_barrier(); asm volatile("" ::: "memory");
            return;
        }
        if (kind == K_GU) {
            bf16_t* ACT = (bf16_t*)(ws + WS_ACT);
            int rb = u.orow + wr * 64 + fr; asm volatile("" : "+v"(rb));
            float rsv[2][4];
#pragma unroll
            for (int ai = 0; ai < 2; ++ai)
#pragma unroll
                for (int m = 0; m < 4; ++m) rsv[ai][m] = ((const float*)(ws + WS_RS2))[rb + ai * HALF + m * 16];
#pragma unroll
            for (int ai = 0; ai < 2; ++ai)
#pragma unroll
                for (int m = 0; m < 4; ++m) {
                    const size_t row = (size_t)(rb + ai * HALF + m * 16);
                    const float rs = rsv[ai][m];
                    float g[8], w[8]; get8(acc, ai, 0, m, g); get8(acc, ai, 1, m, w);
#pragma unroll
                    for (int j = 0; j < 8; ++j) { const float gg = g[j] * rs; g[j] = gg * fsigmoid(gg) * (w[j] * rs); }
                    *(u32x4*)(ACT + row * FF + u.pn * HALF + wc * 32 + 8 * fq) = pack8(g);
                }
            return;
        }
        if (kind == K_S5E) {
            float* E = (float*)(ws + WS_EBUF);
            int rb = u.orow + wr * 64 + fr; asm volatile("" : "+v"(rb));
            int cb = wc * 32 + 8 * fq; asm volatile("" : "+v"(cb));
#pragma unroll
            for (int ai = 0; ai < 2; ++ai)
#pragma unroll
                for (int m = 0; m < 4; ++m) {
                    const size_t row = (size_t)(rb + ai * HALF + m * 16);
                    float* p = E + row * 128 + cb;
                    *(f32x4*)p = acc[ai][0][m][0]; *(f32x4*)(p + 4) = acc[ai][0][m][1];
                }
            return;
        }
        if (kind == K_IN) {
            const int pn = u.pn;
            if (pn < 8) tiles<1>(acc, u.orow, wr, wc, fr, fq, (bf16_t*)(ws + (pn < 4 ? WS_U : WS_V)), DM, (pn & 3) * BM, nullptr);
            else if (pn < 10) tiles<3>(acc, u.orow, wr, wc, fr, fq, (bf16_t*)(ws + WS_UC), 0, (pn - 8) * BM, nullptr);
            else tiles<2>(acc, u.orow, wr, wc, fr, fq, (bf16_t*)(ws + (pn < 14 ? WS_SC : WS_SD)), DM, ((pn - 10) & 3) * BM, nullptr);
        } else if (kind == K_KVPROJ) tiles<0>(acc, u.orow, wr, wc, fr, fq, (bf16_t*)(ws + (u.pn < 4 ? WS_KB : WS_VB)), DM, (u.pn & 3) * BM, nullptr);
        else if (kind == K_MB) tiles<6>(acc, u.orow, wr, wc, fr, fq, (bf16_t*)(ws + WS_MB), DM, u.ocol, nullptr);
        else if (kind == K_NB) tiles<0>(acc, u.orow, wr, wc, fr, fq, (bf16_t*)(ws + WS_NB), DM, u.ocol, nullptr);
        else if (kind == K_S5Y) tiles<1>(acc, u.orow, wr, wc, fr, fq, (bf16_t*)(ws + WS_U), 1024, u.ocol, nullptr);
        else if (kind == K_GLU) tiles<4>(acc, u.orow, wr, wc, fr, fq, (bf16_t*)(ws + WS_SB), DM, u.ocol, (const bf16_t*)(ws + WS_U));
        else if (kind == K_BR) tiles<5>(acc, u.orow, wr, wc, fr, fq, (bf16_t*)(ws + WS_SC), DM, u.ocol, (const bf16_t*)(ws + WS_SD));
        else if (kind == K_MIX) tiles<0>(acc, u.orow, wr, wc, fr, fq, (bf16_t*)(ws + WS_SA), DM, u.ocol, nullptr);
        else if (kind == K_OPROJ) tiles<0>(acc, u.orow, wr, wc, fr, fq, (bf16_t*)(ws + WS_SD), DM, u.ocol, nullptr);
        else tiles<0>(acc, u.orow, wr, wc, fr, fq, (bf16_t*)(ws + WS_SC), DM, u.ocol, nullptr);
    }
    template <int MODE>
    __device__ __forceinline__ void tiles(const f32x4 (&acc)[2][2][4][2], int orow, int wr, int wc, int fr, int fq, bf16_t* base, int ld, int colbase, const bf16_t* aux) const {
        int rb = orow + wr * 64 + fr; asm volatile("" : "+v"(rb));
        int cb = colbase + wc * 32 + 8 * fq; asm volatile("" : "+v"(cb));
#pragma unroll
        for (int ai = 0; ai < 2; ++ai) {
            u32x4 ax[4][2];
            if (MODE == 4 || MODE == 5) {
#pragma unroll
                for (int m = 0; m < 4; ++m)
#pragma unroll
                    for (int bj = 0; bj < 2; ++bj) {
                        const size_t row = (size_t)(rb + ai * HALF + m * 16); const int col = cb + bj * HALF;
                        if (MODE == 4) ax[m][bj] = *(const u32x4*)(aux + ((size_t)(col >> 4) * M_TOK + row) * 16 + (col & 15));
                        else ax[m][bj] = *(const u32x4*)(aux + row * DM + col);
                    }
            }
#pragma unroll
            for (int m = 0; m < 4; ++m) {
                const int rowi = rb + ai * HALF + m * 16; const size_t row = (size_t)rowi;
#pragma unroll
                for (int bj = 0; bj < 2; ++bj) {
                    const int col = cb + bj * HALF;
                    float v[8]; get8(acc, ai, bj, m, v);
                    bf16_t* dst = base + row * ld + col;
                    if (MODE == 1) {
#pragma unroll
                        for (int j = 0; j < 8; ++j) v[j] = gelu_t(v[j]);
                    } else if (MODE == 2) {
#pragma unroll
                        for (int j = 0; j < 8; ++j) v[j] = fsigmoid(v[j]);
                    } else if (MODE == 3) {
                        const int g = col >> 4, h0 = col & 15;
                        dst = base + ((size_t)(g * 1024 + (rowi >> 6))) * 1152 + (rowi & 63) * 16 + h0;
                    } else if (MODE == 4) {
                        float y[8]; unpack8(ax[m][bj], y);
#pragma unroll
                        for (int j = 0; j < 8; ++j) v[j] = y[j] * fsigmoid(v[j]);
                    } else if (MODE == 5) {
                        float b[8]; unpack8(ax[m][bj], b);
#pragma unroll
                        for (int j = 0; j < 8; ++j) v[j] *= b[j];
                    } else if (MODE == 6) {
#pragma unroll
                        for (int j = 0; j < 8; ++j) v[j] *= 0.0625f;
                    }
                    *(u32x4*)dst = pack8(v);
                }
                if (MODE != 4 && MODE != 5) asm volatile("" ::: "memory");
            }
            asm volatile("" ::: "memory");
        }
    }
};

__device__ __forceinline__ void gemm_phase(LAS unsigned char* lds, const Sched& S, const Epi& E, const int tid) {
    const int wid = __builtin_amdgcn_readfirstlane(tid >> 6), lane = tid & 63, wr = wid >> 2, wc = wid & 3, fr = lane & 15, fq = lane >> 4;
    const unsigned ldsw = (unsigned)wid * 1024u;
    const int aoff = lds_byte(wr * 64 + fr, fq * 8), boff = lds_byte(wc * 32 + fr, fq * 8);
#define PG8_SA(b, h) (((b) * 2 + (h)) * HTB)
#define PG8_SB(b, h) ((4 + (b) * 2 + (h)) * HTB)
#define PG8_STAGE(bufoff, gbase, v0, v1) do { \
        __builtin_amdgcn_global_load_lds((const unsigned*)((const char*)(gbase) + (v0)), (LAS unsigned*)(lds + (bufoff) + ldsw), 16, 0, 0); \
        __builtin_amdgcn_global_load_lds((const unsigned*)((const char*)(gbase) + (v1)), (LAS unsigned*)(lds + (bufoff) + ldsw + 8192), 16, 0, 0); } while (0)
#define PG8_LDA(dst, b, h) do { _Pragma("unroll") for (int m = 0; m < 4; ++m) _Pragma("unroll") for (int k = 0; k < 2; ++k) dst[m][k] = *(const LAS bf16x8*)(lds + PG8_SA(b, h) + aoff + m * 2048 + k * 1024); } while (0)
#define PG8_LDB(dst, b, h) do { _Pragma("unroll") for (int n = 0; n < 2; ++n) _Pragma("unroll") for (int k = 0; k < 2; ++k) dst[n][k] = *(const LAS bf16x8*)(lds + PG8_SB(b, h) + boff + n * 2048 + k * 1024); } while (0)
#define PG8_MMA(ai, bj, At, Bt) do { __builtin_amdgcn_s_setprio(1); _Pragma("unroll") for (int m = 0; m < 4; ++m) _Pragma("unroll") for (int n = 0; n < 2; ++n) _Pragma("unroll") for (int k = 0; k < 2; ++k) \
        acc[ai][bj][m][n] = __builtin_amdgcn_mfma_f32_16x16x32_bf16(Bt[n][k], At[m][k], acc[ai][bj][m][n], 0, 0, 0); __builtin_amdgcn_s_setprio(0); } while (0)
#define PG8_WAIT_V(n) asm volatile("s_waitcnt vmcnt(" #n ")" ::: "memory")
#define PG8_WAIT_L(n) asm volatile("s_waitcnt lgkmcnt(" #n ")" ::: "memory")
#define PG8_BAR __builtin_amdgcn_s_barrier()
#define PG8_SCHED __builtin_amdgcn_sched_barrier(0)
    Unit cur, nxt; int ui = 0;
    if (!S.next(0, cur)) return;
    nxt = cur;
    f32x4 acc[2][2][4][2];
#pragma unroll
    for (int a = 0; a < 2; ++a)
#pragma unroll
        for (int b = 0; b < 2; ++b)
#pragma unroll
            for (int m = 0; m < 4; ++m)
#pragma unroll
                for (int n = 0; n < 2; ++n) acc[a][b][m][n] = (f32x4){0.f, 0.f, 0.f, 0.f};
    bf16x8 At[4][2], B0[2][2], B1[2][2];
    const Drv dc = derive(cur, tid);
    const char* cA = cur.A; const char* cB = cur.B;
    PG8_STAGE(PG8_SB(0, 0), cB, dc.vB0, dc.vB1); PG8_STAGE(PG8_SB(0, 1), cB + dc.hB, dc.vB0, dc.vB1); PG8_STAGE(PG8_SA(0, 0), cA, dc.vA0, dc.vA1); PG8_STAGE(PG8_SA(0, 1), cA + dc.hA, dc.vA0, dc.vA1);
    if (wr == 1) PG8_BAR;
    PG8_WAIT_V(2); PG8_BAR;
    PG8_STAGE(PG8_SB(1, 0), cB + 128, dc.vB0, dc.vB1); PG8_STAGE(PG8_SA(1, 0), cA + dc.kA, dc.vA0, dc.vA1); PG8_STAGE(PG8_SB(1, 1), cB + dc.hB + 128, dc.vB0, dc.vB1);
    PG8_WAIT_V(6); PG8_BAR;
    for (;;) {
        const bool has_next = S.next(ui + 1, nxt);
        const char* nA = cA; const char* nB = cB;
        if (has_next) { nA = nxt.A; nB = nxt.B; }
        const int nt = cur.nt;
        for (int t = 0; t < nt; t += 2) {
            const bool last = (t == nt - 2);
            if (cur.kind == K_BR && t == 16) E.mid(acc, cur, wr, wc, fr, fq);
            const size_t aj = (cur.kind == K_BR) ? (size_t)(WS_SB - WS_SA) - 16 * 128 : 0;
            const char* a1 = cA + (size_t)(t + 1) * dc.kA + (t >= 16 ? aj : 0);
            const char* a2 = last ? nA : cA + (size_t)(t + 2) * dc.kA + (t >= 14 ? aj : 0); const char* b2 = last ? nB : cB + (size_t)(t + 2) * 128;
            const unsigned xA0 = dc.vA0, xA1 = dc.vA1, xB0 = dc.vB0, xB1 = dc.vB1, xk = dc.kA, xhA = dc.hA, xhB = dc.hB;
            const char* a3 = a2 + xk; const char* b3 = b2 + 128;
            PG8_LDB(B0, 0, 0); PG8_LDB(B1, 0, 1); PG8_SCHED; PG8_LDA(At, 0, 0); PG8_STAGE(PG8_SA(1, 1), a1 + dc.hA, dc.vA0, dc.vA1);
            PG8_WAIT_V(8); PG8_WAIT_L(0); PG8_BAR; PG8_MMA(0, 0, At, B0); PG8_MMA(0, 1, At, B1); PG8_BAR; PG8_SCHED;
            PG8_LDA(At, 0, 1); PG8_STAGE(PG8_SB(0, 0), b2, xB0, xB1); PG8_STAGE(PG8_SB(0, 1), b2 + xhB, xB0, xB1); PG8_STAGE(PG8_SA(0, 0), a2, xA0, xA1);
            PG8_WAIT_V(8); PG8_WAIT_L(0); PG8_BAR; PG8_MMA(1, 0, At, B0); PG8_MMA(1, 1, At, B1); PG8_BAR; PG8_SCHED;
            PG8_LDB(B0, 1, 0); PG8_LDB(B1, 1, 1); PG8_SCHED; PG8_LDA(At, 1, 0); PG8_STAGE(PG8_SA(0, 1), a2 + xhA, xA0, xA1);
            PG8_WAIT_V(8); PG8_WAIT_L(0); PG8_BAR; PG8_MMA(0, 0, At, B0); PG8_MMA(0, 1, At, B1); PG8_BAR; PG8_SCHED;
            PG8_LDA(At, 1, 1); PG8_STAGE(PG8_SB(1, 0), b3, xB0, xB1); PG8_STAGE(PG8_SB(1, 1), b3 + xhB, xB0, xB1); PG8_STAGE(PG8_SA(1, 0), a3, xA0, xA1);
            PG8_WAIT_V(8); PG8_WAIT_L(0); PG8_BAR; PG8_MMA(1, 0, At, B0); PG8_MMA(1, 1, At, B1); PG8_BAR; PG8_SCHED;
        }
        if (wr == 0) PG8_BAR;
        E(acc, cur, wr, wc, fr, fq);
        if (!has_next) break;
#pragma unroll
        for (int a = 0; a < 2; ++a)
#pragma unroll
            for (int b = 0; b < 2; ++b)
#pragma unroll
                for (int m = 0; m < 4; ++m)
#pragma unroll
                    for (int n = 0; n < 2; ++n) acc[a][b][m][n] = (f32x4){0.f, 0.f, 0.f, 0.f};
        cur = nxt; cA = nA; cB = nB; ++ui;
        if (wr == 1) PG8_BAR;
    }
    PG8_WAIT_V(0);
    PG8_BAR;
#undef PG8_SA
#undef PG8_SB
#undef PG8_STAGE
#undef PG8_LDA
#undef PG8_LDB
#undef PG8_MMA
#undef PG8_WAIT_V
#undef PG8_WAIT_L
#undef PG8_BAR
#undef PG8_SCHED
}
}

__device__ __forceinline__ void transpose_item(const float* W, int N, bf16_t* WT, int ldt, int col_off, int rmode, LAS float* scr, int item, int lane, const float* kscale = nullptr) {
    const int nblk = N / 32, kb = item / nblk, nb = item % nblk, k0 = 64 * kb, n0 = 32 * nb;
    f32x4 wv[8];
#pragma unroll
    for (int i = 0; i < 8; ++i) { wv[i] = *(const f32x4*)(W + (size_t)(k0 + 8 * i + (lane >> 3)) * N + n0 + 4 * (lane & 7)); if (kscale) wv[i] = wv[i] * kscale[k0 + 8 * i + (lane >> 3)]; }
#pragma unroll
    for (int i = 0; i < 8; ++i) { LAS float* d = scr + (8 * i + (lane >> 3)) * 33 + 4 * (lane & 7); d[0] = wv[i][0]; d[1] = wv[i][1]; d[2] = wv[i][2]; d[3] = wv[i][3]; }
    asm volatile("s_waitcnt lgkmcnt(0)" ::: "memory");
    int r0 = n0;
    if (rmode == 1) { const int isu = n0 >= FF, nn = isu ? n0 - FF : n0; r0 = 256 * (nn >> 7) + (nn & 127) + (isu ? 128 : 0); }
    const int c = lane & 7;
#pragma unroll
    for (int j = 0; j < 4; ++j) { const int n = (lane >> 3) + 8 * j; const LAS float* s = scr + (8 * c) * 33 + n;
        u32x4 o; o.x = cvt_pk_bf16(s[0 * 33], s[1 * 33]); o.y = cvt_pk_bf16(s[2 * 33], s[3 * 33]); o.z = cvt_pk_bf16(s[4 * 33], s[5 * 33]); o.w = cvt_pk_bf16(s[6 * 33], s[7 * 33]);
        *(u32x4*)(WT + (size_t)(r0 + n) * ldt + col_off + k0 + 8 * c) = o; }
    asm volatile("s_waitcnt lgkmcnt(0)" ::: "memory");
}
template <int R>
__device__ __forceinline__ void rms_rows_to_bf16(const float* x0, size_t xstride, const float* g, bf16_t* o0, size_t ostride, int lane) {
    f32x4 v[R][4]; float s[R];
#pragma unroll
    for (int r = 0; r < R; ++r)
#pragma unroll
        for (int j = 0; j < 2; ++j) { v[r][2 * j] = *(const f32x4*)(x0 + r * xstride + 512 * j + 8 * lane); v[r][2 * j + 1] = *(const f32x4*)(x0 + r * xstride + 512 * j + 8 * lane + 4); }
#pragma unroll
    for (int r = 0; r < R; ++r) { s[r] = 0.f;
#pragma unroll
        for (int j = 0; j < 4; ++j) s[r] += (v[r][j][0] * v[r][j][0] + v[r][j][1] * v[r][j][1]) + (v[r][j][2] * v[r][j][2] + v[r][j][3] * v[r][j][3]); }
#pragma unroll
    for (int o = 1; o < 64; o <<= 1)
#pragma unroll
        for (int r = 0; r < R; ++r) s[r] += shx(s[r], lane, o);
    f32x4 gg[4];
#pragma unroll
    for (int j = 0; j < 2; ++j) { gg[2 * j] = *(const f32x4*)(g + 512 * j + 8 * lane); gg[2 * j + 1] = *(const f32x4*)(g + 512 * j + 8 * lane + 4); }
#pragma unroll
    for (int r = 0; r < R; ++r) {
        const float rstd = 1.f / sqrtf(s[r] * (1.f / DM) + EPS);
#pragma unroll
        for (int j = 0; j < 2; ++j) {
            const f32x4 a = v[r][2 * j] * rstd * gg[2 * j], b = v[r][2 * j + 1] * rstd * gg[2 * j + 1];
            u32x4 w; w.x = cvt_pk_bf16(a[0], a[1]); w.y = cvt_pk_bf16(a[2], a[3]); w.z = cvt_pk_bf16(b[0], b[1]); w.w = cvt_pk_bf16(b[2], b[3]);
            *(u32x4*)(o0 + r * ostride + 512 * j + 8 * lane) = w;
        }
    }
}
template <bool XIN_BF, bool XOUT_BF>
__device__ __forceinline__ void rowpass(const bf16_t* m, const float* gpost, const void* xin_, void* xout_, const float* gpre, bf16_t* hout, float* rsout, int gw, int NGW, int lane, int row_end) {
    constexpr int R = 4;
    const float* xin = (const float*)xin_; const bf16_t* xinb = (const bf16_t*)xin_; float* xout = (float*)xout_; bf16_t* xoutb = (bf16_t*)xout_;
    for (int row0 = gw; row0 < row_end; row0 += R * NGW) {
        u32x4 mw[R][2]; f32x4 xv[R][4]; u32x4 xw[R][2];
#pragma unroll
        for (int r = 0; r < R; ++r) { const size_t ro = (size_t)(row0 + r * NGW) * DM;
#pragma unroll
            for (int j = 0; j < 2; ++j) { mw[r][j] = *(const u32x4*)(m + ro + 512 * j + 8 * lane);
                if (XIN_BF) xw[r][j] = *(const u32x4*)(xinb + ro + 512 * j + 8 * lane);
                else { xv[r][2 * j] = *(const f32x4*)(xin + ro + 512 * j + 8 * lane); xv[r][2 * j + 1] = *(const f32x4*)(xin + ro + 512 * j + 8 * lane + 4); } } }
        f32x4 gp[4];
#pragma unroll
        for (int j = 0; j < 2; ++j) { gp[2 * j] = *(const f32x4*)(gpost + 512 * j + 8 * lane); gp[2 * j + 1] = *(const f32x4*)(gpost + 512 * j + 8 * lane + 4); }
        float mv[R][2][8]; float ss[R];
#pragma unroll
        for (int r = 0; r < R; ++r) { ss[r] = 0.f;
#pragma unroll
            for (int j = 0; j < 2; ++j) { unpack8(mw[r][j], mv[r][j]);
#pragma unroll
                for (int i = 0; i < 8; ++i) ss[r] += mv[r][j][i] * mv[r][j][i]; } }
#pragma unroll
        for (int o = 1; o < 64; o <<= 1)
#pragma unroll
            for (int r = 0; r < R; ++r) ss[r] += shx(ss[r], lane, o);
        float x1[R][2][8]; float s2[R];
#pragma unroll
        for (int r = 0; r < R; ++r) {
            const size_t ro = (size_t)(row0 + r * NGW) * DM;
            const float rstd = 1.f / sqrtf(ss[r] * (1.f / DM) + EPS); s2[r] = 0.f;
#pragma unroll
            for (int j = 0; j < 2; ++j) {
                const int c = 512 * j + 8 * lane;
                float xi[8];
                if (XIN_BF) unpack8(xw[r][j], xi);
                else {
#pragma unroll
                    for (int i = 0; i < 4; ++i) { xi[i] = xv[r][2 * j][i]; xi[4 + i] = xv[r][2 * j + 1][i]; }
                }
#pragma unroll
                for (int i = 0; i < 4; ++i) { x1[r][j][i] = xi[i] + mv[r][j][i] * rstd * gp[2 * j][i]; x1[r][j][4 + i] = xi[4 + i] + mv[r][j][4 + i] * rstd * gp[2 * j + 1][i]; }
#pragma unroll
                for (int i = 0; i < 8; ++i) s2[r] += x1[r][j][i] * x1[r][j][i];
                if (XOUT_BF) *(u32x4*)(xoutb + ro + c) = pack8(x1[r][j]);
                else { *(f32x4*)(xout + ro + c) = (f32x4){x1[r][j][0], x1[r][j][1], x1[r][j][2], x1[r][j][3]}; *(f32x4*)(xout + ro + c + 4) = (f32x4){x1[r][j][4], x1[r][j][5], x1[r][j][6], x1[r][j][7]}; }
            }
        }
        if (hout || rsout) {
#pragma unroll
            for (int o = 1; o < 64; o <<= 1)
#pragma unroll
                for (int r = 0; r < R; ++r) s2[r] += shx(s2[r], lane, o);
        }
        if (rsout) {
#pragma unroll
            for (int r = 0; r < R; ++r) if (lane == 0) rsout[row0 + r * NGW] = 1.f / sqrtf(s2[r] * (1.f / DM) + EPS);
        }
        if (hout) {
#pragma unroll
            for (int j = 0; j < 2; ++j) { gp[2 * j] = *(const f32x4*)(gpre + 512 * j + 8 * lane); gp[2 * j + 1] = *(const f32x4*)(gpre + 512 * j + 8 * lane + 4); }
#pragma unroll
            for (int r = 0; r < R; ++r) {
                const size_t ro = (size_t)(row0 + r * NGW) * DM;
                const float r2 = 1.f / sqrtf(s2[r] * (1.f / DM) + EPS);
#pragma unroll
                for (int j = 0; j < 2; ++j) {
                    float h[8];
#pragma unroll
                    for (int i = 0; i < 4; ++i) { h[i] = x1[r][j][i] * r2 * gp[2 * j][i]; h[4 + i] = x1[r][j][4 + i] * r2 * gp[2 * j + 1][i]; }
                    *(u32x4*)(hout + ro + 512 * j + 8 * lane) = pack8(h);
                }
            }
        }
    }
}

__device__ __forceinline__ void s5_build(LAS unsigned char* lds, unsigned char* ws, const float* lam_re, const float* lam_im, const float* log_step, const float* b_re,
                                         const float* b_im, const float* c_re, const float* c_im, const float* dvec, int g, int tid) {
    LAS f32x2* AP = (LAS f32x2*)lds;
    LAS f32x2* BB = (LAS f32x2*)(lds + 33280);
    LAS f32x2* CC = (LAS f32x2*)(lds + 41472);
    LAS float* KT = (LAS float*)(lds + 49664);
    const float step = expf(log_step[g]);
    for (int i = tid; i < 64 * 65; i += 512) {
        const int p = i / 65, tau = i % 65;
        const float lr = lam_re[g * 64 + p], li = lam_im[g * 64 + p];
        const float mag = expf(lr * step * (float)tau);
        const double ang = (double)li * (double)step * (double)tau;
        const double kq = rint(ang * 0.15915494309189535);
        const float r = (float)(ang - kq * 6.283185307179586);
        AP[p * 65 + tau] = (f32x2){mag * cosf(r), mag * sinf(r)};
    }
    for (int i = tid; i < 64 * 16; i += 512) {
        const int p = i >> 4, h = i & 15;
        const float lr = lam_re[g * 64 + p], li = lam_im[g * 64 + p];
        const float x = lr * step, mag = expf(x), em1 = expm1f(x);
        const double ang = (double)li * (double)step; const double kq = rint(ang * 0.15915494309189535);
        const float r = (float)(ang - kq * 6.283185307179586);
        const float sh = sinf(0.5f * r), cm1 = -2.f * sh * sh, sn = sinf(r), cs = 1.f + cm1;
        const float nr = em1 * cs + cm1, ni = mag * sn;
        const float den = lr * lr + li * li;
        const float co_re = (nr * lr + ni * li) / den, co_im = (ni * lr - nr * li) / den;
        const float br = b_re[(g * 64 + p) * 16 + h], bi = b_im[(g * 64 + p) * 16 + h];
        BB[p * 16 + h] = (f32x2){co_re * br - co_im * bi, co_re * bi + co_im * br};
        const int hh = i >> 6, pp = i & 63;
        CC[hh * 64 + pp] = (f32x2){c_re[(g * 16 + hh) * 64 + pp], c_im[(g * 16 + hh) * 64 + pp]};
    }
    __syncthreads();
    for (int it = 0; it < 2; ++it) {
        const int tau = tid & 63, hp = (tid >> 6) + 8 * it;
        float a[16];
#pragma unroll
        for (int h = 0; h < 16; ++h) a[h] = 0.f;
        for (int p = 0; p < 64; ++p) {
            const f32x2 c = CC[hp * 64 + p], ap = AP[p * 65 + tau];
            const float xr = c.x * ap.x - c.y * ap.y, xi = c.x * ap.y + c.y * ap.x;
#pragma unroll
            for (int h = 0; h < 16; ++h) { const f32x2 b = BB[p * 16 + h]; a[h] += xr * b.x - xi * b.y; }
        }
        if (tau == 0) {
#pragma unroll
            for (int h = 0; h < 16; ++h) if (h == hp) a[h] += dvec[g * 16 + hp];
        }
#pragma unroll
        for (int h = 0; h < 16; ++h) KT[tau * KTS + hp * 16 + h] = a[h];
    }
    __syncthreads();
    { const LAS f32x4* src = (const LAS f32x4*)lds; f32x4* dst = (f32x4*)(ws + WS_S5T + (size_t)g * S5T_BYTES);
      for (int i = tid; i < S5T_BYTES / 16; i += 512) dst[i] = src[i]; }
    if (tid < 64) ((f32x2*)(ws + WS_A64))[g * 64 + tid] = AP[tid * 65 + 64];
    __syncthreads();
}
__device__ __forceinline__ void s5_expand(LAS unsigned char* lds, unsigned char* ws, int g, int part, int tid) {
    LAS f32x2* AP = (LAS f32x2*)lds; LAS f32x2* BB = (LAS f32x2*)(lds + 33280); LAS f32x2* CC = (LAS f32x2*)(lds + 41472); LAS float* KT = (LAS float*)(lds + 49664);
    { const f32x4* src = (const f32x4*)(ws + WS_S5T + (size_t)g * S5T_BYTES); LAS f32x4* dst = (LAS f32x4*)lds;
      for (int i = tid; i < S5T_BYTES / 16; i += 512) dst[i] = src[i]; }
    __syncthreads();
    bf16_t* BT2 = (bf16_t*)(ws + WS_BT2) + (size_t)g * 1024 * 1152;
    for (int i = tid; i < 128 * 144; i += 512) {
        const int rl = i / 144, cc = i % 144, t = 8 * part + (rl >> 4), hp = rl & 15;
        float v[8];
        if (cc < 128) {
            const int s = cc >> 1, h0 = (cc & 1) * 8;
            if (s <= t) {
#pragma unroll
                for (int j = 0; j < 8; ++j) v[j] = KT[(t - s) * KTS + hp * 16 + h0 + j];
            } else {
#pragma unroll
                for (int j = 0; j < 8; ++j) v[j] = 0.f;
            }
        } else {
            const int p0 = (cc - 128) * 4;
#pragma unroll
            for (int j = 0; j < 4; ++j) { const f32x2 c = CC[hp * 64 + p0 + j], ap = AP[(p0 + j) * 65 + t + 1];
                v[2 * j] = c.x * ap.x - c.y * ap.y; v[2 * j + 1] = -(c.x * ap.y + c.y * ap.x); }
        }
        *(u32x4*)(BT2 + (size_t)(t * 16 + hp) * 1152 + cc * 8) = pack8(v);
    }
    bf16_t* BT1 = (bf16_t*)(ws + WS_BT1) + (size_t)g * 128 * 1152;
    for (int i = tid; i < 16 * 128; i += 512) {
        const int rl = i >> 7, cc = i & 127, p = 8 * part + (rl >> 1), ri = rl & 1, s = cc >> 1, h0 = (cc & 1) * 8;
        const f32x2 ap = AP[p * 65 + 63 - s];
        float v[8];
#pragma unroll
        for (int j = 0; j < 8; ++j) { const f32x2 b = BB[p * 16 + h0 + j]; v[j] = ri ? (ap.x * b.y + ap.y * b.x) : (ap.x * b.x - ap.y * b.y); }
        *(u32x4*)(BT1 + (size_t)(2 * p + ri) * 1152 + cc * 8) = pack8(v);
    }
    __syncthreads();
}

__device__ __forceinline__ void spatial_phase(LAS unsigned char* lds, unsigned char* ws, const float* ln_g, const float* ln_b, const float* b_s, int vcu, int G, const int tid) {
    __syncthreads();
    const int wid = __builtin_amdgcn_readfirstlane(tid >> 6), lane = tid & 63, fr = lane & 15, fq = lane >> 4;
    LAS f32x2* ST = (LAS f32x2*)lds;
    LAS bf16_t* VT = (LAS bf16_t*)(lds + 1024);
    LAS float* LG = (LAS float*)(lds + 36864);
    LAS float* LB = (LAS float*)(lds + 40960);
    const bf16_t* U = (const bf16_t*)(ws + WS_U); const bf16_t* V = (const bf16_t*)(ws + WS_V); bf16_t* YC = (bf16_t*)(ws + WS_SA);
    const bf16_t* WSP = (const bf16_t*)(ws + WS_WSP);
    for (int i = tid; i < 1024; i += 512) { LG[i] = ln_g[i]; LB[i] = ln_b[i]; }
    const int kmax = (16 * wid + 15) >> 5, t = 16 * wid + fr;
    for (int unit = vcu; unit < M_TOK / 128; unit += G) {
        const size_t r0 = (size_t)unit * 128;
        u32x4 vreg[4];
#pragma unroll
        for (int it = 0; it < 4; ++it) { const int idx = wid * 4 + it, s = (idx & 1) * 64 + lane, c0 = (idx >> 1) * 8; vreg[it] = *(const u32x4*)(V + (r0 + s) * DM + c0); }
#pragma unroll
        for (int jb = 0; jb < 2; ++jb) {
            u32x4 a[8], b[8]; float s1[8], s2[8];
#pragma unroll
            for (int j = 0; j < 8; ++j) { const bf16_t* p = V + (r0 + 16 * wid + 8 * jb + j) * DM; a[j] = *(const u32x4*)(p + 8 * lane); b[j] = *(const u32x4*)(p + 512 + 8 * lane); }
#pragma unroll
            for (int j = 0; j < 8; ++j) { float x[8], y[8]; unpack8(a[j], x); unpack8(b[j], y); s1[j] = 0.f; s2[j] = 0.f;
#pragma unroll
                for (int i = 0; i < 8; ++i) { s1[j] += x[i] + y[i]; s2[j] += x[i] * x[i] + y[i] * y[i]; } }
#pragma unroll
            for (int o = 1; o < 64; o <<= 1)
#pragma unroll
                for (int j = 0; j < 8; ++j) { s1[j] += shx(s1[j], lane, o); s2[j] += shx(s2[j], lane, o); }
#pragma unroll
            for (int j = 0; j < 8; ++j) { const float mean = s1[j] * (1.f / DM), var = fmaxf(s2[j] * (1.f / DM) - mean * mean, 0.f);
                if (lane == 0) ST[16 * wid + 8 * jb + j] = (f32x2){mean, 1.f / sqrtf(var + EPS)}; }
        }
        __syncthreads();
        for (int g = 0; g < 8; ++g) {
#pragma unroll
            for (int it = 0; it < 4; ++it) {
                const int idx = wid * 4 + it, s = (idx & 1) * 64 + lane, c0 = (idx >> 1) * 8;
                float v[8]; unpack8(vreg[it], v);
                const f32x2 st = ST[s];
                const f32x4 g0 = *(const LAS f32x4*)(LG + g * 128 + c0), g1 = *(const LAS f32x4*)(LG + g * 128 + c0 + 4), e0 = *(const LAS f32x4*)(LB + g * 128 + c0), e1 = *(const LAS f32x4*)(LB + g * 128 + c0 + 4);
#pragma unroll
                for (int i = 0; i < 8; ++i) {
                    const int c = c0 + i, rho = (c & ~31) + 16 * ((c >> 2) & 1) + 4 * ((c & 31) >> 3) + (c & 3);
                    const float gm = i < 4 ? g0[i] : g1[i - 4], be = i < 4 ? e0[i] : e1[i - 4];
                    const float val = (v[i] - st.x) * st.y * gm + be;
                    VT[rho * 136 + s] = (bf16_t)(cvt_pk_bf16(val, 0.f) & 0xffffu);
                }
            }
            bf16x8 wf[4];
#pragma unroll
            for (int kk = 0; kk < 4; ++kk) if (kk <= kmax) wf[kk] = *(const bf16x8*)(WSP + ((size_t)(g * 128 + t)) * 128 + 32 * kk + 8 * fq);
            const float bias = b_s[g * 128 + t];
            u32x4 ureg[4];
#pragma unroll
            for (int b = 0; b < 4; ++b) ureg[b] = *(const u32x4*)(U + (r0 + t) * DM + g * 128 + b * 32 + 8 * fq);
            if (g < 7) {
#pragma unroll
                for (int it = 0; it < 4; ++it) { const int idx = wid * 4 + it, s = (idx & 1) * 64 + lane, c0 = (idx >> 1) * 8; vreg[it] = *(const u32x4*)(V + (r0 + s) * DM + (g + 1) * 128 + c0); }
            }
            __syncthreads();
            f32x4 acc[4][2];
#pragma unroll
            for (int b = 0; b < 4; ++b) { acc[b][0] = (f32x4){0.f, 0.f, 0.f, 0.f}; acc[b][1] = (f32x4){0.f, 0.f, 0.f, 0.f}; }
#pragma unroll
            for (int kk = 0; kk < 4; ++kk) if (kk <= kmax) {
#pragma unroll
                for (int b = 0; b < 4; ++b)
#pragma unroll
                    for (int n = 0; n < 2; ++n) {
                        const bf16x8 vf = *(const LAS bf16x8*)(VT + (b * 32 + 16 * n + fr) * 136 + 32 * kk + 8 * fq);
                        acc[b][n] = __builtin_amdgcn_mfma_f32_16x16x32_bf16(vf, wf[kk], acc[b][n], 0, 0, 0);
                    }
            }
#pragma unroll
            for (int b = 0; b < 4; ++b) {
                float u8[8]; unpack8(ureg[b], u8);
                float o[8];
#pragma unroll
                for (int j = 0; j < 4; ++j) { o[j] = (acc[b][0][j] + bias) * u8[j]; o[4 + j] = (acc[b][1][j] + bias) * u8[4 + j]; }
                *(u32x4*)(YC + (r0 + t) * DM + g * 128 + b * 32 + 8 * fq) = pack8(o);
            }
            __syncthreads();
        }
    }
}


#define XB_TMO      128
#define XB_XCNT(j)  (256  + 64 * (j))
#define XB_XSUB(j)  (1280 + 64 * (j))
#define XB_XGEN(j)  (2304 + 64 * (j))
#define XB_TOP      3328
#define XB_TOPGEN   3392
#define XB_SPIN_CAP (1u << 20)
__device__ __forceinline__ unsigned xb_ld(unsigned* p)              { return __hip_atomic_load(p, __ATOMIC_RELAXED, __HIP_MEMORY_SCOPE_AGENT); }
__device__ __forceinline__ unsigned xb_add(unsigned* p, unsigned v) { return __hip_atomic_fetch_add(p, v, __ATOMIC_RELAXED, __HIP_MEMORY_SCOPE_AGENT); }
__device__ __forceinline__ unsigned xb_xcc_id() { return (unsigned)__builtin_amdgcn_s_getreg((3 << 11) | 20) & 0xFu; }
#define XB_SPIN(cond, bar) do { unsigned _sp = 0; while (cond) { __builtin_amdgcn_s_sleep(1); \
    if ((++_sp & 255u) == 0u) { if (xb_ld(&(bar)[XB_TMO])) break; if (_sp > XB_SPIN_CAP) { atomicAdd(&(bar)[XB_TMO], 1u); break; } } } } while (0)
struct XcdBarrier { unsigned* bar; unsigned x; volatile LAS unsigned* st; };
__device__ __forceinline__ void xcd_barrier_post(unsigned* bar, int tid) { if (tid == 0) (void)xb_add(&bar[XB_XCNT(xb_xcc_id())], 1u); }
__device__ __forceinline__ void xcd_barrier_complete(unsigned* bar, unsigned x, unsigned& nloc, unsigned& nx) {
    const unsigned G = gridDim.x * gridDim.y * gridDim.z;
    unsigned sum, cnt, mine, sp = 0u;
    for (;;) {
        sum = 0u; cnt = 0u; mine = 0u;
#pragma unroll
        for (unsigned j = 0; j < 16; ++j) { const unsigned c = xb_ld(&bar[XB_XCNT(j)]); sum += c; cnt += (c > 0u) ? 1u : 0u; mine = (j == x) ? c : mine; }
        if (sum == G) break;
        __builtin_amdgcn_s_sleep(1);
        if ((++sp & 255u) == 0u) { if (xb_ld(&bar[XB_TMO])) break; if (sp > XB_SPIN_CAP) { atomicAdd(&bar[XB_TMO], 1u); break; } }
    }
    nloc = mine > 0u ? mine : 1u; nx = cnt > 0u ? cnt : 1u;
}
__device__ __forceinline__ void xcd_barrier(const XcdBarrier& b, int tid) {
    asm volatile("s_waitcnt vmcnt(0)" ::: "memory");
    __syncthreads();
    if (tid == 0) {
        unsigned* bar = b.bar;
        __builtin_amdgcn_s_waitcnt(0);
        unsigned nloc = b.st[0], nx = b.st[1];
        if (nloc == 0u) { xcd_barrier_complete(bar, b.x, nloc, nx); b.st[0] = nloc; b.st[1] = nx; }
        const unsigned old = xb_add(&bar[XB_XSUB(b.x)], 1u);
        const unsigned gen = old / nloc;
        if (old + 1u == (gen + 1u) * nloc) {
            __builtin_amdgcn_fence(__ATOMIC_RELEASE, "agent");
            asm volatile("s_waitcnt vmcnt(0)" ::: "memory");
            const unsigned og = xb_add(&bar[XB_TOP], 1u);
            const unsigned tg = og / nx;
            if (og + 1u == (tg + 1u) * nx) xb_add(&bar[XB_TOPGEN], 1u);
            else XB_SPIN(xb_ld(&bar[XB_TOPGEN]) == tg, bar);
            __builtin_amdgcn_fence(__ATOMIC_ACQUIRE, "agent");
            xb_add(&bar[XB_XGEN(b.x)], 1u);
            asm volatile("s_waitcnt vmcnt(0)" ::: "memory");
        } else {
            XB_SPIN(xb_ld(&bar[XB_XGEN(b.x)]) == gen, bar);
            __builtin_amdgcn_fence(__ATOMIC_ACQUIRE, "agent");
            asm volatile("s_waitcnt vmcnt(0)" ::: "memory");
        }
    }
    __syncthreads();
}

struct Args { const float* in[31]; float* out; unsigned char* ws; int ph_lo, ph_hi; };

__global__ void __launch_bounds__(512, 2) mk_fwd(Args args) {
    extern __shared__ __attribute__((aligned(16))) unsigned char lds_raw[];
    LAS unsigned char* lds = (LAS unsigned char*)lds_raw;
    const int G = gridDim.x, bx = blockIdx.x;
    const int vcu = (G % 8 == 0) ? (bx % 8) * (G / 8) + bx / 8 : bx;
    volatile LAS unsigned* xst = (volatile LAS unsigned*)(lds + LDS_XS + 8192);
    const bool multi = args.ph_hi - args.ph_lo > 1;
    if (multi) { if (threadIdx.x < 2) xst[threadIdx.x] = 0u; __syncthreads(); xcd_barrier_post((unsigned*)args.ws, (int)threadIdx.x); }

    for (int pi = args.ph_lo; pi < args.ph_hi; ++pi) {
        const int ph = pi;
        if (ph == 11 || ph == 12) continue;
        int tid = threadIdx.x; asm volatile("" : "+v"(tid));
        size_t wz = 0; asm volatile("" : "+s"(wz)); unsigned char* ws = args.ws + wz;
        const __attribute__((address_space(4))) char* kp = (const __attribute__((address_space(4))) char*)__builtin_amdgcn_kernarg_segment_ptr() + wz;
#define IN(i) ((const float*)(*(const __attribute__((address_space(1))) float* const __attribute__((address_space(4)))*)(kp + 8 * (i))))
        const int lane = tid & 63, wave = __builtin_amdgcn_readfirstlane(tid >> 6);
        const int gw = vcu * 8 + wave, NGW = G * 8;
        const bool panel_mode = (G == M_TOK / 256); const int panel = vcu;
        pg8::Epi E; E.ws = ws; E.lds = lds;
        bool is_gemm = false;
        if (ph == 0) {
            const bool split = (G % 32 == 0) && (G >= 128);
            const int nc = split ? (G / 32) * 12 : G, nm = split ? G - nc : G;
            const int ci = split ? (vcu % 32) * (G / 32) + (vcu / 32) : vcu, mi = split ? (vcu / 32) * 20 + (vcu % 32) - 12 : vcu;
            const bool do_c = !split || (vcu % 32) < 12, do_m = !split || (vcu % 32) >= 12;
            const int gwc = ci * 8 + wave, NGWC = nc * 8, gwm = mi * 8 + wave, NGWM = nm * 8;
            if (do_c) {
            for (int g = ci; g < 32; g += nc) s5_build(lds, ws, IN(8), IN(9), IN(10), IN(11), IN(12), IN(13), IN(14), IN(15), g, tid);
            LAS float* scr = (LAS float*)(lds + wave * 16384);
            constexpr int I_IN = 16 * (NIN / 32), I_BG = 16 * 32, I_BS = 8 * 32, I_MX = 16 * 32, I_GL = 8 * 16, I_Q = 16 * 32, I_KV = 16 * 64, I_O = 16 * 32, I_GU = 16 * (2 * FF / 32), I_DN = (FF / 64) * 32;
            constexpr int NIT = I_IN + I_BG + I_BS + I_MX + I_GL + I_KV + I_O + I_GU + I_DN;
            for (int it = gwc; it < NIT; it += NGWC) {
                int r = it;
                if (r < I_IN) { transpose_item(IN(3), NIN, (bf16_t*)(ws + WS_WIN), 1024, 0, 0, scr, r, lane); continue; } r -= I_IN;
                if (r < I_BG) { transpose_item(IN(17), 1024, (bf16_t*)(ws + WS_WBR), 1536, 0, 0, scr, r, lane); continue; } r -= I_BG;
                if (r < I_BS) { transpose_item(IN(18), 1024, (bf16_t*)(ws + WS_WBR), 1536, 1024, 0, scr, r, lane); continue; } r -= I_BS;
                if (r < I_MX) { transpose_item(IN(19), 1024, (bf16_t*)(ws + WS_WMIX), 1024, 0, 0, scr, r, lane); continue; } r -= I_MX;
                if (r < I_GL) { transpose_item(IN(16), 512, (bf16_t*)(ws + WS_WGLU), 512, 0, 0, scr, r, lane); continue; } r -= I_GL;
                if (r < I_KV) { transpose_item(IN(24), 2048, (bf16_t*)(ws + WS_WKV), 1152, 0, 0, scr, r, lane); continue; } r -= I_KV;
                if (r < I_O) { transpose_item(IN(25), 1024, (bf16_t*)(ws + WS_WO), 1024, 0, 0, scr, r, lane); continue; } r -= I_O;
                if (r < I_GU) { transpose_item(IN(28), 2 * FF, (bf16_t*)(ws + WS_WGU), 1024, 0, 1, scr, r, lane, IN(27)); continue; } r -= I_GU;
                transpose_item(IN(29), 1024, (bf16_t*)(ws + WS_WDN), FF, 0, 0, scr, r, lane);
            }
            {
                const float* w = IN(23); const float* gq = IN(21); bf16_t* o = (bf16_t*)(ws + WS_WQ);
                for (int i = ci * 512 + tid; i < 1024 * 1024 / 8; i += nc * 512) {
                    const int e = i * 8; const float gsc = gq[e >> 10];
                    const f32x4 a = *(const f32x4*)(w + e) * gsc, b = *(const f32x4*)(w + e + 4) * gsc;
                    float v[8] = {a[0], a[1], a[2], a[3], b[0], b[1], b[2], b[3]};
                    *(u32x4*)(o + e) = pack8(v);
                }
            }
            {
                const float* w = IN(6); bf16_t* o = (bf16_t*)(ws + WS_WSP);
                for (int i = ci * 512 + tid; i < 8 * 128 * 128 / 8; i += nc * 512) {
                    const int e = i * 8, s0 = e & 127, t = (e >> 7) & 127;
                    const f32x4 a = *(const f32x4*)(w + e), b = *(const f32x4*)(w + e + 4);
                    float v[8] = {a[0], a[1], a[2], a[3], b[0], b[1], b[2], b[3]};
#pragma unroll
                    for (int j = 0; j < 8; ++j) if (s0 + j > t) v[j] = 0.f;
                    *(u32x4*)(o + e) = pack8(v);
                }
            }
            }
            if (do_m) {
                int m = gwm;
                for (; m + 3 * NGWM < M_TOK; m += 4 * NGWM) rms_rows_to_bf16<4>(IN(0) + (size_t)m * DM, (size_t)NGWM * DM, IN(2), (bf16_t*)(ws + WS_SA) + (size_t)m * DM, (size_t)NGWM * DM, lane);
                for (; m < M_TOK; m += NGWM) rms_rows_to_bf16<1>(IN(0) + (size_t)m * DM, 0, IN(2), (bf16_t*)(ws + WS_SA) + (size_t)m * DM, 0, lane);
                for (m = gwm; m < NMEM; m += NGWM) rms_rows_to_bf16<1>(IN(1) + (size_t)m * DM, 0, IN(22), (bf16_t*)(ws + WS_MEMN) + (size_t)m * 1152, 0, lane);
            }
        } else if (ph == 1 || ph == 2) { is_gemm = true;
        } else if (ph == 3) { is_gemm = true;
        } else if (ph == 4 || ph == 5 || ph == 6 || ph == 7) { is_gemm = true;
        } else if (ph == 8) {
            if (panel_mode) rowpass<false, true>((const bf16_t*)(ws + WS_SA), IN(20), IN(0), ws + WS_X1B, nullptr, nullptr, (float*)(ws + WS_RS1), panel * 256 + wave, 8, lane, panel * 256 + 256);
            else rowpass<false, true>((const bf16_t*)(ws + WS_SA), IN(20), IN(0), ws + WS_X1B, nullptr, nullptr, (float*)(ws + WS_RS1), gw, NGW, lane, M_TOK);
        } else if (ph == 9 || ph == 10) { is_gemm = true;
        } else if (ph == 13) {
            if (panel_mode) rowpass<true, true>((const bf16_t*)(ws + WS_SD), IN(26), ws + WS_X1B, ws + WS_X2B, nullptr, nullptr, (float*)(ws + WS_RS2), panel * 256 + wave, 8, lane, panel * 256 + 256);
            else rowpass<true, true>((const bf16_t*)(ws + WS_SD), IN(26), ws + WS_X1B, ws + WS_X2B, nullptr, nullptr, (float*)(ws + WS_RS2), gw, NGW, lane, M_TOK);
        } else if (ph == 14 || ph == 15) { is_gemm = true;
        } else if (ph == 16) {
            if (panel_mode) rowpass<true, false>((const bf16_t*)(ws + WS_SC), IN(30), ws + WS_X2B, args.out, nullptr, nullptr, nullptr, panel * 256 + wave, 8, lane, panel * 256 + 256);
            else rowpass<true, false>((const bf16_t*)(ws + WS_SC), IN(30), ws + WS_X2B, args.out, nullptr, nullptr, nullptr, gw, NGW, lane, M_TOK);
        }
        if (is_gemm) {
            pg8::Sched S; S.ws = ws; S.ph = ph; S.G = G; S.c = bx; S.panel = (panel_mode && ph >= 6) ? panel : -1;
            const bool scan_wg = (ph == 3) && (G > 128) && (vcu < 64);
            if (ph == 3 && G > 128) { S.G = G - 64; S.c = vcu - 64; }
            S.n0 = pg8::phase_units(ph, 0); S.n1 = (ph == 2 || ph == 3) ? pg8::phase_units(ph, 1) : 0; S.total = S.n0 + S.n1;
            if (S.panel >= 0) S.total = (ph == 14) ? 2 * FF / 256 : 4;
            if (ph == 1) { for (int u = vcu; u < 256; u += G) s5_expand(lds, ws, u >> 3, u & 7, tid); }
            const bool sp_first = (ph == 2) && ((vcu >> 0) & 1);
            if (sp_first) spatial_phase(lds, ws, IN(4), IN(5), IN(7), vcu, G, tid);
            if (!scan_wg) pg8::gemm_phase(lds, S, E, tid);
            if (ph == 2 && !sp_first) spatial_phase(lds, ws, IN(4), IN(5), IN(7), vcu, G, tid);
            if (ph == 3) {
            const int gt = vcu * 512 + tid;
                if (gt < 16 * 32 * 64) {
                    const int p = gt & 63, g = (gt >> 6) & 31, b = gt >> 11;
                    const f32x2 a = ((const f32x2*)(ws + WS_A64))[g * 64 + p];
                    const float* Eb = (const float*)(ws + WS_EBUF); bf16_t* UC = (bf16_t*)(ws + WS_UC);
                    float cr = 0.f, ci = 0.f;
    #pragma unroll 8
                    for (int k = 0; k < 64; ++k) {
                        const size_t row = (size_t)g * 1024 + b * 64 + k;
                        const f32x2 e = *(const f32x2*)(Eb + row * 128 + 2 * p);
                        *(unsigned*)(UC + row * 1152 + 1024 + 2 * p) = cvt_pk_bf16(cr, ci);
                        const float nr = a.x * cr - a.y * ci + e.x, ni = a.x * ci + a.y * cr + e.y; cr = nr; ci = ni;
                    }
                }

            }
        }
        if (pi + 1 < args.ph_hi) {
            if (panel_mode && ph >= 6 && ph != 16) {
                asm volatile("s_waitcnt vmcnt(0) lgkmcnt(0)" ::: "memory");
                __syncthreads();
                __builtin_amdgcn_fence(__ATOMIC_ACQUIRE, "agent");
                asm volatile("s_waitcnt vmcnt(0)" ::: "memory");
                __syncthreads();
            } else if (args.ph_hi > 4096) cg::this_grid().sync();
            else { XcdBarrier xb; xb.bar = (unsigned*)ws; xb.x = xb_xcc_id(); xb.st = xst; xcd_barrier(xb, tid); }
        }
    }
}

extern "C" void kernel_launch(void* const* d_in, const int* in_sizes, int n_in, void* d_out, int out_size, void* d_ws, size_t ws_size, hipStream_t stream) {
    static int grid = 0;
    if (grid == 0) {
        if (n_in != 31 || in_sizes[0] != M_TOK * DM || out_size != M_TOK * DM || ws_size < WS_END) { fprintf(stderr, "kernel_launch: unexpected problem (n_in %d, ws %zu)\n", n_in, ws_size); grid = -1; return; }
        int dev = 0, cus = 0, per_cu = 0;
        hipGetDevice(&dev); hipDeviceGetAttribute(&cus, hipDeviceAttributeMultiprocessorCount, dev);
        hipFuncSetAttribute((const void*)mk_fwd, hipFuncAttributeMaxDynamicSharedMemorySize, LDS_BYTES);
        hipOccupancyMaxActiveBlocksPerMultiprocessor(&per_cu, (const void*)mk_fwd, 512, LDS_BYTES);
        if (per_cu < 1) { fprintf(stderr, "kernel_launch: occupancy query says %d blocks per CU\n", per_cu); per_cu = 1; }
        (void)hipGetLastError();
        grid = cus;
    }
    if (grid < 0) return;
    Args a{};
    for (int i = 0; i < 31; ++i) a.in[i] = (const float*)d_in[i];
    a.out = (float*)d_out; a.ws = (unsigned char*)d_ws;
#if MK_ONE_LAUNCH
    (void)hipMemsetAsync(d_ws, 0, 65536, stream);
    a.ph_lo = 0; a.ph_hi = NPHASE;
    void* kargs[] = {&a};
    hipError_t e = hipLaunchCooperativeKernel((const void*)mk_fwd, dim3(grid), dim3(512), kargs, LDS_BYTES, stream);
    if (e != hipSuccess) fprintf(stderr, "cooperative launch failed: %s (grid %d)\n", hipGetErrorString(e), grid);

#else
    for (int ph = 0; ph < NPHASE; ++ph) {
        a.ph_lo = ph; a.ph_hi = ph + 1;
        hipLaunchKernelGGL(mk_fwd, dim3(grid), dim3(512), LDS_BYTES, stream, a);
    }
#endif
}
```

```cpp
#include <hip/hip_runtime.h>
#include <hip/hip_cooperative_groups.h>
#include <cstdint>
#include <cstdio>
namespace cg = cooperative_groups;

#ifndef MK_ONE_LAUNCH
#define MK_ONE_LAUNCH 1
#endif

#define LAS __attribute__((address_space(3)))
typedef unsigned short bf16_t;
typedef short bf16x8 __attribute__((ext_vector_type(8)));
typedef float f32x4 __attribute__((ext_vector_type(4)));
typedef float f32x2 __attribute__((ext_vector_type(2)));
typedef unsigned u32x4 __attribute__((ext_vector_type(4)));
typedef unsigned u32x2 __attribute__((ext_vector_type(2)));

constexpr int M_TOK = 65536, DM = 1024, NIN = 4608, FF = 2816, NMEM = 4096, SEQ = 4096;
constexpr float EPS = 1e-6f;
constexpr int NPHASE = 17;
constexpr size_t MiB = 1u << 20;
constexpr size_t WS_WIN = 1 * MiB, WS_WBR = 10 * MiB, WS_WMIX = 13 * MiB, WS_WGLU = 15 * MiB, WS_WQ = 16 * MiB, WS_WKV = 18 * MiB  , WS_WO = 23 * MiB,
                 WS_WGU = 25 * MiB, WS_WDN = 36 * MiB, WS_WSP = 42 * MiB, WS_A64 = 42 * MiB + 256 * 1024, WS_RS1 = 42 * MiB + 320 * 1024  , WS_RS2 = 42 * MiB + 576 * 1024  , WS_KB = 43 * MiB, WS_VB = 51 * MiB  ;
constexpr size_t WS_SA = 59 * MiB, WS_SB = 187 * MiB, WS_SC = 315 * MiB, WS_SD = 443 * MiB;
constexpr size_t WS_ACT = 571 * MiB;
constexpr size_t WS_BT1 = 571 * MiB  , WS_BT2 = 581 * MiB, WS_EBUF = 653 * MiB, WS_MEMN = 669 * MiB  , WS_UC = 678 * MiB,
                 WS_U = 750 * MiB  , WS_V = 878 * MiB, WS_S5T = 1006 * MiB  , WS_END = 1010 * MiB;
constexpr size_t WS_X1B = WS_SB, WS_X2B = WS_SA;
constexpr size_t WS_VST = WS_SB;
constexpr size_t WS_MB = 942 * MiB, WS_NB = 974 * MiB;
constexpr int KTS = 257;
constexpr int S5T_BYTES = 49664 + 64 * KTS * 4;
constexpr int LDS_RING = 131072, LDS_XS = 131072, LDS_BYTES = 147456;

typedef __bf16 bf16v2 __attribute__((ext_vector_type(2)));
__device__ __forceinline__ unsigned cvt_pk_bf16(float lo, float hi) { const f32x2 f = {lo, hi}; const bf16v2 v = __builtin_convertvector(f, bf16v2); return __builtin_bit_cast(unsigned, v); }
__device__ __forceinline__ float bf_lo(unsigned w) { return __uint_as_float(w << 16); }
__device__ __forceinline__ float bf_hi(unsigned w) { return __uint_as_float(w & 0xffff0000u); }
__device__ __forceinline__ float fsigmoid(float x) { return __builtin_amdgcn_rcpf(1.f + __builtin_amdgcn_exp2f(-1.4426950408889634f * x)); }
__device__ __forceinline__ float gelu_t(float x) { const float y = 1.5957691216057308f * (x + 0.044715f * x * x * x); return x * fsigmoid(y); }
__device__ __forceinline__ float shx(float v, int lane, int o) { return __int_as_float(__builtin_amdgcn_ds_bpermute((lane ^ o) << 2, __float_as_int(v))); }
__device__ __forceinline__ float wave_sum(float v, int lane) {
#pragma unroll
    for (int o = 1; o < 64; o <<= 1) v += shx(v, lane, o);
    return v;
}
__device__ __forceinline__ void unpack8(const u32x4 w, float (&v)[8]) {
    v[0] = bf_lo(w.x); v[1] = bf_hi(w.x); v[2] = bf_lo(w.y); v[3] = bf_hi(w.y); v[4] = bf_lo(w.z); v[5] = bf_hi(w.z); v[6] = bf_lo(w.w); v[7] = bf_hi(w.w);
}
__device__ __forceinline__ u32x4 pack8(const float (&v)[8]) {
    u32x4 w; w.x = cvt_pk_bf16(v[0], v[1]); w.y = cvt_pk_bf16(v[2], v[3]); w.z = cvt_pk_bf16(v[4], v[5]); w.w = cvt_pk_bf16(v[6], v[7]); return w;
}

namespace pg8 {
constexpr int BM = 256, BK = 64, HALF = 128, HTB = HALF * BK * 2, NXCD = 8, WGM = 8;
__host__ __device__ __forceinline__ int lds_byte(int r, int c) { const int st = (r >> 4) * 2 + (c >> 5), rr = r & 15, cc = c & 31, ob = rr * 64 + cc * 2; return st * 1024 + (ob ^ (((ob >> 9) & 1) << 5)); }
__host__ __device__ __forceinline__ void stage_rc(int b, int& R, int& C) { const int st = b / 1024, sb = b % 1024, swz = sb ^ (((sb >> 9) & 1) << 5); R = (st >> 1) * 16 + swz / 64; C = (st & 1) * 32 + (swz % 64) / 2; }
__host__ __device__ __forceinline__ int perm32(int rho) { const int n = rho >> 4, i = rho & 15; return 8 * (i >> 2) + 4 * n + (i & 3); }

enum Kind { K_IN = 0, K_KVPROJ, K_MB, K_NB, K_S5E, K_S5Y, K_GLU, K_BR, K_MIX, K_SMAX, K_OPROJ, K_GU, K_DOWN };

struct Unit { const char* A; const char* B; int lda, cha, ldb, nt, pn, kind, orow, ocol; };
struct Desc {
    const char* A; const char* B; int lda, cha, ldb, nt, nM, nN, nZ0; long zsA0, zsA1, zsB0, zsB1; int kind, orz0, orz1, ocz0;
    __device__ __forceinline__ void fill(int w, Unit& u) const {
        const int per = nM * nN, z = w / per, r = w % per;
        const int nig = WGM * nN, gid = r / nig, fm = gid * WGM, gsz = (nM - fm) < WGM ? (nM - fm) : WGM;
        const int pm = fm + ((r % nig) % gsz), pn = (r % nig) / gsz;
        const int z0 = z % nZ0, z1 = z / nZ0;
        fill_pz(pm, pn, z0, z1, u);
    }
    __device__ __forceinline__ void fill_pz(int pm, int pn, int z0, int z1, Unit& u) const {
        u.pn = pn;
        u.A = A + z0 * zsA0 + z1 * zsA1 + (long)pm * BM * lda * 2;
        u.B = B + z0 * zsB0 + z1 * zsB1 + (long)pn * BM * ldb * 2;
        u.lda = lda; u.cha = cha; u.ldb = ldb; u.nt = nt; u.kind = kind;
        u.orow = pm * BM + z0 * orz0 + z1 * orz1; u.ocol = pn * BM + z0 * ocz0;
    }
};
__device__ __forceinline__ Desc mk_desc(const void* A, const void* B, int lda, int ldb, int K, int Mrows, int Ncols, int kind) {
    Desc d; d.A = (const char*)A; d.B = (const char*)B; d.lda = lda; d.cha = 16; d.ldb = ldb; d.nt = K / BK; d.nM = Mrows / BM; d.nN = Ncols / BM; d.nZ0 = 1;
    d.zsA0 = d.zsA1 = d.zsB0 = d.zsB1 = 0; d.kind = kind; d.orz0 = d.orz1 = d.ocz0 = 0; return d;
}
__device__ __forceinline__ Desc phase_desc(int ph, int sub, unsigned char* ws) {
    Desc d;
    if (ph == 1) { d = mk_desc(ws + WS_SA, ws + WS_WIN, 1024, 1024, 1024, M_TOK, NIN, K_IN);
    } else if (ph == 2) {
        if (sub == 0) { d = mk_desc(ws + WS_UC, ws + WS_BT1, 1152, 1152, 1024, 1024, 256, K_S5E); d.nZ0 = 32; d.zsA0 = 1024L * 1152 * 2; d.zsB0 = 128L * 1152 * 2; d.orz0 = 1024; }
        else d = mk_desc(ws + WS_MEMN, ws + WS_WKV, 1152, 1152, 1024, NMEM, 2048, K_KVPROJ);
    } else if (ph == 3) {
        if (sub == 0) { d = mk_desc(ws + WS_KB, ws + WS_WQ, 1024, 1024, 256, 256, 1024, K_MB); d.nZ0 = 4; d.zsA0 = 256 * 2; d.zsA1 = 256L * 1024 * 2; d.zsB0 = 256 * 2; d.orz0 = 256; d.orz1 = 1024; }
        else { d = mk_desc(ws + WS_WO, ws + WS_VB, 1024, 1024, 256, 1024, 256, K_NB); d.nZ0 = 4; d.zsA0 = 256 * 2; d.zsB0 = 256 * 2; d.zsB1 = 256L * 1024 * 2; d.orz1 = 1024; d.ocz0 = 256; }
    } else if (ph == 4) { d = mk_desc(ws + WS_UC, ws + WS_BT2, 1152, 1152, 1152, 1024, 1024, K_S5Y); d.nZ0 = 32; d.zsA0 = 1024L * 1152 * 2; d.zsB0 = 1024L * 1152 * 2; d.orz0 = 1024;
    } else if (ph == 5) { d = mk_desc(ws + WS_U, ws + WS_WGLU, 16, 512, 512, M_TOK, 512, K_GLU); d.cha = M_TOK * 16;
    } else if (ph == 6) { d = mk_desc(ws + WS_SA, ws + WS_WBR, 1024, 1536, 1536, M_TOK, 1024, K_BR);
    } else if (ph == 7) { d = mk_desc(ws + WS_SC, ws + WS_WMIX, 1024, 1024, 1024, M_TOK, 1024, K_MIX);
    } else if (ph == 9) {
        d = mk_desc(ws + WS_SB, ws + WS_MB, 1024, 1024, 1024, SEQ, 1024, K_SMAX); d.zsA1 = (long)SEQ * 1024 * 2; d.zsB1 = 1024L * 1024 * 2; d.orz1 = SEQ;
    } else if (ph == 10) {
        d = mk_desc(ws + WS_SC, ws + WS_NB, 1024, 1024, 1024, SEQ, 1024, K_OPROJ); d.zsA1 = (long)SEQ * 1024 * 2; d.zsB1 = 1024L * 1024 * 2; d.orz1 = SEQ;
    } else if (ph == 14) { d = mk_desc(ws + WS_SA, ws + WS_WGU, 1024, 1024, 1024, M_TOK, 2 * FF, K_GU);
    } else { d = mk_desc(ws + WS_ACT, ws + WS_WDN, FF, FF, FF, M_TOK, 1024, K_DOWN); }
    return d;
}
__device__ __forceinline__ int phase_units(int ph, int sub) {
    switch (ph) {
        case 1: return (M_TOK / BM) * (NIN / BM);
        case 2: return sub == 0 ? 32 * 4 : (sub == 1 ? 128 : 0);
        case 3: return sub < 2 ? 256 : 0;
        case 4: return 32 * 16;
        case 5: return (M_TOK / BM) * 2;
        case 14: return (M_TOK / BM) * (2 * FF / BM);
        default: return (M_TOK / BM) * 4;
    }
}
struct Sched {
    unsigned char* ws; int ph, n0, n1, total, G, c, panel;
    __device__ __forceinline__ bool next(int i, Unit& u) const {
        if (panel >= 0) {
            if (i >= total) return false;
            const Desc d = phase_desc(ph, 0, ws);
            if (ph == 9 || ph == 10) d.fill_pz(panel & 15, i, 0, panel >> 4, u); else d.fill_pz(panel, i, 0, 0, u);
            return true;
        }
        const long L = (long)i * G + c; if (L >= total) return false;
        int wgid = (int)L; { const int q = total / NXCD, r = total % NXCD, xcd = wgid % NXCD, off = wgid / NXCD; wgid = (xcd < r ? xcd * (q + 1) : r * (q + 1) + (xcd - r) * q) + off; }
        int sub = 0; if (wgid >= n0) { sub = 1; wgid -= n0; if (wgid >= n1) { sub = 2; wgid -= n1; } }
        const Desc d = phase_desc(ph, sub, ws); d.fill(wgid, u);
        return true;
    }
};
struct Drv { unsigned vA0, vA1, vB0, vB1, kA, hA, hB; };
__device__ __forceinline__ Drv derive(const Unit& u, int tid) {
    int R0, C0, R1, C1; stage_rc(tid * 16, R0, C0); stage_rc(tid * 16 + 8192, R1, C1);
    const int Rb0 = (R0 & ~31) + perm32(R0 & 31), Rb1 = (R1 & ~31) + perm32(R1 & 31);
    Drv d;
    d.vA0 = (unsigned)(R0 * u.lda + (C0 >> 4) * u.cha + (C0 & 15)) * 2u; d.vA1 = (unsigned)(R1 * u.lda + (C1 >> 4) * u.cha + (C1 & 15)) * 2u;
    d.vB0 = (unsigned)(Rb0 * u.ldb + C0) * 2u; d.vB1 = (unsigned)(Rb1 * u.ldb + C1) * 2u;
    d.kA = (unsigned)(8 * u.cha); d.hA = (unsigned)(HALF * 2 * u.lda); d.hB = (unsigned)(HALF * 2 * u.ldb);
    return d;
}

struct Epi {
    unsigned char* ws; LAS unsigned char* lds;
    __device__ __forceinline__ void get8(const f32x4 (&acc)[2][2][4][2], int ai, int bj, int m, float (&v)[8]) const {
        const f32x4 a = acc[ai][bj][m][0], b = acc[ai][bj][m][1];
        v[0] = a[0]; v[1] = a[1]; v[2] = a[2]; v[3] = a[3]; v[4] = b[0]; v[5] = b[1]; v[6] = b[2]; v[7] = b[3];
    }
    __device__ __forceinline__ void mid(f32x4 (&acc)[2][2][4][2], const Unit& u, int wr, int wc, int fr, int fq) const {
        const bf16_t* GA = (const bf16_t*)(ws + WS_SC); const bf16_t* GB = (const bf16_t*)(ws + WS_SD);
        int rb = u.orow + wr * 64 + fr; asm volatile("" : "+v"(rb));
        int cb = u.ocol + wc * 32 + 8 * fq; asm volatile("" : "+v"(cb));
#pragma unroll
        for (int ai = 0; ai < 2; ++ai) {
            u32x4 ga[4][2], gb[4][2];
#pragma unroll
            for (int m = 0; m < 4; ++m)
#pragma unroll
                for (int bj = 0; bj < 2; ++bj) { const size_t o = (size_t)(rb + ai * HALF + m * 16) * DM + cb + bj * HALF; ga[m][bj] = *(const u32x4*)(GA + o); gb[m][bj] = *(const u32x4*)(GB + o); }
#pragma unroll
            for (int m = 0; m < 4; ++m)
#pragma unroll
                for (int bj = 0; bj < 2; ++bj) {
                    float a[8], b[8]; unpack8(ga[m][bj], a); unpack8(gb[m][bj], b);
#pragma unroll
                    for (int j = 0; j < 8; ++j) { const float r = a[j] * __builtin_amdgcn_rcpf(fmaxf(b[j], 1e-30f)); asm volatile("v_mul_f32 %0, %0, %1" : "+v"(acc[ai][bj][m][j >> 2][j & 3]) : "v"(r)); }
                }
            asm volatile("" ::: "memory");
        }
    }
    __device__ __forceinline__ void operator()(const f32x4 (&acc)[2][2][4][2], const Unit& u, int wr, int wc, int fr, int fq) const {
        const int kind = u.kind;
        if (kind == K_SMAX) {
            LAS f32x2* XS = (LAS f32x2*)(lds + LDS_XS);
            int rls = wr * 64 + fr; asm volatile("" : "+v"(rls));
            bf16_t* P = (bf16_t*)(ws + WS_SC); const float* RS = (const float*)(ws + WS_RS1);
            int rbs = u.orow + wr * 64 + fr; asm volatile("" : "+v"(rbs));
            float rsv[2][4];
#pragma unroll
            for (int ai = 0; ai < 2; ++ai)
#pragma unroll
                for (int m = 0; m < 4; ++m) rsv[ai][m] = RS[rbs + ai * HALF + m * 16] * 1.4426950408889634f;
#pragma unroll
            for (int ai = 0; ai < 2; ++ai)
#pragma unroll
                for (int m = 0; m < 4; ++m) {
                    const float rs = rsv[ai][m];
                    float mx = -3.0e38f;
#pragma unroll
                    for (int bj = 0; bj < 2; ++bj)
#pragma unroll
                        for (int n = 0; n < 2; ++n)
#pragma unroll
                            for (int j = 0; j < 4; ++j) mx = fmaxf(mx, acc[ai][bj][m][n][j]);
                    mx = fmaxf(mx, shx(mx, fr + 16 * fq, 16)); mx = fmaxf(mx, shx(mx, fr + 16 * fq, 32));
                    float s = 0.f;
#pragma unroll
                    for (int bj = 0; bj < 2; ++bj)
#pragma unroll
                        for (int n = 0; n < 2; ++n)
#pragma unroll
                            for (int j = 0; j < 4; ++j) s += __builtin_amdgcn_exp2f((acc[ai][bj][m][n][j] - mx) * rs);
                    s += shx(s, fr + 16 * fq, 16); s += shx(s, fr + 16 * fq, 32);
                    if (fq == 0) XS[(rls + ai * HALF + m * 16) * 4 + wc] = (f32x2){mx * rs, s};
                }
            asm volatile("s_waitcnt lgkmcnt(0)" ::: "memory"); __builtin_amdgcn_s_barrier(); asm volatile("" ::: "memory");
#pragma unroll
            for (int ai = 0; ai < 2; ++ai)
#pragma unroll
                for (int m = 0; m < 4; ++m) {
                    const int rl = rls + ai * HALF + m * 16;
                    const f32x2 p0 = XS[rl * 4 + 0], p1 = XS[rl * 4 + 1], p2 = XS[rl * 4 + 2], p3 = XS[rl * 4 + 3];
                    const f32x2 me = XS[rl * 4 + wc];
                    const float MX = fmaxf(fmaxf(p0.x, p1.x), fmaxf(p2.x, p3.x));
                    const float L = p0.y * __builtin_amdgcn_exp2f(p0.x - MX) + p1.y * __builtin_amdgcn_exp2f(p1.x - MX) + p2.y * __builtin_amdgcn_exp2f(p2.x - MX) + p3.y * __builtin_amdgcn_exp2f(p3.x - MX);
                    const float f = 1.0f / L; (void)me;
                    const size_t row = (size_t)(u.orow + rl);
                    const float rs = rsv[ai][m];
#pragma unroll
                    for (int bj = 0; bj < 2; ++bj) {
                        float v[8]; get8(acc, ai, bj, m, v);
#pragma unroll
                        for (int j = 0; j < 8; ++j) v[j] = __builtin_amdgcn_exp2f(v[j] * rs - MX) * f;
                        *(u32x4*)(P + row * DM + u.ocol + bj * HALF + wc * 32 + 8 * fq) = pack8(v);
                    }
                }
            asm volatile("s_waitcnt lgkmcnt(0)" ::: "memory"); __builtin_amdgcn_s_barrier(); asm volatile("" ::: "memory");
            return;
        }
        if (kind == K_GU) {
            bf16_t* ACT = (bf16_t*)(ws + WS_ACT);
            int rb = u.orow + wr * 64 + fr; asm volatile("" : "+v"(rb));
            float rsv[2][4];
#pragma unroll
            for (int ai = 0; ai < 2; ++ai)
#pragma unroll
                for (int m = 0; m < 4; ++m) rsv[ai][m] = ((const float*)(ws + WS_RS2))[rb + ai * HALF + m * 16];
#pragma unroll
            for (int ai = 0; ai < 2; ++ai)
#pragma unroll
                for (int m = 0; m < 4; ++m) {
                    const size_t row = (size_t)(rb + ai * HALF + m * 16);
                    const float rs = rsv[ai][m];
                    float g[8], w[8]; get8(acc, ai, 0, m, g); get8(acc, ai, 1, m, w);
#pragma unroll
                    for (int j = 0; j < 8; ++j) { const float gg = g[j] * rs; g[j] = gg * fsigmoid(gg) * (w[j] * rs); }
                    *(u32x4*)(ACT + row * FF + u.pn * HALF + wc * 32 + 8 * fq) = pack8(g);
                }
            return;
        }
        if (kind == K_S5E) {
            float* E = (float*)(ws + WS_EBUF);
            int rb = u.orow + wr * 64 + fr; asm volatile("" : "+v"(rb));
            int cb = wc * 32 + 8 * fq; asm volatile("" : "+v"(cb));
#pragma unroll
            for (int ai = 0; ai < 2; ++ai)
#pragma unroll
                for (int m = 0; m < 4; ++m) {
                    const size_t row = (size_t)(rb + ai * HALF + m * 16);
                    float* p = E + row * 128 + cb;
                    *(f32x4*)p = acc[ai][0][m][0]; *(f32x4*)(p + 4) = acc[ai][0][m][1];
                }
            return;
        }
        if (kind == K_IN) {
            const int pn = u.pn;
            if (pn < 4) tiles<1>(acc, u.orow, wr, wc, fr, fq, (bf16_t*)(ws + WS_U), DM, pn * BM, nullptr);
            else if (pn < 8) tiles<7>(acc, u.orow, wr, wc, fr, fq, (bf16_t*)(ws + WS_V), DM, (pn & 3) * BM, (const bf16_t*)(ws + WS_VST));
            else if (pn < 10) tiles<3>(acc, u.orow, wr, wc, fr, fq, (bf16_t*)(ws + WS_UC), 0, (pn - 8) * BM, nullptr);
            else tiles<2>(acc, u.orow, wr, wc, fr, fq, (bf16_t*)(ws + (pn < 14 ? WS_SC : WS_SD)), DM, ((pn - 10) & 3) * BM, nullptr);
        } else if (kind == K_KVPROJ) tiles<0>(acc, u.orow, wr, wc, fr, fq, (bf16_t*)(ws + (u.pn < 4 ? WS_KB : WS_VB)), DM, (u.pn & 3) * BM, nullptr);
        else if (kind == K_MB) tiles<6>(acc, u.orow, wr, wc, fr, fq, (bf16_t*)(ws + WS_MB), DM, u.ocol, nullptr);
        else if (kind == K_NB) tiles<0>(acc, u.orow, wr, wc, fr, fq, (bf16_t*)(ws + WS_NB), DM, u.ocol, nullptr);
        else if (kind == K_S5Y) tiles<1>(acc, u.orow, wr, wc, fr, fq, (bf16_t*)(ws + WS_U), 1024, u.ocol, nullptr);
        else if (kind == K_GLU) tiles<4>(acc, u.orow, wr, wc, fr, fq, (bf16_t*)(ws + WS_SB), DM, u.ocol, (const bf16_t*)(ws + WS_U));
        else if (kind == K_BR) tiles<5>(acc, u.orow, wr, wc, fr, fq, (bf16_t*)(ws + WS_SC), DM, u.ocol, (const bf16_t*)(ws + WS_SD));
        else if (kind == K_MIX) tiles<0>(acc, u.orow, wr, wc, fr, fq, (bf16_t*)(ws + WS_SA), DM, u.ocol, nullptr);
        else if (kind == K_OPROJ) tiles<0>(acc, u.orow, wr, wc, fr, fq, (bf16_t*)(ws + WS_SD), DM, u.ocol, nullptr);
        else tiles<0>(acc, u.orow, wr, wc, fr, fq, (bf16_t*)(ws + WS_SC), DM, u.ocol, nullptr);
    }
    template <int MODE>
    __device__ __forceinline__ void tiles(const f32x4 (&acc)[2][2][4][2], int orow, int wr, int wc, int fr, int fq, bf16_t* base, int ld, int colbase, const bf16_t* aux) const {
        int rb = orow + wr * 64 + fr; asm volatile("" : "+v"(rb));
        int cb = colbase + wc * 32 + 8 * fq; asm volatile("" : "+v"(cb));
#pragma unroll
        for (int ai = 0; ai < 2; ++ai) {
            u32x4 ax[4][2];
            if (MODE == 4 || MODE == 5) {
#pragma unroll
                for (int m = 0; m < 4; ++m)
#pragma unroll
                    for (int bj = 0; bj < 2; ++bj) {
                        const size_t row = (size_t)(rb + ai * HALF + m * 16); const int col = cb + bj * HALF;
                        if (MODE == 4) ax[m][bj] = *(const u32x4*)(aux + ((size_t)(col >> 4) * M_TOK + row) * 16 + (col & 15));
                        else ax[m][bj] = *(const u32x4*)(aux + row * DM + col);
                    }
            }
#pragma unroll
            for (int m = 0; m < 4; ++m) {
                const int rowi = rb + ai * HALF + m * 16; const size_t row = (size_t)rowi;
                float st1 = 0.f, st2 = 0.f;
#pragma unroll
                for (int bj = 0; bj < 2; ++bj) {
                    const int col = cb + bj * HALF;
                    float v[8]; get8(acc, ai, bj, m, v);
                    bf16_t* dst = base + row * ld + col;
                    if (MODE == 1 || MODE == 7) {
#pragma unroll
                        for (int j = 0; j < 8; ++j) v[j] = gelu_t(v[j]);
                        if (MODE == 7) {
#pragma unroll
                            for (int j = 0; j < 8; ++j) { st1 += v[j]; st2 += v[j] * v[j]; }
                        }
                    } else if (MODE == 2) {
#pragma unroll
                        for (int j = 0; j < 8; ++j) v[j] = fsigmoid(v[j]);
                    } else if (MODE == 3) {
                        const int g = col >> 4, h0 = col & 15;
                        dst = base + ((size_t)(g * 1024 + (rowi >> 6))) * 1152 + (rowi & 63) * 16 + h0;
                    } else if (MODE == 4) {
                        float y[8]; unpack8(ax[m][bj], y);
#pragma unroll
                        for (int j = 0; j < 8; ++j) v[j] = y[j] * fsigmoid(v[j]);
                    } else if (MODE == 5) {
                        float b[8]; unpack8(ax[m][bj], b);
#pragma unroll
                        for (int j = 0; j < 8; ++j) v[j] *= b[j];
                    } else if (MODE == 6) {
#pragma unroll
                        for (int j = 0; j < 8; ++j) v[j] *= 0.0625f;
                    }
                    *(u32x4*)dst = pack8(v);
                }
                if (MODE == 7) {
                    st1 += shx(st1, fr + 16 * fq, 16); st1 += shx(st1, fr + 16 * fq, 32); st2 += shx(st2, fr + 16 * fq, 16); st2 += shx(st2, fr + 16 * fq, 32);
                    if (fq == 0) ((f32x2*)aux)[row * 16 + (colbase >> 8) * 4 + wc] = (f32x2){st1, st2};
                }
                if (MODE != 4 && MODE != 5) asm volatile("" ::: "memory");
            }
            asm volatile("" ::: "memory");
        }
    }
};

__device__ __forceinline__ void gemm_phase(LAS unsigned char* lds, const Sched& S, const Epi& E, const int tid) {
    const int wid = __builtin_amdgcn_readfirstlane(tid >> 6), lane = tid & 63, wr = wid >> 2, wc = wid & 3, fr = lane & 15, fq = lane >> 4;
    const unsigned ldsw = (unsigned)wid * 1024u;
    const int aoff = lds_byte(wr * 64 + fr, fq * 8), boff = lds_byte(wc * 32 + fr, fq * 8);
#define PG8_SA(b, h) (((b) * 2 + (h)) * HTB)
#define PG8_SB(b, h) ((4 + (b) * 2 + (h)) * HTB)
#define PG8_STAGE(bufoff, gbase, v0, v1) do { \
        __builtin_amdgcn_global_load_lds((const unsigned*)((const char*)(gbase) + (v0)), (LAS unsigned*)(lds + (bufoff) + ldsw), 16, 0, 0); \
        __builtin_amdgcn_global_load_lds((const unsigned*)((const char*)(gbase) + (v1)), (LAS unsigned*)(lds + (bufoff) + ldsw + 8192), 16, 0, 0); } while (0)
#define PG8_LDA(dst, b, h) do { _Pragma("unroll") for (int m = 0; m < 4; ++m) _Pragma("unroll") for (int k = 0; k < 2; ++k) dst[m][k] = *(const LAS bf16x8*)(lds + PG8_SA(b, h) + aoff + m * 2048 + k * 1024); } while (0)
#define PG8_LDB(dst, b, h) do { _Pragma("unroll") for (int n = 0; n < 2; ++n) _Pragma("unroll") for (int k = 0; k < 2; ++k) dst[n][k] = *(const LAS bf16x8*)(lds + PG8_SB(b, h) + boff + n * 2048 + k * 1024); } while (0)
#define PG8_MMA(ai, bj, At, Bt) do { __builtin_amdgcn_s_setprio(1); _Pragma("unroll") for (int m = 0; m < 4; ++m) _Pragma("unroll") for (int n = 0; n < 2; ++n) _Pragma("unroll") for (int k = 0; k < 2; ++k) \
        acc[ai][bj][m][n] = __builtin_amdgcn_mfma_f32_16x16x32_bf16(Bt[n][k], At[m][k], acc[ai][bj][m][n], 0, 0, 0); __builtin_amdgcn_s_setprio(0); } while (0)
#define PG8_WAIT_V(n) asm volatile("s_waitcnt vmcnt(" #n ")" ::: "memory")
#define PG8_WAIT_L(n) asm volatile("s_waitcnt lgkmcnt(" #n ")" ::: "memory")
#define PG8_BAR __builtin_amdgcn_s_barrier()
#define PG8_SCHED __builtin_amdgcn_sched_barrier(0)
    Unit cur, nxt; int ui = 0;
    if (!S.next(0, cur)) return;
    nxt = cur;
    f32x4 acc[2][2][4][2];
#pragma unroll
    for (int a = 0; a < 2; ++a)
#pragma unroll
        for (int b = 0; b < 2; ++b)
#pragma unroll
            for (int m = 0; m < 4; ++m)
#pragma unroll
                for (int n = 0; n < 2; ++n) acc[a][b][m][n] = (f32x4){0.f, 0.f, 0.f, 0.f};
    bf16x8 At[4][2], B0[2][2], B1[2][2];
    const Drv dc = derive(cur, tid);
    const char* cA = cur.A; const char* cB = cur.B;
    PG8_STAGE(PG8_SB(0, 0), cB, dc.vB0, dc.vB1); PG8_STAGE(PG8_SB(0, 1), cB + dc.hB, dc.vB0, dc.vB1); PG8_STAGE(PG8_SA(0, 0), cA, dc.vA0, dc.vA1); PG8_STAGE(PG8_SA(0, 1), cA + dc.hA, dc.vA0, dc.vA1);
    if (wr == 1) PG8_BAR;
    PG8_WAIT_V(2); PG8_BAR;
    PG8_STAGE(PG8_SB(1, 0), cB + 128, dc.vB0, dc.vB1); PG8_STAGE(PG8_SA(1, 0), cA + dc.kA, dc.vA0, dc.vA1); PG8_STAGE(PG8_SB(1, 1), cB + dc.hB + 128, dc.vB0, dc.vB1);
    PG8_WAIT_V(6); PG8_BAR;
    for (;;) {
        const bool has_next = S.next(ui + 1, nxt);
        const char* nA = cA; const char* nB = cB;
        if (has_next) { nA = nxt.A; nB = nxt.B; }
        const int nt = cur.nt;
        for (int t = 0; t < nt; t += 2) {
            const bool last = (t == nt - 2);
            if (cur.kind == K_BR && t == 16) E.mid(acc, cur, wr, wc, fr, fq);
            const size_t aj = (cur.kind == K_BR) ? (size_t)(WS_SB - WS_SA) - 16 * 128 : 0;
            const char* a1 = cA + (size_t)(t + 1) * dc.kA + (t >= 16 ? aj : 0);
            const char* a2 = last ? nA : cA + (size_t)(t + 2) * dc.kA + (t >= 14 ? aj : 0); const char* b2 = last ? nB : cB + (size_t)(t + 2) * 128;
            const unsigned xA0 = dc.vA0, xA1 = dc.vA1, xB0 = dc.vB0, xB1 = dc.vB1, xk = dc.kA, xhA = dc.hA, xhB = dc.hB;
            const char* a3 = a2 + xk; const char* b3 = b2 + 128;
            PG8_LDB(B0, 0, 0); PG8_LDB(B1, 0, 1); PG8_SCHED; PG8_LDA(At, 0, 0); PG8_STAGE(PG8_SA(1, 1), a1 + dc.hA, dc.vA0, dc.vA1);
            PG8_WAIT_V(8); PG8_WAIT_L(0); PG8_BAR; PG8_MMA(0, 0, At, B0); PG8_MMA(0, 1, At, B1); PG8_BAR; PG8_SCHED;
            PG8_LDA(At, 0, 1); PG8_STAGE(PG8_SB(0, 0), b2, xB0, xB1); PG8_STAGE(PG8_SB(0, 1), b2 + xhB, xB0, xB1); PG8_STAGE(PG8_SA(0, 0), a2, xA0, xA1);
            PG8_WAIT_V(8); PG8_WAIT_L(0); PG8_BAR; PG8_MMA(1, 0, At, B0); PG8_MMA(1, 1, At, B1); PG8_BAR; PG8_SCHED;
            PG8_LDB(B0, 1, 0); PG8_LDB(B1, 1, 1); PG8_SCHED; PG8_LDA(At, 1, 0); PG8_STAGE(PG8_SA(0, 1), a2 + xhA, xA0, xA1);
            PG8_WAIT_V(8); PG8_WAIT_L(0); PG8_BAR; PG8_MMA(0, 0, At, B0); PG8_MMA(0, 1, At, B1); PG8_BAR; PG8_SCHED;
            PG8_LDA(At, 1, 1); PG8_STAGE(PG8_SB(1, 0), b3, xB0, xB1); PG8_STAGE(PG8_SB(1, 1), b3 + xhB, xB0, xB1); PG8_STAGE(PG8_SA(1, 0), a3, xA0, xA1);
            PG8_WAIT_V(8); PG8_WAIT_L(0); PG8_BAR; PG8_MMA(1, 0, At, B0); PG8_MMA(1, 1, At, B1); PG8_BAR; PG8_SCHED;
        }
        if (wr == 0) PG8_BAR;
        E(acc, cur, wr, wc, fr, fq);
        if (!has_next) break;
#pragma unroll
        for (int a = 0; a < 2; ++a)
#pragma unroll
            for (int b = 0; b < 2; ++b)
#pragma unroll
                for (int m = 0; m < 4; ++m)
#pragma unroll
                    for (int n = 0; n < 2; ++n) acc[a][b][m][n] = (f32x4){0.f, 0.f, 0.f, 0.f};
        cur = nxt; cA = nA; cB = nB; ++ui;
        if (wr == 1) PG8_BAR;
    }
    PG8_WAIT_V(0);
    PG8_BAR;
#undef PG8_SA
#undef PG8_SB
#undef PG8_STAGE
#undef PG8_LDA
#undef PG8_LDB
#undef PG8_MMA
#undef PG8_WAIT_V
#undef PG8_WAIT_L
#undef PG8_BAR
#undef PG8_SCHED
}
}

__device__ __forceinline__ void transpose_item(const float* W, int N, bf16_t* WT, int ldt, int col_off, int rmode, LAS float* scr, int item, int lane, const float* kscale = nullptr) {
    const int nblk = N / 32, kb = item / nblk, nb = item % nblk, k0 = 64 * kb, n0 = 32 * nb;
    f32x4 wv[8];
#pragma unroll
    for (int i = 0; i < 8; ++i) { wv[i] = *(const f32x4*)(W + (size_t)(k0 + 8 * i + (lane >> 3)) * N + n0 + 4 * (lane & 7)); if (kscale) wv[i] = wv[i] * kscale[k0 + 8 * i + (lane >> 3)]; }
#pragma unroll
    for (int i = 0; i < 8; ++i) { LAS float* d = scr + (8 * i + (lane >> 3)) * 33 + 4 * (lane & 7); d[0] = wv[i][0]; d[1] = wv[i][1]; d[2] = wv[i][2]; d[3] = wv[i][3]; }
    asm volatile("s_waitcnt lgkmcnt(0)" ::: "memory");
    int r0 = n0;
    if (rmode == 1) { const int isu = n0 >= FF, nn = isu ? n0 - FF : n0; r0 = 256 * (nn >> 7) + (nn & 127) + (isu ? 128 : 0); }
    const int c = lane & 7;
#pragma unroll
    for (int j = 0; j < 4; ++j) { const int n = (lane >> 3) + 8 * j; const LAS float* s = scr + (8 * c) * 33 + n;
        u32x4 o; o.x = cvt_pk_bf16(s[0 * 33], s[1 * 33]); o.y = cvt_pk_bf16(s[2 * 33], s[3 * 33]); o.z = cvt_pk_bf16(s[4 * 33], s[5 * 33]); o.w = cvt_pk_bf16(s[6 * 33], s[7 * 33]);
        *(u32x4*)(WT + (size_t)(r0 + n) * ldt + col_off + k0 + 8 * c) = o; }
    asm volatile("s_waitcnt lgkmcnt(0)" ::: "memory");
}
template <int R>
__device__ __forceinline__ void rms_rows_to_bf16(const float* x0, size_t xstride, const float* g, bf16_t* o0, size_t ostride, int lane) {
    f32x4 v[R][4]; float s[R];
#pragma unroll
    for (int r = 0; r < R; ++r)
#pragma unroll
        for (int j = 0; j < 2; ++j) { v[r][2 * j] = *(const f32x4*)(x0 + r * xstride + 512 * j + 8 * lane); v[r][2 * j + 1] = *(const f32x4*)(x0 + r * xstride + 512 * j + 8 * lane + 4); }
#pragma unroll
    for (int r = 0; r < R; ++r) { s[r] = 0.f;
#pragma unroll
        for (int j = 0; j < 4; ++j) s[r] += (v[r][j][0] * v[r][j][0] + v[r][j][1] * v[r][j][1]) + (v[r][j][2] * v[r][j][2] + v[r][j][3] * v[r][j][3]); }
#pragma unroll
    for (int o = 1; o < 64; o <<= 1)
#pragma unroll
        for (int r = 0; r < R; ++r) s[r] += shx(s[r], lane, o);
    f32x4 gg[4];
#pragma unroll
    for (int j = 0; j < 2; ++j) { gg[2 * j] = *(const f32x4*)(g + 512 * j + 8 * lane); gg[2 * j + 1] = *(const f32x4*)(g + 512 * j + 8 * lane + 4); }
#pragma unroll
    for (int r = 0; r < R; ++r) {
        const float rstd = 1.f / sqrtf(s[r] * (1.f / DM) + EPS);
#pragma unroll
        for (int j = 0; j < 2; ++j) {
            const f32x4 a = v[r][2 * j] * rstd * gg[2 * j], b = v[r][2 * j + 1] * rstd * gg[2 * j + 1];
            u32x4 w; w.x = cvt_pk_bf16(a[0], a[1]); w.y = cvt_pk_bf16(a[2], a[3]); w.z = cvt_pk_bf16(b[0], b[1]); w.w = cvt_pk_bf16(b[2], b[3]);
            *(u32x4*)(o0 + r * ostride + 512 * j + 8 * lane) = w;
        }
    }
}
template <bool XIN_BF, bool XOUT_BF>
__device__ __forceinline__ void rowpass(const bf16_t* m, const float* gpost, const void* xin_, void* xout_, const float* gpre, bf16_t* hout, float* rsout, int gw, int NGW, int lane, int row_end) {
    constexpr int R = 4;
    const float* xin = (const float*)xin_; const bf16_t* xinb = (const bf16_t*)xin_; float* xout = (float*)xout_; bf16_t* xoutb = (bf16_t*)xout_;
    for (int row0 = gw; row0 < row_end; row0 += R * NGW) {
        u32x4 mw[R][2]; f32x4 xv[R][4]; u32x4 xw[R][2];
#pragma unroll
        for (int r = 0; r < R; ++r) { const size_t ro = (size_t)(row0 + r * NGW) * DM;
#pragma unroll
            for (int j = 0; j < 2; ++j) { mw[r][j] = *(const u32x4*)(m + ro + 512 * j + 8 * lane);
                if (XIN_BF) xw[r][j] = *(const u32x4*)(xinb + ro + 512 * j + 8 * lane);
                else { xv[r][2 * j] = *(const f32x4*)(xin + ro + 512 * j + 8 * lane); xv[r][2 * j + 1] = *(const f32x4*)(xin + ro + 512 * j + 8 * lane + 4); } } }
        f32x4 gp[4];
#pragma unroll
        for (int j = 0; j < 2; ++j) { gp[2 * j] = *(const f32x4*)(gpost + 512 * j + 8 * lane); gp[2 * j + 1] = *(const f32x4*)(gpost + 512 * j + 8 * lane + 4); }
        float mv[R][2][8]; float ss[R];
#pragma unroll
        for (int r = 0; r < R; ++r) { ss[r] = 0.f;
#pragma unroll
            for (int j = 0; j < 2; ++j) { unpack8(mw[r][j], mv[r][j]);
#pragma unroll
                for (int i = 0; i < 8; ++i) ss[r] += mv[r][j][i] * mv[r][j][i]; } }
#pragma unroll
        for (int o = 1; o < 64; o <<= 1)
#pragma unroll
            for (int r = 0; r < R; ++r) ss[r] += shx(ss[r], lane, o);
        float x1[R][2][8]; float s2[R];
#pragma unroll
        for (int r = 0; r < R; ++r) {
            const size_t ro = (size_t)(row0 + r * NGW) * DM;
            const float rstd = 1.f / sqrtf(ss[r] * (1.f / DM) + EPS); s2[r] = 0.f;
#pragma unroll
            for (int j = 0; j < 2; ++j) {
                const int c = 512 * j + 8 * lane;
                float xi[8];
                if (XIN_BF) unpack8(xw[r][j], xi);
                else {
#pragma unroll
                    for (int i = 0; i < 4; ++i) { xi[i] = xv[r][2 * j][i]; xi[4 + i] = xv[r][2 * j + 1][i]; }
                }
#pragma unroll
                for (int i = 0; i < 4; ++i) { x1[r][j][i] = xi[i] + mv[r][j][i] * rstd * gp[2 * j][i]; x1[r][j][4 + i] = xi[4 + i] + mv[r][j][4 + i] * rstd * gp[2 * j + 1][i]; }
#pragma unroll
                for (int i = 0; i < 8; ++i) s2[r] += x1[r][j][i] * x1[r][j][i];
                if (XOUT_BF) *(u32x4*)(xoutb + ro + c) = pack8(x1[r][j]);
                else { *(f32x4*)(xout + ro + c) = (f32x4){x1[r][j][0], x1[r][j][1], x1[r][j][2], x1[r][j][3]}; *(f32x4*)(xout + ro + c + 4) = (f32x4){x1[r][j][4], x1[r][j][5], x1[r][j][6], x1[r][j][7]}; }
            }
        }
        if (hout || rsout) {
#pragma unroll
            for (int o = 1; o < 64; o <<= 1)
#pragma unroll
                for (int r = 0; r < R; ++r) s2[r] += shx(s2[r], lane, o);
        }
        if (rsout) {
#pragma unroll
            for (int r = 0; r < R; ++r) if (lane == 0) rsout[row0 + r * NGW] = 1.f / sqrtf(s2[r] * (1.f / DM) + EPS);
        }
        if (hout) {
#pragma unroll
            for (int j = 0; j < 2; ++j) { gp[2 * j] = *(const f32x4*)(gpre + 512 * j + 8 * lane); gp[2 * j + 1] = *(const f32x4*)(gpre + 512 * j + 8 * lane + 4); }
#pragma unroll
            for (int r = 0; r < R; ++r) {
                const size_t ro = (size_t)(row0 + r * NGW) * DM;
                const float r2 = 1.f / sqrtf(s2[r] * (1.f / DM) + EPS);
#pragma unroll
                for (int j = 0; j < 2; ++j) {
                    float h[8];
#pragma unroll
                    for (int i = 0; i < 4; ++i) { h[i] = x1[r][j][i] * r2 * gp[2 * j][i]; h[4 + i] = x1[r][j][4 + i] * r2 * gp[2 * j + 1][i]; }
                    *(u32x4*)(hout + ro + 512 * j + 8 * lane) = pack8(h);
                }
            }
        }
    }
}

__device__ __forceinline__ void s5_build(LAS unsigned char* lds, unsigned char* ws, const float* lam_re, const float* lam_im, const float* log_step, const float* b_re,
                                         const float* b_im, const float* c_re, const float* c_im, const float* dvec, int g, int tid) {
    LAS f32x2* AP = (LAS f32x2*)lds;
    LAS f32x2* BB = (LAS f32x2*)(lds + 33280);
    LAS f32x2* CC = (LAS f32x2*)(lds + 41472);
    LAS float* KT = (LAS float*)(lds + 49664);
    const float step = expf(log_step[g]);
    for (int i = tid; i < 64 * 65; i += 512) {
        const int p = i / 65, tau = i % 65;
        const float lr = lam_re[g * 64 + p], li = lam_im[g * 64 + p];
        const float mag = expf(lr * step * (float)tau);
        const double ang = (double)li * (double)step * (double)tau;
        const double kq = rint(ang * 0.15915494309189535);
        const float r = (float)(ang - kq * 6.283185307179586);
        AP[p * 65 + tau] = (f32x2){mag * cosf(r), mag * sinf(r)};
    }
    for (int i = tid; i < 64 * 16; i += 512) {
        const int p = i >> 4, h = i & 15;
        const float lr = lam_re[g * 64 + p], li = lam_im[g * 64 + p];
        const float x = lr * step, mag = expf(x), em1 = expm1f(x);
        const double ang = (double)li * (double)step; const double kq = rint(ang * 0.15915494309189535);
        const float r = (float)(ang - kq * 6.283185307179586);
        const float sh = sinf(0.5f * r), cm1 = -2.f * sh * sh, sn = sinf(r), cs = 1.f + cm1;
        const float nr = em1 * cs + cm1, ni = mag * sn;
        const float den = lr * lr + li * li;
        const float co_re = (nr * lr + ni * li) / den, co_im = (ni * lr - nr * li) / den;
        const float br = b_re[(g * 64 + p) * 16 + h], bi = b_im[(g * 64 + p) * 16 + h];
        BB[p * 16 + h] = (f32x2){co_re * br - co_im * bi, co_re * bi + co_im * br};
        const int hh = i >> 6, pp = i & 63;
        CC[hh * 64 + pp] = (f32x2){c_re[(g * 16 + hh) * 64 + pp], c_im[(g * 16 + hh) * 64 + pp]};
    }
    __syncthreads();
    for (int it = 0; it < 2; ++it) {
        const int tau = tid & 63, hp = (tid >> 6) + 8 * it;
        float a[16];
#pragma unroll
        for (int h = 0; h < 16; ++h) a[h] = 0.f;
        for (int p = 0; p < 64; ++p) {
            const f32x2 c = CC[hp * 64 + p], ap = AP[p * 65 + tau];
            const float xr = c.x * ap.x - c.y * ap.y, xi = c.x * ap.y + c.y * ap.x;
#pragma unroll
            for (int h = 0; h < 16; ++h) { const f32x2 b = BB[p * 16 + h]; a[h] += xr * b.x - xi * b.y; }
        }
        if (tau == 0) {
#pragma unroll
            for (int h = 0; h < 16; ++h) if (h == hp) a[h] += dvec[g * 16 + hp];
        }
#pragma unroll
        for (int h = 0; h < 16; ++h) KT[tau * KTS + hp * 16 + h] = a[h];
    }
    __syncthreads();
    { const LAS f32x4* src = (const LAS f32x4*)lds; f32x4* dst = (f32x4*)(ws + WS_S5T + (size_t)g * S5T_BYTES);
      for (int i = tid; i < S5T_BYTES / 16; i += 512) dst[i] = src[i]; }
    if (tid < 64) ((f32x2*)(ws + WS_A64))[g * 64 + tid] = AP[tid * 65 + 64];
    __syncthreads();
}
__device__ __forceinline__ void s5_expand(LAS unsigned char* lds, unsigned char* ws, int g, int part, int tid) {
    LAS f32x2* AP = (LAS f32x2*)lds; LAS f32x2* BB = (LAS f32x2*)(lds + 33280); LAS f32x2* CC = (LAS f32x2*)(lds + 41472); LAS float* KT = (LAS float*)(lds + 49664);
    { const f32x4* src = (const f32x4*)(ws + WS_S5T + (size_t)g * S5T_BYTES); LAS f32x4* dst = (LAS f32x4*)lds;
      for (int i = tid; i < S5T_BYTES / 16; i += 512) dst[i] = src[i]; }
    __syncthreads();
    bf16_t* BT2 = (bf16_t*)(ws + WS_BT2) + (size_t)g * 1024 * 1152;
    for (int i = tid; i < 128 * 144; i += 512) {
        const int rl = i / 144, cc = i % 144, t = 8 * part + (rl >> 4), hp = rl & 15;
        float v[8];
        if (cc < 128) {
            const int s = cc >> 1, h0 = (cc & 1) * 8;
            if (s <= t) {
#pragma unroll
                for (int j = 0; j < 8; ++j) v[j] = KT[(t - s) * KTS + hp * 16 + h0 + j];
            } else {
#pragma unroll
                for (int j = 0; j < 8; ++j) v[j] = 0.f;
            }
        } else {
            const int p0 = (cc - 128) * 4;
#pragma unroll
            for (int j = 0; j < 4; ++j) { const f32x2 c = CC[hp * 64 + p0 + j], ap = AP[(p0 + j) * 65 + t + 1];
                v[2 * j] = c.x * ap.x - c.y * ap.y; v[2 * j + 1] = -(c.x * ap.y + c.y * ap.x); }
        }
        *(u32x4*)(BT2 + (size_t)(t * 16 + hp) * 1152 + cc * 8) = pack8(v);
    }
    bf16_t* BT1 = (bf16_t*)(ws + WS_BT1) + (size_t)g * 128 * 1152;
    for (int i = tid; i < 16 * 128; i += 512) {
        const int rl = i >> 7, cc = i & 127, p = 8 * part + (rl >> 1), ri = rl & 1, s = cc >> 1, h0 = (cc & 1) * 8;
        const f32x2 ap = AP[p * 65 + 63 - s];
        float v[8];
#pragma unroll
        for (int j = 0; j < 8; ++j) { const f32x2 b = BB[p * 16 + h0 + j]; v[j] = ri ? (ap.x * b.y + ap.y * b.x) : (ap.x * b.x - ap.y * b.y); }
        *(u32x4*)(BT1 + (size_t)(2 * p + ri) * 1152 + cc * 8) = pack8(v);
    }
    __syncthreads();
}

__device__ __forceinline__ void spatial_phase(LAS unsigned char* lds, unsigned char* ws, const float* ln_g, const float* ln_b, const float* b_s, int vcu, int G, const int tid) {
    __syncthreads();
    const int wid = __builtin_amdgcn_readfirstlane(tid >> 6), lane = tid & 63, fr = lane & 15, fq = lane >> 4;
    LAS f32x2* ST = (LAS f32x2*)lds;
    LAS bf16_t* VT = (LAS bf16_t*)(lds + 1024);
    LAS float* LG = (LAS float*)(lds + 36864);
    LAS float* LB = (LAS float*)(lds + 40960);
    const bf16_t* U = (const bf16_t*)(ws + WS_U); const bf16_t* V = (const bf16_t*)(ws + WS_V); bf16_t* YC = (bf16_t*)(ws + WS_SA);
    const bf16_t* WSP = (const bf16_t*)(ws + WS_WSP);
    for (int i = tid; i < 1024; i += 512) { LG[i] = ln_g[i]; LB[i] = ln_b[i]; }
    const int kmax = (16 * wid + 15) >> 5, t = 16 * wid + fr;
    for (int unit = vcu; unit < M_TOK / 128; unit += G) {
        const size_t r0 = (size_t)unit * 128;
        u32x4 vreg[4];
#pragma unroll
        for (int it = 0; it < 4; ++it) { const int idx = wid * 4 + it, s = (idx & 1) * 64 + lane, c0 = (idx >> 1) * 8; vreg[it] = *(const u32x4*)(V + (r0 + s) * DM + c0); }
        {
            const f32x4* pv = (const f32x4*)((const float*)(ws + WS_VST) + ((r0 + 16 * wid + (lane >> 2)) * 16 + 4 * (lane & 3)) * 2);
            const f32x4 p0 = pv[0], p1 = pv[1];
            float s1 = (p0[0] + p0[2]) + (p1[0] + p1[2]), s2 = (p0[1] + p0[3]) + (p1[1] + p1[3]);
            s1 += shx(s1, lane, 1); s1 += shx(s1, lane, 2); s2 += shx(s2, lane, 1); s2 += shx(s2, lane, 2);
            const float mean = s1 * (1.f / DM), var = fmaxf(s2 * (1.f / DM) - mean * mean, 0.f);
            if ((lane & 3) == 0) ST[16 * wid + (lane >> 2)] = (f32x2){mean, 1.f / sqrtf(var + EPS)};
        }
        __syncthreads();
        for (int g = 0; g < 8; ++g) {
#pragma unroll
            for (int it = 0; it < 4; ++it) {
                const int idx = wid * 4 + it, s = (idx & 1) * 64 + lane, c0 = (idx >> 1) * 8;
                float v[8]; unpack8(vreg[it], v);
                const f32x2 st = ST[s];
                const f32x4 g0 = *(const LAS f32x4*)(LG + g * 128 + c0), g1 = *(const LAS f32x4*)(LG + g * 128 + c0 + 4), e0 = *(const LAS f32x4*)(LB + g * 128 + c0), e1 = *(const LAS f32x4*)(LB + g * 128 + c0 + 4);
#pragma unroll
                for (int i = 0; i < 8; ++i) {
                    const int c = c0 + i, rho = (c & ~31) + 16 * ((c >> 2) & 1) + 4 * ((c & 31) >> 3) + (c & 3);
                    const float gm = i < 4 ? g0[i] : g1[i - 4], be = i < 4 ? e0[i] : e1[i - 4];
                    const float val = (v[i] - st.x) * st.y * gm + be;
                    VT[rho * 136 + s] = (bf16_t)(cvt_pk_bf16(val, 0.f) & 0xffffu);
                }
            }
            bf16x8 wf[4];
#pragma unroll
            for (int kk = 0; kk < 4; ++kk) if (kk <= kmax) wf[kk] = *(const bf16x8*)(WSP + ((size_t)(g * 128 + t)) * 128 + 32 * kk + 8 * fq);
            const float bias = b_s[g * 128 + t];
            u32x4 ureg[4];
#pragma unroll
            for (int b = 0; b < 4; ++b) ureg[b] = *(const u32x4*)(U + (r0 + t) * DM + g * 128 + b * 32 + 8 * fq);
            if (g < 7) {
#pragma unroll
                for (int it = 0; it < 4; ++it) { const int idx = wid * 4 + it, s = (idx & 1) * 64 + lane, c0 = (idx >> 1) * 8; vreg[it] = *(const u32x4*)(V + (r0 + s) * DM + (g + 1) * 128 + c0); }
            }
            __syncthreads();
            f32x4 acc[4][2];
#pragma unroll
            for (int b = 0; b < 4; ++b) { acc[b][0] = (f32x4){0.f, 0.f, 0.f, 0.f}; acc[b][1] = (f32x4){0.f, 0.f, 0.f, 0.f}; }
#pragma unroll
            for (int kk = 0; kk < 4; ++kk) if (kk <= kmax) {
#pragma unroll
                for (int b = 0; b < 4; ++b)
#pragma unroll
                    for (int n = 0; n < 2; ++n) {
                        const bf16x8 vf = *(const LAS bf16x8*)(VT + (b * 32 + 16 * n + fr) * 136 + 32 * kk + 8 * fq);
                        acc[b][n] = __builtin_amdgcn_mfma_f32_16x16x32_bf16(vf, wf[kk], acc[b][n], 0, 0, 0);
                    }
            }
#pragma unroll
            for (int b = 0; b < 4; ++b) {
                float u8[8]; unpack8(ureg[b], u8);
                float o[8];
#pragma unroll
                for (int j = 0; j < 4; ++j) { o[j] = (acc[b][0][j] + bias) * u8[j]; o[4 + j] = (acc[b][1][j] + bias) * u8[4 + j]; }
                *(u32x4*)(YC + (r0 + t) * DM + g * 128 + b * 32 + 8 * fq) = pack8(o);
            }
            __syncthreads();
        }
    }
}


#define XB_TMO      128
#define XB_XCNT(j)  (256  + 64 * (j))
#define XB_XSUB(j)  (1280 + 64 * (j))
#define XB_XGEN(j)  (2304 + 64 * (j))
#define XB_TOP      3328
#define XB_TOPGEN   3392
#define XB_SPIN_CAP (1u << 20)
__device__ __forceinline__ unsigned xb_ld(unsigned* p)              { return __hip_atomic_load(p, __ATOMIC_RELAXED, __HIP_MEMORY_SCOPE_AGENT); }
__device__ __forceinline__ unsigned xb_add(unsigned* p, unsigned v) { return __hip_atomic_fetch_add(p, v, __ATOMIC_RELAXED, __HIP_MEMORY_SCOPE_AGENT); }
__device__ __forceinline__ unsigned xb_xcc_id() { return (unsigned)__builtin_amdgcn_s_getreg((3 << 11) | 20) & 0xFu; }
#define XB_SPIN(cond, bar) do { unsigned _sp = 0; while (cond) { __builtin_amdgcn_s_sleep(1); \
    if ((++_sp & 255u) == 0u) { if (xb_ld(&(bar)[XB_TMO])) break; if (_sp > XB_SPIN_CAP) { atomicAdd(&(bar)[XB_TMO], 1u); break; } } } } while (0)
struct XcdBarrier { unsigned* bar; unsigned x; volatile LAS unsigned* st; };
__device__ __forceinline__ void xcd_barrier_post(unsigned* bar, int tid) { if (tid == 0) (void)xb_add(&bar[XB_XCNT(xb_xcc_id())], 1u); }
__device__ __forceinline__ void xcd_barrier_complete(unsigned* bar, unsigned x, unsigned& nloc, unsigned& nx) {
    const unsigned G = gridDim.x * gridDim.y * gridDim.z;
    unsigned sum, cnt, mine, sp = 0u;
    for (;;) {
        sum = 0u; cnt = 0u; mine = 0u;
#pragma unroll
        for (unsigned j = 0; j < 16; ++j) { const unsigned c = xb_ld(&bar[XB_XCNT(j)]); sum += c; cnt += (c > 0u) ? 1u : 0u; mine = (j == x) ? c : mine; }
        if (sum == G) break;
        __builtin_amdgcn_s_sleep(1);
        if ((++sp & 255u) == 0u) { if (xb_ld(&bar[XB_TMO])) break; if (sp > XB_SPIN_CAP) { atomicAdd(&bar[XB_TMO], 1u); break; } }
    }
    nloc = mine > 0u ? mine : 1u; nx = cnt > 0u ? cnt : 1u;
}
__device__ __forceinline__ void xcd_barrier(const XcdBarrier& b, int tid) {
    asm volatile("s_waitcnt vmcnt(0)" ::: "memory");
    __syncthreads();
    if (tid == 0) {
        unsigned* bar = b.bar;
        __builtin_amdgcn_s_waitcnt(0);
        unsigned nloc = b.st[0], nx = b.st[1];
        if (nloc == 0u) { xcd_barrier_complete(bar, b.x, nloc, nx); b.st[0] = nloc; b.st[1] = nx; }
        const unsigned old = xb_add(&bar[XB_XSUB(b.x)], 1u);
        const unsigned gen = old / nloc;
        if (old + 1u == (gen + 1u) * nloc) {
            __builtin_amdgcn_fence(__ATOMIC_RELEASE, "agent");
            asm volatile("s_waitcnt vmcnt(0)" ::: "memory");
            const unsigned og = xb_add(&bar[XB_TOP], 1u);
            const unsigned tg = og / nx;
            if (og + 1u == (tg + 1u) * nx) xb_add(&bar[XB_TOPGEN], 1u);
            else XB_SPIN(xb_ld(&bar[XB_TOPGEN]) == tg, bar);
            __builtin_amdgcn_fence(__ATOMIC_ACQUIRE, "agent");
            xb_add(&bar[XB_XGEN(b.x)], 1u);
            asm volatile("s_waitcnt vmcnt(0)" ::: "memory");
        } else {
            XB_SPIN(xb_ld(&bar[XB_XGEN(b.x)]) == gen, bar);
            __builtin_amdgcn_fence(__ATOMIC_ACQUIRE, "agent");
            asm volatile("s_waitcnt vmcnt(0)" ::: "memory");
        }
    }
    __syncthreads();
}

struct Args { const float* in[31]; float* out; unsigned char* ws; int ph_lo, ph_hi; };

__global__ void __launch_bounds__(512, 2) mk_fwd(Args args) {
    extern __shared__ __attribute__((aligned(16))) unsigned char lds_raw[];
    LAS unsigned char* lds = (LAS unsigned char*)lds_raw;
    const int G = gridDim.x, bx = blockIdx.x;
    const int vcu = (G % 8 == 0) ? (bx % 8) * (G / 8) + bx / 8 : bx;
    volatile LAS unsigned* xst = (volatile LAS unsigned*)(lds + LDS_XS + 8192);
    const bool multi = args.ph_hi - args.ph_lo > 1;
    if (multi) { if (threadIdx.x < 2) xst[threadIdx.x] = 0u; __syncthreads(); xcd_barrier_post((unsigned*)args.ws, (int)threadIdx.x); }

    for (int pi = args.ph_lo; pi < args.ph_hi; ++pi) {
        const int ph = pi;
        if (ph == 11 || ph == 12) continue;
        int tid = threadIdx.x; asm volatile("" : "+v"(tid));
        size_t wz = 0; asm volatile("" : "+s"(wz)); unsigned char* ws = args.ws + wz;
        const __attribute__((address_space(4))) char* kp = (const __attribute__((address_space(4))) char*)__builtin_amdgcn_kernarg_segment_ptr() + wz;
#define IN(i) ((const float*)(*(const __attribute__((address_space(1))) float* const __attribute__((address_space(4)))*)(kp + 8 * (i))))
        const int lane = tid & 63, wave = __builtin_amdgcn_readfirstlane(tid >> 6);
        const int gw = vcu * 8 + wave, NGW = G * 8;
        const bool panel_mode = (G == M_TOK / 256); const int panel = vcu;
        pg8::Epi E; E.ws = ws; E.lds = lds;
        bool is_gemm = false;
        if (ph == 0) {
            const bool split = (G % 32 == 0) && (G >= 128);
            const int nc = split ? (G / 32) * 12 : G, nm = split ? G - nc : G;
            const int ci = split ? (vcu % 32) * (G / 32) + (vcu / 32) : vcu, mi = split ? (vcu / 32) * 20 + (vcu % 32) - 12 : vcu;
            const bool do_c = !split || (vcu % 32) < 12, do_m = !split || (vcu % 32) >= 12;
            const int gwc = ci * 8 + wave, NGWC = nc * 8, gwm = mi * 8 + wave, NGWM = nm * 8;
            if (do_c) {
            for (int g = ci; g < 32; g += nc) s5_build(lds, ws, IN(8), IN(9), IN(10), IN(11), IN(12), IN(13), IN(14), IN(15), g, tid);
            LAS float* scr = (LAS float*)(lds + wave * 16384);
            constexpr int I_IN = 16 * (NIN / 32), I_BG = 16 * 32, I_BS = 8 * 32, I_MX = 16 * 32, I_GL = 8 * 16, I_Q = 16 * 32, I_KV = 16 * 64, I_O = 16 * 32, I_GU = 16 * (2 * FF / 32), I_DN = (FF / 64) * 32;
            constexpr int NIT = I_IN + I_BG + I_BS + I_MX + I_GL + I_KV + I_O + I_GU + I_DN;
            for (int it = gwc; it < NIT; it += NGWC) {
                int r = it;
                if (r < I_IN) { transpose_item(IN(3), NIN, (bf16_t*)(ws + WS_WIN), 1024, 0, 0, scr, r, lane); continue; } r -= I_IN;
                if (r < I_BG) { transpose_item(IN(17), 1024, (bf16_t*)(ws + WS_WBR), 1536, 0, 0, scr, r, lane); continue; } r -= I_BG;
                if (r < I_BS) { transpose_item(IN(18), 1024, (bf16_t*)(ws + WS_WBR), 1536, 1024, 0, scr, r, lane); continue; } r -= I_BS;
                if (r < I_MX) { transpose_item(IN(19), 1024, (bf16_t*)(ws + WS_WMIX), 1024, 0, 0, scr, r, lane); continue; } r -= I_MX;
                if (r < I_GL) { transpose_item(IN(16), 512, (bf16_t*)(ws + WS_WGLU), 512, 0, 0, scr, r, lane); continue; } r -= I_GL;
                if (r < I_KV) { transpose_item(IN(24), 2048, (bf16_t*)(ws + WS_WKV), 1152, 0, 0, scr, r, lane); continue; } r -= I_KV;
                if (r < I_O) { transpose_item(IN(25), 1024, (bf16_t*)(ws + WS_WO), 1024, 0, 0, scr, r, lane); continue; } r -= I_O;
                if (r < I_GU) { transpose_item(IN(28), 2 * FF, (bf16_t*)(ws + WS_WGU), 1024, 0, 1, scr, r, lane, IN(27)); continue; } r -= I_GU;
                transpose_item(IN(29), 1024, (bf16_t*)(ws + WS_WDN), FF, 0, 0, scr, r, lane);
            }
            {
                const float* w = IN(23); const float* gq = IN(21); bf16_t* o = (bf16_t*)(ws + WS_WQ);
                for (int i = ci * 512 + tid; i < 1024 * 1024 / 8; i += nc * 512) {
                    const int e = i * 8; const float gsc = gq[e >> 10];
                    const f32x4 a = *(const f32x4*)(w + e) * gsc, b = *(const f32x4*)(w + e + 4) * gsc;
                    float v[8] = {a[0], a[1], a[2], a[3], b[0], b[1], b[2], b[3]};
                    *(u32x4*)(o + e) = pack8(v);
                }
            }
            {
                const float* w = IN(6); bf16_t* o = (bf16_t*)(ws + WS_WSP);
                for (int i = ci * 512 + tid; i < 8 * 128 * 128 / 8; i += nc * 512) {
                    const int e = i * 8, s0 = e & 127, t = (e >> 7) & 127;
                    const f32x4 a = *(const f32x4*)(w + e), b = *(const f32x4*)(w + e + 4);
                    float v[8] = {a[0], a[1], a[2], a[3], b[0], b[1], b[2], b[3]};
#pragma unroll
                    for (int j = 0; j < 8; ++j) if (s0 + j > t) v[j] = 0.f;
                    *(u32x4*)(o + e) = pack8(v);
                }
            }
            }
            if (do_m) {
                int m = gwm;
                for (; m + 3 * NGWM < M_TOK; m += 4 * NGWM) rms_rows_to_bf16<4>(IN(0) + (size_t)m * DM, (size_t)NGWM * DM, IN(2), (bf16_t*)(ws + WS_SA) + (size_t)m * DM, (size_t)NGWM * DM, lane);
                for (; m < M_TOK; m += NGWM) rms_rows_to_bf16<1>(IN(0) + (size_t)m * DM, 0, IN(2), (bf16_t*)(ws + WS_SA) + (size_t)m * DM, 0, lane);
                for (m = gwm; m < NMEM; m += NGWM) rms_rows_to_bf16<1>(IN(1) + (size_t)m * DM, 0, IN(22), (bf16_t*)(ws + WS_MEMN) + (size_t)m * 1152, 0, lane);
            }
        } else if (ph == 1 || ph == 2) { is_gemm = true;
        } else if (ph == 3) { is_gemm = true;
        } else if (ph == 4 || ph == 5 || ph == 6 || ph == 7) { is_gemm = true;
        } else if (ph == 8) {
            if (panel_mode) rowpass<false, true>((const bf16_t*)(ws + WS_SA), IN(20), IN(0), ws + WS_X1B, nullptr, nullptr, (float*)(ws + WS_RS1), panel * 256 + wave, 8, lane, panel * 256 + 256);
            else rowpass<false, true>((const bf16_t*)(ws + WS_SA), IN(20), IN(0), ws + WS_X1B, nullptr, nullptr, (float*)(ws + WS_RS1), gw, NGW, lane, M_TOK);
        } else if (ph == 9 || ph == 10) { is_gemm = true;
        } else if (ph == 13) {
            if (panel_mode) rowpass<true, true>((const bf16_t*)(ws + WS_SD), IN(26), ws + WS_X1B, ws + WS_X2B, nullptr, nullptr, (float*)(ws + WS_RS2), panel * 256 + wave, 8, lane, panel * 256 + 256);
            else rowpass<true, true>((const bf16_t*)(ws + WS_SD), IN(26), ws + WS_X1B, ws + WS_X2B, nullptr, nullptr, (float*)(ws + WS_RS2), gw, NGW, lane, M_TOK);
        } else if (ph == 14 || ph == 15) { is_gemm = true;
        } else if (ph == 16) {
            if (panel_mode) rowpass<true, false>((const bf16_t*)(ws + WS_SC), IN(30), ws + WS_X2B, args.out, nullptr, nullptr, nullptr, panel * 256 + wave, 8, lane, panel * 256 + 256);
            else rowpass<true, false>((const bf16_t*)(ws + WS_SC), IN(30), ws + WS_X2B, args.out, nullptr, nullptr, nullptr, gw, NGW, lane, M_TOK);
        }
        if (is_gemm) {
            pg8::Sched S; S.ws = ws; S.ph = ph; S.G = G; S.c = bx; S.panel = (panel_mode && ph >= 6) ? panel : -1;
            const bool scan_wg = (ph == 3) && (G > 128) && (vcu < 64);
            if (ph == 3 && G > 128) { S.G = G - 64; S.c = vcu - 64; }
            S.n0 = pg8::phase_units(ph, 0); S.n1 = (ph == 2 || ph == 3) ? pg8::phase_units(ph, 1) : 0; S.total = S.n0 + S.n1;
            if (S.panel >= 0) S.total = (ph == 14) ? 2 * FF / 256 : 4;
            if (ph == 1) { for (int u = vcu; u < 256; u += G) s5_expand(lds, ws, u >> 3, u & 7, tid); }
            const bool sp_first = (ph == 2) && ((vcu >> 0) & 1);
            if (sp_first) spatial_phase(lds, ws, IN(4), IN(5), IN(7), vcu, G, tid);
            if (!scan_wg) pg8::gemm_phase(lds, S, E, tid);
            if (ph == 2 && !sp_first) spatial_phase(lds, ws, IN(4), IN(5), IN(7), vcu, G, tid);
            if (ph == 3) {
            const int gt = vcu * 512 + tid;
                if (gt < 16 * 32 * 64) {
                    const int p = gt & 63, g = (gt >> 6) & 31, b = gt >> 11;
                    const f32x2 a = ((const f32x2*)(ws + WS_A64))[g * 64 + p];
                    const float* Eb = (const float*)(ws + WS_EBUF); bf16_t* UC = (bf16_t*)(ws + WS_UC);
                    float cr = 0.f, ci = 0.f;
    #pragma unroll 8
                    for (int k = 0; k < 64; ++k) {
                        const size_t row = (size_t)g * 1024 + b * 64 + k;
                        const f32x2 e = *(const f32x2*)(Eb + row * 128 + 2 * p);
                        *(unsigned*)(UC + row * 1152 + 1024 + 2 * p) = cvt_pk_bf16(cr, ci);
                        const float nr = a.x * cr - a.y * ci + e.x, ni = a.x * ci + a.y * cr + e.y; cr = nr; ci = ni;
                    }
                }

            }
        }
        if (pi + 1 < args.ph_hi) {
            if (panel_mode && ph >= 6 && ph != 16) {
                asm volatile("s_waitcnt vmcnt(0) lgkmcnt(0)" ::: "memory");
                __syncthreads();
                __builtin_amdgcn_fence(__ATOMIC_ACQUIRE, "agent");
                asm volatile("s_waitcnt vmcnt(0)" ::: "memory");
                __syncthreads();
            } else if (args.ph_hi > 4096) cg::this_grid().sync();
            else { XcdBarrier xb; xb.bar = (unsigned*)ws; xb.x = xb_xcc_id(); xb.st = xst; xcd_barrier(xb, tid); }
        }
    }
}

extern "C" void kernel_launch(void* const* d_in, const int* in_sizes, int n_in, void* d_out, int out_size, void* d_ws, size_t ws_size, hipStream_t stream) {
    static int grid = 0;
    if (grid == 0) {
        if (n_in != 31 || in_sizes[0] != M_TOK * DM || out_size != M_TOK * DM || ws_size < WS_END) { fprintf(stderr, "kernel_launch: unexpected problem (n_in %d, ws %zu)\n", n_in, ws_size); grid = -1; return; }
        int dev = 0, cus = 0, per_cu = 0;
        hipGetDevice(&dev); hipDeviceGetAttribute(&cus, hipDeviceAttributeMultiprocessorCount, dev);
        hipFuncSetAttribute((const void*)mk_fwd, hipFuncAttributeMaxDynamicSharedMemorySize, LDS_BYTES);
        hipOccupancyMaxActiveBlocksPerMultiprocessor(&per_cu, (const void*)mk_fwd, 512, LDS_BYTES);
        if (per_cu < 1) { fprintf(stderr, "kernel_launch: occupancy query says %d blocks per CU\n", per_cu); per_cu = 1; }
        (void)hipGetLastError();
        grid = cus;
    }
    if (grid < 0) return;
    Args a{};
    for (int i = 0; i < 31; ++i) a.in[i] = (const float*)d_in[i];
    a.out = (float*)d_out; a.ws = (unsigned char*)d_ws;
#if MK_ONE_LAUNCH
    (void)hipMemsetAsync(d_ws, 0, 65536, stream);
    a.ph_lo = 0; a.ph_hi = NPHASE;
    void* kargs[] = {&a};
    hipError_t e = hipLaunchCooperativeKernel((const void*)mk_fwd, dim3(grid), dim3(512), kargs, LDS_BYTES, stream);
    if (e != hipSuccess) fprintf(stderr, "cooperative launch failed: %s (grid %d)\n", hipGetErrorString(e), grid);

#else
    for (int ph = 0; ph < NPHASE; ++ph) {
        a.ph_lo = ph; a.ph_hi = ph + 1;
        hipLaunchKernelGGL(mk_fwd, dim3(grid), dim3(512), LDS_BYTES, stream, a);
    }
#endif
}
```

```cpp
#include <hip/hip_runtime.h>
#include <hip/hip_cooperative_groups.h>
#include <cstdint>
#include <cstdio>
namespace cg = cooperative_groups;

#define FFN_GRID(p) ((p) == 6 || (p) == 7 || (p) == 9 || (p) == 10 || (p) == 14 || (p) == 15)
#ifndef MK_ONE_LAUNCH
#define MK_ONE_LAUNCH 1
#endif

#define LAS __attribute__((address_space(3)))
typedef unsigned short bf16_t;
typedef short bf16x8 __attribute__((ext_vector_type(8)));
typedef float f32x4 __attribute__((ext_vector_type(4)));
typedef float f32x2 __attribute__((ext_vector_type(2)));
typedef unsigned u32x4 __attribute__((ext_vector_type(4)));
typedef unsigned u32x2 __attribute__((ext_vector_type(2)));

constexpr int M_TOK = 65536, DM = 1024, NIN = 4608, FF = 2816, NMEM = 4096, SEQ = 4096;
constexpr float EPS = 1e-6f;
constexpr int NPHASE = 17;
constexpr size_t MiB = 1u << 20;
constexpr size_t WS_WIN = 1 * MiB, WS_WBR = 10 * MiB, WS_WMIX = 13 * MiB, WS_WGLU = 15 * MiB, WS_WQ = 16 * MiB, WS_WKV = 18 * MiB  , WS_WO = 23 * MiB,
                 WS_WGU = 25 * MiB, WS_WDN = 36 * MiB, WS_WSP = 42 * MiB, WS_A64 = 42 * MiB + 256 * 1024, WS_RS1 = 42 * MiB + 320 * 1024  , WS_RS2 = 42 * MiB + 576 * 1024  , WS_KB = 43 * MiB, WS_VB = 51 * MiB  ;
constexpr size_t WS_SA = 59 * MiB, WS_SB = 187 * MiB, WS_SC = 315 * MiB, WS_SD = 443 * MiB;
constexpr size_t WS_ACT = 571 * MiB;
constexpr size_t WS_BT1 = 571 * MiB  , WS_BT2 = 581 * MiB, WS_EBUF = 653 * MiB, WS_MEMN = 669 * MiB  , WS_UC = 678 * MiB,
                 WS_U = 750 * MiB  , WS_V = 878 * MiB, WS_S5T = 1006 * MiB  , WS_END = 1010 * MiB;
constexpr size_t WS_X1B = WS_SB, WS_X2B = WS_SA;
constexpr size_t WS_VST = WS_SB;
constexpr size_t WS_MB = 942 * MiB, WS_NB = 974 * MiB;
constexpr int KTS = 257;
constexpr int S5T_BYTES = 49664 + 64 * KTS * 4;
constexpr int LDS_RING = 131072, LDS_XS = 131072, LDS_BYTES = 147456;

typedef __bf16 bf16v2 __attribute__((ext_vector_type(2)));
__device__ __forceinline__ unsigned cvt_pk_bf16(float lo, float hi) { const f32x2 f = {lo, hi}; const bf16v2 v = __builtin_convertvector(f, bf16v2); return __builtin_bit_cast(unsigned, v); }
__device__ __forceinline__ float bf_lo(unsigned w) { return __uint_as_float(w << 16); }
__device__ __forceinline__ float bf_hi(unsigned w) { return __uint_as_float(w & 0xffff0000u); }
__device__ __forceinline__ float fsigmoid(float x) { return __builtin_amdgcn_rcpf(1.f + __builtin_amdgcn_exp2f(-1.4426950408889634f * x)); }
__device__ __forceinline__ float gelu_t(float x) { const float y = 1.5957691216057308f * (x + 0.044715f * x * x * x); return x * fsigmoid(y); }
__device__ __forceinline__ float shx(float v, int lane, int o) { return __int_as_float(__builtin_amdgcn_ds_bpermute((lane ^ o) << 2, __float_as_int(v))); }
__device__ __forceinline__ float wave_sum(float v, int lane) {
#pragma unroll
    for (int o = 1; o < 64; o <<= 1) v += shx(v, lane, o);
    return v;
}
__device__ __forceinline__ void unpack8(const u32x4 w, float (&v)[8]) {
    v[0] = bf_lo(w.x); v[1] = bf_hi(w.x); v[2] = bf_lo(w.y); v[3] = bf_hi(w.y); v[4] = bf_lo(w.z); v[5] = bf_hi(w.z); v[6] = bf_lo(w.w); v[7] = bf_hi(w.w);
}
__device__ __forceinline__ u32x4 pack8(const float (&v)[8]) {
    u32x4 w; w.x = cvt_pk_bf16(v[0], v[1]); w.y = cvt_pk_bf16(v[2], v[3]); w.z = cvt_pk_bf16(v[4], v[5]); w.w = cvt_pk_bf16(v[6], v[7]); return w;
}

namespace pg8 {
constexpr int BM = 256, BK = 64, HALF = 128, HTB = HALF * BK * 2, NXCD = 8, WGM = 8;
__host__ __device__ __forceinline__ int lds_byte(int r, int c) { const int st = (r >> 4) * 2 + (c >> 5), rr = r & 15, cc = c & 31, ob = rr * 64 + cc * 2; return st * 1024 + (ob ^ (((ob >> 9) & 1) << 5)); }
__host__ __device__ __forceinline__ void stage_rc(int b, int& R, int& C) { const int st = b / 1024, sb = b % 1024, swz = sb ^ (((sb >> 9) & 1) << 5); R = (st >> 1) * 16 + swz / 64; C = (st & 1) * 32 + (swz % 64) / 2; }
__host__ __device__ __forceinline__ int perm32(int rho) { const int n = rho >> 4, i = rho & 15; return 8 * (i >> 2) + 4 * n + (i & 3); }

enum Kind { K_IN = 0, K_KVPROJ, K_MB, K_NB, K_S5E, K_S5Y, K_GLU, K_BR, K_MIX, K_SMAX, K_OPROJ, K_GU, K_DOWN };

struct Unit { const char* A; const char* B; int lda, cha, ldb, nt, pn, kind, orow, ocol; };
struct Desc {
    const char* A; const char* B; int lda, cha, ldb, nt, nM, nN, nZ0; long zsA0, zsA1, zsB0, zsB1; int kind, orz0, orz1, ocz0;
    __device__ __forceinline__ void fill(int w, Unit& u) const {
        const int per = nM * nN, z = w / per, r = w % per;
        const int nig = WGM * nN, gid = r / nig, fm = gid * WGM, gsz = (nM - fm) < WGM ? (nM - fm) : WGM;
        const int pm = fm + ((r % nig) % gsz), pn = (r % nig) / gsz;
        const int z0 = z % nZ0, z1 = z / nZ0;
        fill_pz(pm, pn, z0, z1, u);
    }
    __device__ __forceinline__ void fill_pz(int pm, int pn, int z0, int z1, Unit& u) const {
        u.pn = pn;
        u.A = A + z0 * zsA0 + z1 * zsA1 + (long)pm * BM * lda * 2;
        u.B = B + z0 * zsB0 + z1 * zsB1 + (long)pn * BM * ldb * 2;
        u.lda = lda; u.cha = cha; u.ldb = ldb; u.nt = nt; u.kind = kind;
        u.orow = pm * BM + z0 * orz0 + z1 * orz1; u.ocol = pn * BM + z0 * ocz0;
    }
};
__device__ __forceinline__ Desc mk_desc(const void* A, const void* B, int lda, int ldb, int K, int Mrows, int Ncols, int kind) {
    Desc d; d.A = (const char*)A; d.B = (const char*)B; d.lda = lda; d.cha = 16; d.ldb = ldb; d.nt = K / BK; d.nM = Mrows / BM; d.nN = Ncols / BM; d.nZ0 = 1;
    d.zsA0 = d.zsA1 = d.zsB0 = d.zsB1 = 0; d.kind = kind; d.orz0 = d.orz1 = d.ocz0 = 0; return d;
}
__device__ __forceinline__ Desc phase_desc(int ph, int sub, unsigned char* ws) {
    Desc d;
    if (ph == 1) { d = mk_desc(ws + WS_SA, ws + WS_WIN, 1024, 1024, 1024, M_TOK, NIN, K_IN);
    } else if (ph == 2) {
        if (sub == 0) { d = mk_desc(ws + WS_UC, ws + WS_BT1, 1152, 1152, 1024, 1024, 256, K_S5E); d.nZ0 = 32; d.zsA0 = 1024L * 1152 * 2; d.zsB0 = 128L * 1152 * 2; d.orz0 = 1024; }
        else d = mk_desc(ws + WS_MEMN, ws + WS_WKV, 1152, 1152, 1024, NMEM, 2048, K_KVPROJ);
    } else if (ph == 3) {
        if (sub == 0) { d = mk_desc(ws + WS_KB, ws + WS_WQ, 1024, 1024, 256, 256, 1024, K_MB); d.nZ0 = 4; d.zsA0 = 256 * 2; d.zsA1 = 256L * 1024 * 2; d.zsB0 = 256 * 2; d.orz0 = 256; d.orz1 = 1024; }
        else { d = mk_desc(ws + WS_WO, ws + WS_VB, 1024, 1024, 256, 1024, 256, K_NB); d.nZ0 = 4; d.zsA0 = 256 * 2; d.zsB0 = 256 * 2; d.zsB1 = 256L * 1024 * 2; d.orz1 = 1024; d.ocz0 = 256; }
    } else if (ph == 4) { d = mk_desc(ws + WS_UC, ws + WS_BT2, 1152, 1152, 1152, 1024, 1024, K_S5Y); d.nZ0 = 32; d.zsA0 = 1024L * 1152 * 2; d.zsB0 = 1024L * 1152 * 2; d.orz0 = 1024;
    } else if (ph == 5) { d = mk_desc(ws + WS_U, ws + WS_WGLU, 16, 512, 512, M_TOK, 512, K_GLU); d.cha = M_TOK * 16;
    } else if (ph == 6) { d = mk_desc(ws + WS_SA, ws + WS_WBR, 1024, 1536, 1536, M_TOK, 1024, K_BR);
    } else if (ph == 7) { d = mk_desc(ws + WS_SC, ws + WS_WMIX, 1024, 1024, 1024, M_TOK, 1024, K_MIX);
    } else if (ph == 9) {
        d = mk_desc(ws + WS_SB, ws + WS_MB, 1024, 1024, 1024, SEQ, 1024, K_SMAX); d.zsA1 = (long)SEQ * 1024 * 2; d.zsB1 = 1024L * 1024 * 2; d.orz1 = SEQ;
    } else if (ph == 10) {
        d = mk_desc(ws + WS_SC, ws + WS_NB, 1024, 1024, 1024, SEQ, 1024, K_OPROJ); d.zsA1 = (long)SEQ * 1024 * 2; d.zsB1 = 1024L * 1024 * 2; d.orz1 = SEQ;
    } else if (ph == 14) { d = mk_desc(ws + WS_SA, ws + WS_WGU, 1024, 1024, 1024, M_TOK, 2 * FF, K_GU);
    } else { d = mk_desc(ws + WS_ACT, ws + WS_WDN, FF, FF, FF, M_TOK, 1024, K_DOWN); }
    return d;
}
__device__ __forceinline__ int phase_units(int ph, int sub) {
    switch (ph) {
        case 1: return (M_TOK / BM) * (NIN / BM);
        case 2: return sub == 0 ? 32 * 4 : (sub == 1 ? 128 : 0);
        case 3: return sub < 2 ? 256 : 0;
        case 4: return 32 * 16;
        case 5: return (M_TOK / BM) * 2;
        case 14: return (M_TOK / BM) * (2 * FF / BM);
        default: return (M_TOK / BM) * 4;
    }
}
struct Sched {
    unsigned char* ws; int ph, n0, n1, total, G, c, panel;
    __device__ __forceinline__ bool next(int i, Unit& u) const {
        if (panel >= 0) {
            if (i >= total) return false;
            const Desc d = phase_desc(ph, 0, ws);
            if (ph == 9 || ph == 10) d.fill_pz(panel & 15, i, 0, panel >> 4, u); else d.fill_pz(panel, i, 0, 0, u);
            return true;
        }
        const long L = (long)i * G + c; if (L >= total) return false;
        int wgid = (int)L; { const int q = total / NXCD, r = total % NXCD, xcd = wgid % NXCD, off = wgid / NXCD; wgid = (xcd < r ? xcd * (q + 1) : r * (q + 1) + (xcd - r) * q) + off; }
        int sub = 0; if (wgid >= n0) { sub = 1; wgid -= n0; if (wgid >= n1) { sub = 2; wgid -= n1; } }
        const Desc d = phase_desc(ph, sub, ws); d.fill(wgid, u);
        return true;
    }
};
struct Drv { unsigned vA0, vA1, vB0, vB1, kA, hA, hB; };
__device__ __forceinline__ Drv derive(const Unit& u, int tid) {
    int R0, C0, R1, C1; stage_rc(tid * 16, R0, C0); stage_rc(tid * 16 + 8192, R1, C1);
    const int Rb0 = (R0 & ~31) + perm32(R0 & 31), Rb1 = (R1 & ~31) + perm32(R1 & 31);
    Drv d;
    d.vA0 = (unsigned)(R0 * u.lda + (C0 >> 4) * u.cha + (C0 & 15)) * 2u; d.vA1 = (unsigned)(R1 * u.lda + (C1 >> 4) * u.cha + (C1 & 15)) * 2u;
    d.vB0 = (unsigned)(Rb0 * u.ldb + C0) * 2u; d.vB1 = (unsigned)(Rb1 * u.ldb + C1) * 2u;
    d.kA = (unsigned)(8 * u.cha); d.hA = (unsigned)(HALF * 2 * u.lda); d.hB = (unsigned)(HALF * 2 * u.ldb);
    return d;
}

struct Epi {
    unsigned char* ws; LAS unsigned char* lds;
    __device__ __forceinline__ void get8(const f32x4 (&acc)[2][2][4][2], int ai, int bj, int m, float (&v)[8]) const {
        const f32x4 a = acc[ai][bj][m][0], b = acc[ai][bj][m][1];
        v[0] = a[0]; v[1] = a[1]; v[2] = a[2]; v[3] = a[3]; v[4] = b[0]; v[5] = b[1]; v[6] = b[2]; v[7] = b[3];
    }
    __device__ __forceinline__ void mid(f32x4 (&acc)[2][2][4][2], const Unit& u, int wr, int wc, int fr, int fq) const {
        const bf16_t* GA = (const bf16_t*)(ws + WS_SC); const bf16_t* GB = (const bf16_t*)(ws + WS_SD);
        int rb = u.orow + wr * 64 + fr; asm volatile("" : "+v"(rb));
        int cb = u.ocol + wc * 32 + 8 * fq; asm volatile("" : "+v"(cb));
#pragma unroll
        for (int ai = 0; ai < 2; ++ai) {
            u32x4 ga[4][2], gb[4][2];
#pragma unroll
            for (int m = 0; m < 4; ++m)
#pragma unroll
                for (int bj = 0; bj < 2; ++bj) { const size_t o = (size_t)(rb + ai * HALF + m * 16) * DM + cb + bj * HALF; ga[m][bj] = *(const u32x4*)(GA + o); gb[m][bj] = *(const u32x4*)(GB + o); }
#pragma unroll
            for (int m = 0; m < 4; ++m)
#pragma unroll
                for (int bj = 0; bj < 2; ++bj) {
                    float a[8], b[8]; unpack8(ga[m][bj], a); unpack8(gb[m][bj], b);
#pragma unroll
                    for (int j = 0; j < 8; ++j) { const float r = a[j] * __builtin_amdgcn_rcpf(fmaxf(b[j], 1e-30f)); asm volatile("v_mul_f32 %0, %0, %1" : "+v"(acc[ai][bj][m][j >> 2][j & 3]) : "v"(r)); }
                }
            asm volatile("" ::: "memory");
        }
    }
    __device__ __forceinline__ void operator()(const f32x4 (&acc)[2][2][4][2], const Unit& u, int wr, int wc, int fr, int fq) const {
        const int kind = u.kind;
        if (kind == K_SMAX) {
            LAS f32x2* XS = (LAS f32x2*)(lds + LDS_XS);
            int rls = wr * 64 + fr; asm volatile("" : "+v"(rls));
            bf16_t* P = (bf16_t*)(ws + WS_SC); const float* RS = (const float*)(ws + WS_RS1);
            int rbs = u.orow + wr * 64 + fr; asm volatile("" : "+v"(rbs));
            float rsv[2][4];
#pragma unroll
            for (int ai = 0; ai < 2; ++ai)
#pragma unroll
                for (int m = 0; m < 4; ++m) rsv[ai][m] = RS[rbs + ai * HALF + m * 16] * 1.4426950408889634f;
#pragma unroll
            for (int ai = 0; ai < 2; ++ai)
#pragma unroll
                for (int m = 0; m < 4; ++m) {
                    const float rs = rsv[ai][m];
                    float mx = -3.0e38f;
#pragma unroll
                    for (int bj = 0; bj < 2; ++bj)
#pragma unroll
                        for (int n = 0; n < 2; ++n)
#pragma unroll
                            for (int j = 0; j < 4; ++j) mx = fmaxf(mx, acc[ai][bj][m][n][j]);
                    mx = fmaxf(mx, shx(mx, fr + 16 * fq, 16)); mx = fmaxf(mx, shx(mx, fr + 16 * fq, 32));
                    float s = 0.f;
#pragma unroll
                    for (int bj = 0; bj < 2; ++bj)
#pragma unroll
                        for (int n = 0; n < 2; ++n)
#pragma unroll
                            for (int j = 0; j < 4; ++j) s += __builtin_amdgcn_exp2f((acc[ai][bj][m][n][j] - mx) * rs);
                    s += shx(s, fr + 16 * fq, 16); s += shx(s, fr + 16 * fq, 32);
                    if (fq == 0) XS[(rls + ai * HALF + m * 16) * 4 + wc] = (f32x2){mx * rs, s};
                }
            asm volatile("s_waitcnt lgkmcnt(0)" ::: "memory"); __builtin_amdgcn_s_barrier(); asm volatile("" ::: "memory");
#pragma unroll
            for (int ai = 0; ai < 2; ++ai)
#pragma unroll
                for (int m = 0; m < 4; ++m) {
                    const int rl = rls + ai * HALF + m * 16;
                    const f32x2 p0 = XS[rl * 4 + 0], p1 = XS[rl * 4 + 1], p2 = XS[rl * 4 + 2], p3 = XS[rl * 4 + 3];
                    const f32x2 me = XS[rl * 4 + wc];
                    const float MX = fmaxf(fmaxf(p0.x, p1.x), fmaxf(p2.x, p3.x));
                    const float L = p0.y * __builtin_amdgcn_exp2f(p0.x - MX) + p1.y * __builtin_amdgcn_exp2f(p1.x - MX) + p2.y * __builtin_amdgcn_exp2f(p2.x - MX) + p3.y * __builtin_amdgcn_exp2f(p3.x - MX);
                    const float f = 1.0f / L; (void)me;
                    const size_t row = (size_t)(u.orow + rl);
                    const float rs = rsv[ai][m];
#pragma unroll
                    for (int bj = 0; bj < 2; ++bj) {
                        float v[8]; get8(acc, ai, bj, m, v);
#pragma unroll
                        for (int j = 0; j < 8; ++j) v[j] = __builtin_amdgcn_exp2f(v[j] * rs - MX) * f;
                        *(u32x4*)(P + row * DM + u.ocol + bj * HALF + wc * 32 + 8 * fq) = pack8(v);
                    }
                }
            asm volatile("s_waitcnt lgkmcnt(0)" ::: "memory"); __builtin_amdgcn_s_barrier(); asm volatile("" ::: "memory");
            return;
        }
        if (kind == K_GU) {
            bf16_t* ACT = (bf16_t*)(ws + WS_ACT);
            int rb = u.orow + wr * 64 + fr; asm volatile("" : "+v"(rb));
            float rsv[2][4];
#pragma unroll
            for (int ai = 0; ai < 2; ++ai)
#pragma unroll
                for (int m = 0; m < 4; ++m) rsv[ai][m] = ((const float*)(ws + WS_RS2))[rb + ai * HALF + m * 16];
#pragma unroll
            for (int ai = 0; ai < 2; ++ai)
#pragma unroll
                for (int m = 0; m < 4; ++m) {
                    const size_t row = (size_t)(rb + ai * HALF + m * 16);
                    const float rs = rsv[ai][m];
                    float g[8], w[8]; get8(acc, ai, 0, m, g); get8(acc, ai, 1, m, w);
#pragma unroll
                    for (int j = 0; j < 8; ++j) { const float gg = g[j] * rs; g[j] = gg * fsigmoid(gg) * (w[j] * rs); }
                    *(u32x4*)(ACT + row * FF + u.pn * HALF + wc * 32 + 8 * fq) = pack8(g);
                }
            return;
        }
        if (kind == K_S5E) {
            float* E = (float*)(ws + WS_EBUF);
            int rb = u.orow + wr * 64 + fr; asm volatile("" : "+v"(rb));
            int cb = wc * 32 + 8 * fq; asm volatile("" : "+v"(cb));
#pragma unroll
            for (int ai = 0; ai < 2; ++ai)
#pragma unroll
                for (int m = 0; m < 4; ++m) {
                    const size_t row = (size_t)(rb + ai * HALF + m * 16);
                    float* p = E + row * 128 + cb;
                    *(f32x4*)p = acc[ai][0][m][0]; *(f32x4*)(p + 4) = acc[ai][0][m][1];
                }
            return;
        }
        if (kind == K_IN) {
            const int pn = u.pn;
            if (pn < 4) tiles<1>(acc, u.orow, wr, wc, fr, fq, (bf16_t*)(ws + WS_U), DM, pn * BM, nullptr);
            else if (pn < 8) tiles<7>(acc, u.orow, wr, wc, fr, fq, (bf16_t*)(ws + WS_V), DM, (pn & 3) * BM, (const bf16_t*)(ws + WS_VST));
            else if (pn < 10) tiles<3>(acc, u.orow, wr, wc, fr, fq, (bf16_t*)(ws + WS_UC), 0, (pn - 8) * BM, nullptr);
            else tiles<2>(acc, u.orow, wr, wc, fr, fq, (bf16_t*)(ws + (pn < 14 ? WS_SC : WS_SD)), DM, ((pn - 10) & 3) * BM, nullptr);
        } else if (kind == K_KVPROJ) tiles<0>(acc, u.orow, wr, wc, fr, fq, (bf16_t*)(ws + (u.pn < 4 ? WS_KB : WS_VB)), DM, (u.pn & 3) * BM, nullptr);
        else if (kind == K_MB) tiles<6>(acc, u.orow, wr, wc, fr, fq, (bf16_t*)(ws + WS_MB), DM, u.ocol, nullptr);
        else if (kind == K_NB) tiles<0>(acc, u.orow, wr, wc, fr, fq, (bf16_t*)(ws + WS_NB), DM, u.ocol, nullptr);
        else if (kind == K_S5Y) tiles<1>(acc, u.orow, wr, wc, fr, fq, (bf16_t*)(ws + WS_U), 1024, u.ocol, nullptr);
        else if (kind == K_GLU) tiles<4>(acc, u.orow, wr, wc, fr, fq, (bf16_t*)(ws + WS_SB), DM, u.ocol, (const bf16_t*)(ws + WS_U));
        else if (kind == K_BR) tiles<5>(acc, u.orow, wr, wc, fr, fq, (bf16_t*)(ws + WS_SC), DM, u.ocol, (const bf16_t*)(ws + WS_SD));
        else if (kind == K_MIX) tiles<0>(acc, u.orow, wr, wc, fr, fq, (bf16_t*)(ws + WS_SA), DM, u.ocol, nullptr);
        else if (kind == K_OPROJ) tiles<0>(acc, u.orow, wr, wc, fr, fq, (bf16_t*)(ws + WS_SD), DM, u.ocol, nullptr);
        else tiles<0>(acc, u.orow, wr, wc, fr, fq, (bf16_t*)(ws + WS_SC), DM, u.ocol, nullptr);
    }
    template <int MODE>
    __device__ __forceinline__ void tiles(const f32x4 (&acc)[2][2][4][2], int orow, int wr, int wc, int fr, int fq, bf16_t* base, int ld, int colbase, const bf16_t* aux) const {
        int rb = orow + wr * 64 + fr; asm volatile("" : "+v"(rb));
        int cb = colbase + wc * 32 + 8 * fq; asm volatile("" : "+v"(cb));
#pragma unroll
        for (int ai = 0; ai < 2; ++ai) {
            u32x4 ax[4][2];
            if (MODE == 4 || MODE == 5) {
#pragma unroll
                for (int m = 0; m < 4; ++m)
#pragma unroll
                    for (int bj = 0; bj < 2; ++bj) {
                        const size_t row = (size_t)(rb + ai * HALF + m * 16); const int col = cb + bj * HALF;
                        if (MODE == 4) ax[m][bj] = *(const u32x4*)(aux + ((size_t)(col >> 4) * M_TOK + row) * 16 + (col & 15));
                        else ax[m][bj] = *(const u32x4*)(aux + row * DM + col);
                    }
            }
#pragma unroll
            for (int m = 0; m < 4; ++m) {
                const int rowi = rb + ai * HALF + m * 16; const size_t row = (size_t)rowi;
                float st1 = 0.f, st2 = 0.f;
#pragma unroll
                for (int bj = 0; bj < 2; ++bj) {
                    const int col = cb + bj * HALF;
                    float v[8]; get8(acc, ai, bj, m, v);
                    bf16_t* dst = base + row * ld + col;
                    if (MODE == 1 || MODE == 7) {
#pragma unroll
                        for (int j = 0; j < 8; ++j) v[j] = gelu_t(v[j]);
                        if (MODE == 7) {
#pragma unroll
                            for (int j = 0; j < 8; ++j) { st1 += v[j]; st2 += v[j] * v[j]; }
                        }
                    } else if (MODE == 2) {
#pragma unroll
                        for (int j = 0; j < 8; ++j) v[j] = fsigmoid(v[j]);
                    } else if (MODE == 3) {
                        const int g = col >> 4, h0 = col & 15;
                        dst = base + ((size_t)(g * 1024 + (rowi >> 6))) * 1152 + (rowi & 63) * 16 + h0;
                    } else if (MODE == 4) {
                        float y[8]; unpack8(ax[m][bj], y);
#pragma unroll
                        for (int j = 0; j < 8; ++j) v[j] = y[j] * fsigmoid(v[j]);
                    } else if (MODE == 5) {
                        float b[8]; unpack8(ax[m][bj], b);
#pragma unroll
                        for (int j = 0; j < 8; ++j) v[j] *= b[j];
                    } else if (MODE == 6) {
#pragma unroll
                        for (int j = 0; j < 8; ++j) v[j] *= 0.0625f;
                    }
                    *(u32x4*)dst = pack8(v);
                }
                if (MODE == 7) {
                    st1 += shx(st1, fr + 16 * fq, 16); st1 += shx(st1, fr + 16 * fq, 32); st2 += shx(st2, fr + 16 * fq, 16); st2 += shx(st2, fr + 16 * fq, 32);
                    if (fq == 0) ((f32x2*)aux)[row * 16 + (colbase >> 8) * 4 + wc] = (f32x2){st1, st2};
                }
                if (MODE != 4 && MODE != 5) asm volatile("" ::: "memory");
            }
            asm volatile("" ::: "memory");
        }
    }
};

__device__ __forceinline__ void gemm_phase(LAS unsigned char* lds, const Sched& S, const Epi& E, const int tid) {
    const int wid = __builtin_amdgcn_readfirstlane(tid >> 6), lane = tid & 63, wr = wid >> 2, wc = wid & 3, fr = lane & 15, fq = lane >> 4;
    const unsigned ldsw = (unsigned)wid * 1024u;
    const int aoff = lds_byte(wr * 64 + fr, fq * 8), boff = lds_byte(wc * 32 + fr, fq * 8);
#define PG8_SA(b, h) (((b) * 2 + (h)) * HTB)
#define PG8_SB(b, h) ((4 + (b) * 2 + (h)) * HTB)
#define PG8_STAGE(bufoff, gbase, v0, v1) do { \
        __builtin_amdgcn_global_load_lds((const unsigned*)((const char*)(gbase) + (v0)), (LAS unsigned*)(lds + (bufoff) + ldsw), 16, 0, 0); \
        __builtin_amdgcn_global_load_lds((const unsigned*)((const char*)(gbase) + (v1)), (LAS unsigned*)(lds + (bufoff) + ldsw + 8192), 16, 0, 0); } while (0)
#define PG8_LDA(dst, b, h) do { _Pragma("unroll") for (int m = 0; m < 4; ++m) _Pragma("unroll") for (int k = 0; k < 2; ++k) dst[m][k] = *(const LAS bf16x8*)(lds + PG8_SA(b, h) + aoff + m * 2048 + k * 1024); } while (0)
#define PG8_LDB(dst, b, h) do { _Pragma("unroll") for (int n = 0; n < 2; ++n) _Pragma("unroll") for (int k = 0; k < 2; ++k) dst[n][k] = *(const LAS bf16x8*)(lds + PG8_SB(b, h) + boff + n * 2048 + k * 1024); } while (0)
#define PG8_MMA(ai, bj, At, Bt) do { __builtin_amdgcn_s_setprio(1); _Pragma("unroll") for (int m = 0; m < 4; ++m) _Pragma("unroll") for (int n = 0; n < 2; ++n) _Pragma("unroll") for (int k = 0; k < 2; ++k) \
        acc[ai][bj][m][n] = __builtin_amdgcn_mfma_f32_16x16x32_bf16(Bt[n][k], At[m][k], acc[ai][bj][m][n], 0, 0, 0); __builtin_amdgcn_s_setprio(0); } while (0)
#define PG8_WAIT_V(n) asm volatile("s_waitcnt vmcnt(" #n ")" ::: "memory")
#define PG8_WAIT_L(n) asm volatile("s_waitcnt lgkmcnt(" #n ")" ::: "memory")
#define PG8_BAR __builtin_amdgcn_s_barrier()
#define PG8_SCHED __builtin_amdgcn_sched_barrier(0)
    Unit cur, nxt; int ui = 0;
    if (!S.next(0, cur)) return;
    nxt = cur;
    f32x4 acc[2][2][4][2];
#pragma unroll
    for (int a = 0; a < 2; ++a)
#pragma unroll
        for (int b = 0; b < 2; ++b)
#pragma unroll
            for (int m = 0; m < 4; ++m)
#pragma unroll
                for (int n = 0; n < 2; ++n) acc[a][b][m][n] = (f32x4){0.f, 0.f, 0.f, 0.f};
    bf16x8 At[4][2], B0[2][2], B1[2][2];
    const Drv dc = derive(cur, tid);
    const char* cA = cur.A; const char* cB = cur.B;
    PG8_STAGE(PG8_SB(0, 0), cB, dc.vB0, dc.vB1); PG8_STAGE(PG8_SB(0, 1), cB + dc.hB, dc.vB0, dc.vB1); PG8_STAGE(PG8_SA(0, 0), cA, dc.vA0, dc.vA1); PG8_STAGE(PG8_SA(0, 1), cA + dc.hA, dc.vA0, dc.vA1);
    if (wr == 1) PG8_BAR;
    PG8_WAIT_V(2); PG8_BAR;
    PG8_STAGE(PG8_SB(1, 0), cB + 128, dc.vB0, dc.vB1); PG8_STAGE(PG8_SA(1, 0), cA + dc.kA, dc.vA0, dc.vA1); PG8_STAGE(PG8_SB(1, 1), cB + dc.hB + 128, dc.vB0, dc.vB1);
    PG8_WAIT_V(6); PG8_BAR;
    for (;;) {
        const bool has_next = S.next(ui + 1, nxt);
        const char* nA = cA; const char* nB = cB;
        if (has_next) { nA = nxt.A; nB = nxt.B; }
        const int nt = cur.nt;
        for (int t = 0; t < nt; t += 2) {
            const bool last = (t == nt - 2);
            if (cur.kind == K_BR && t == 16) E.mid(acc, cur, wr, wc, fr, fq);
            const size_t aj = (cur.kind == K_BR) ? (size_t)(WS_SB - WS_SA) - 16 * 128 : 0;
            const char* a1 = cA + (size_t)(t + 1) * dc.kA + (t >= 16 ? aj : 0);
            const char* a2 = last ? nA : cA + (size_t)(t + 2) * dc.kA + (t >= 14 ? aj : 0); const char* b2 = last ? nB : cB + (size_t)(t + 2) * 128;
            const unsigned xA0 = dc.vA0, xA1 = dc.vA1, xB0 = dc.vB0, xB1 = dc.vB1, xk = dc.kA, xhA = dc.hA, xhB = dc.hB;
            const char* a3 = a2 + xk; const char* b3 = b2 + 128;
            PG8_LDB(B0, 0, 0); PG8_LDB(B1, 0, 1); PG8_SCHED; PG8_LDA(At, 0, 0); PG8_STAGE(PG8_SA(1, 1), a1 + dc.hA, dc.vA0, dc.vA1);
            PG8_WAIT_V(8); PG8_WAIT_L(0); PG8_BAR; PG8_MMA(0, 0, At, B0); PG8_MMA(0, 1, At, B1); PG8_BAR; PG8_SCHED;
            PG8_LDA(At, 0, 1); PG8_STAGE(PG8_SB(0, 0), b2, xB0, xB1); PG8_STAGE(PG8_SB(0, 1), b2 + xhB, xB0, xB1); PG8_STAGE(PG8_SA(0, 0), a2, xA0, xA1);
            PG8_WAIT_V(8); PG8_WAIT_L(0); PG8_BAR; PG8_MMA(1, 0, At, B0); PG8_MMA(1, 1, At, B1); PG8_BAR; PG8_SCHED;
            PG8_LDB(B0, 1, 0); PG8_LDB(B1, 1, 1); PG8_SCHED; PG8_LDA(At, 1, 0); PG8_STAGE(PG8_SA(0, 1), a2 + xhA, xA0, xA1);
            PG8_WAIT_V(8); PG8_WAIT_L(0); PG8_BAR; PG8_MMA(0, 0, At, B0); PG8_MMA(0, 1, At, B1); PG8_BAR; PG8_SCHED;
            PG8_LDA(At, 1, 1); PG8_STAGE(PG8_SB(1, 0), b3, xB0, xB1); PG8_STAGE(PG8_SB(1, 1), b3 + xhB, xB0, xB1); PG8_STAGE(PG8_SA(1, 0), a3, xA0, xA1);
            PG8_WAIT_V(8); PG8_WAIT_L(0); PG8_BAR; PG8_MMA(1, 0, At, B0); PG8_MMA(1, 1, At, B1); PG8_BAR; PG8_SCHED;
        }
        if (wr == 0) PG8_BAR;
        E(acc, cur, wr, wc, fr, fq);
        if (!has_next) break;
#pragma unroll
        for (int a = 0; a < 2; ++a)
#pragma unroll
            for (int b = 0; b < 2; ++b)
#pragma unroll
                for (int m = 0; m < 4; ++m)
#pragma unroll
                    for (int n = 0; n < 2; ++n) acc[a][b][m][n] = (f32x4){0.f, 0.f, 0.f, 0.f};
        cur = nxt; cA = nA; cB = nB; ++ui;
        if (wr == 1) PG8_BAR;
    }
    PG8_WAIT_V(0);
    PG8_BAR;
#undef PG8_SA
#undef PG8_SB
#undef PG8_STAGE
#undef PG8_LDA
#undef PG8_LDB
#undef PG8_MMA
#undef PG8_WAIT_V
#undef PG8_WAIT_L
#undef PG8_BAR
#undef PG8_SCHED
}
}

__device__ __forceinline__ void transpose_item(const float* W, int N, bf16_t* WT, int ldt, int col_off, int rmode, LAS float* scr, int item, int lane, const float* kscale = nullptr) {
    const int nblk = N / 32, kb = item / nblk, nb = item % nblk, k0 = 64 * kb, n0 = 32 * nb;
    f32x4 wv[8];
#pragma unroll
    for (int i = 0; i < 8; ++i) { wv[i] = *(const f32x4*)(W + (size_t)(k0 + 8 * i + (lane >> 3)) * N + n0 + 4 * (lane & 7)); if (kscale) wv[i] = wv[i] * kscale[k0 + 8 * i + (lane >> 3)]; }
#pragma unroll
    for (int i = 0; i < 8; ++i) { LAS float* d = scr + (8 * i + (lane >> 3)) * 33 + 4 * (lane & 7); d[0] = wv[i][0]; d[1] = wv[i][1]; d[2] = wv[i][2]; d[3] = wv[i][3]; }
    asm volatile("s_waitcnt lgkmcnt(0)" ::: "memory");
    int r0 = n0;
    if (rmode == 1) { const int isu = n0 >= FF, nn = isu ? n0 - FF : n0; r0 = 256 * (nn >> 7) + (nn & 127) + (isu ? 128 : 0); }
    const int c = lane & 7;
#pragma unroll
    for (int j = 0; j < 4; ++j) { const int n = (lane >> 3) + 8 * j; const LAS float* s = scr + (8 * c) * 33 + n;
        u32x4 o; o.x = cvt_pk_bf16(s[0 * 33], s[1 * 33]); o.y = cvt_pk_bf16(s[2 * 33], s[3 * 33]); o.z = cvt_pk_bf16(s[4 * 33], s[5 * 33]); o.w = cvt_pk_bf16(s[6 * 33], s[7 * 33]);
        *(u32x4*)(WT + (size_t)(r0 + n) * ldt + col_off + k0 + 8 * c) = o; }
    asm volatile("s_waitcnt lgkmcnt(0)" ::: "memory");
}
template <int R>
__device__ __forceinline__ void rms_rows_to_bf16(const float* x0, size_t xstride, const float* g, bf16_t* o0, size_t ostride, int lane) {
    f32x4 v[R][4]; float s[R];
#pragma unroll
    for (int r = 0; r < R; ++r)
#pragma unroll
        for (int j = 0; j < 2; ++j) { v[r][2 * j] = *(const f32x4*)(x0 + r * xstride + 512 * j + 8 * lane); v[r][2 * j + 1] = *(const f32x4*)(x0 + r * xstride + 512 * j + 8 * lane + 4); }
#pragma unroll
    for (int r = 0; r < R; ++r) { s[r] = 0.f;
#pragma unroll
        for (int j = 0; j < 4; ++j) s[r] += (v[r][j][0] * v[r][j][0] + v[r][j][1] * v[r][j][1]) + (v[r][j][2] * v[r][j][2] + v[r][j][3] * v[r][j][3]); }
#pragma unroll
    for (int o = 1; o < 64; o <<= 1)
#pragma unroll
        for (int r = 0; r < R; ++r) s[r] += shx(s[r], lane, o);
    f32x4 gg[4];
#pragma unroll
    for (int j = 0; j < 2; ++j) { gg[2 * j] = *(const f32x4*)(g + 512 * j + 8 * lane); gg[2 * j + 1] = *(const f32x4*)(g + 512 * j + 8 * lane + 4); }
#pragma unroll
    for (int r = 0; r < R; ++r) {
        const float rstd = 1.f / sqrtf(s[r] * (1.f / DM) + EPS);
#pragma unroll
        for (int j = 0; j < 2; ++j) {
            const f32x4 a = v[r][2 * j] * rstd * gg[2 * j], b = v[r][2 * j + 1] * rstd * gg[2 * j + 1];
            u32x4 w; w.x = cvt_pk_bf16(a[0], a[1]); w.y = cvt_pk_bf16(a[2], a[3]); w.z = cvt_pk_bf16(b[0], b[1]); w.w = cvt_pk_bf16(b[2], b[3]);
            *(u32x4*)(o0 + r * ostride + 512 * j + 8 * lane) = w;
        }
    }
}
template <bool XIN_BF, bool XOUT_BF>
__device__ __forceinline__ void rowpass(const bf16_t* m, const float* gpost, const void* xin_, void* xout_, const float* gpre, bf16_t* hout, float* rsout, int gw, int NGW, int lane, int row_end) {
    constexpr int R = 4;
    const float* xin = (const float*)xin_; const bf16_t* xinb = (const bf16_t*)xin_; float* xout = (float*)xout_; bf16_t* xoutb = (bf16_t*)xout_;
    for (int row0 = gw; row0 < row_end; row0 += R * NGW) {
        u32x4 mw[R][2]; f32x4 xv[R][4]; u32x4 xw[R][2];
#pragma unroll
        for (int r = 0; r < R; ++r) { const size_t ro = (size_t)(row0 + r * NGW) * DM;
#pragma unroll
            for (int j = 0; j < 2; ++j) { mw[r][j] = *(const u32x4*)(m + ro + 512 * j + 8 * lane);
                if (XIN_BF) xw[r][j] = *(const u32x4*)(xinb + ro + 512 * j + 8 * lane);
                else { xv[r][2 * j] = *(const f32x4*)(xin + ro + 512 * j + 8 * lane); xv[r][2 * j + 1] = *(const f32x4*)(xin + ro + 512 * j + 8 * lane + 4); } } }
        f32x4 gp[4];
#pragma unroll
        for (int j = 0; j < 2; ++j) { gp[2 * j] = *(const f32x4*)(gpost + 512 * j + 8 * lane); gp[2 * j + 1] = *(const f32x4*)(gpost + 512 * j + 8 * lane + 4); }
        float mv[R][2][8]; float ss[R];
#pragma unroll
        for (int r = 0; r < R; ++r) { ss[r] = 0.f;
#pragma unroll
            for (int j = 0; j < 2; ++j) { unpack8(mw[r][j], mv[r][j]);
#pragma unroll
                for (int i = 0; i < 8; ++i) ss[r] += mv[r][j][i] * mv[r][j][i]; } }
#pragma unroll
        for (int o = 1; o < 64; o <<= 1)
#pragma unroll
            for (int r = 0; r < R; ++r) ss[r] += shx(ss[r], lane, o);
        float x1[R][2][8]; float s2[R];
#pragma unroll
        for (int r = 0; r < R; ++r) {
            const size_t ro = (size_t)(row0 + r * NGW) * DM;
            const float rstd = 1.f / sqrtf(ss[r] * (1.f / DM) + EPS); s2[r] = 0.f;
#pragma unroll
            for (int j = 0; j < 2; ++j) {
                const int c = 512 * j + 8 * lane;
                float xi[8];
                if (XIN_BF) unpack8(xw[r][j], xi);
                else {
#pragma unroll
                    for (int i = 0; i < 4; ++i) { xi[i] = xv[r][2 * j][i]; xi[4 + i] = xv[r][2 * j + 1][i]; }
                }
#pragma unroll
                for (int i = 0; i < 4; ++i) { x1[r][j][i] = xi[i] + mv[r][j][i] * rstd * gp[2 * j][i]; x1[r][j][4 + i] = xi[4 + i] + mv[r][j][4 + i] * rstd * gp[2 * j + 1][i]; }
#pragma unroll
                for (int i = 0; i < 8; ++i) s2[r] += x1[r][j][i] * x1[r][j][i];
                if (XOUT_BF) *(u32x4*)(xoutb + ro + c) = pack8(x1[r][j]);
                else { *(f32x4*)(xout + ro + c) = (f32x4){x1[r][j][0], x1[r][j][1], x1[r][j][2], x1[r][j][3]}; *(f32x4*)(xout + ro + c + 4) = (f32x4){x1[r][j][4], x1[r][j][5], x1[r][j][6], x1[r][j][7]}; }
            }
        }
        if (hout || rsout) {
#pragma unroll
            for (int o = 1; o < 64; o <<= 1)
#pragma unroll
                for (int r = 0; r < R; ++r) s2[r] += shx(s2[r], lane, o);
        }
        if (rsout) {
#pragma unroll
            for (int r = 0; r < R; ++r) if (lane == 0) rsout[row0 + r * NGW] = 1.f / sqrtf(s2[r] * (1.f / DM) + EPS);
        }
        if (hout) {
#pragma unroll
            for (int j = 0; j < 2; ++j) { gp[2 * j] = *(const f32x4*)(gpre + 512 * j + 8 * lane); gp[2 * j + 1] = *(const f32x4*)(gpre + 512 * j + 8 * lane + 4); }
#pragma unroll
            for (int r = 0; r < R; ++r) {
                const size_t ro = (size_t)(row0 + r * NGW) * DM;
                const float r2 = 1.f / sqrtf(s2[r] * (1.f / DM) + EPS);
#pragma unroll
                for (int j = 0; j < 2; ++j) {
                    float h[8];
#pragma unroll
                    for (int i = 0; i < 4; ++i) { h[i] = x1[r][j][i] * r2 * gp[2 * j][i]; h[4 + i] = x1[r][j][4 + i] * r2 * gp[2 * j + 1][i]; }
                    *(u32x4*)(hout + ro + 512 * j + 8 * lane) = pack8(h);
                }
            }
        }
    }
}

__device__ __forceinline__ void s5_build(LAS unsigned char* lds, unsigned char* ws, const float* lam_re, const float* lam_im, const float* log_step, const float* b_re,
                                         const float* b_im, const float* c_re, const float* c_im, const float* dvec, int g, int tid) {
    LAS f32x2* AP = (LAS f32x2*)lds;
    LAS f32x2* BB = (LAS f32x2*)(lds + 33280);
    LAS f32x2* CC = (LAS f32x2*)(lds + 41472);
    LAS float* KT = (LAS float*)(lds + 49664);
    const float step = expf(log_step[g]);
    for (int i = tid; i < 64 * 65; i += 512) {
        const int p = i / 65, tau = i % 65;
        const float lr = lam_re[g * 64 + p], li = lam_im[g * 64 + p];
        const float mag = expf(lr * step * (float)tau);
        const double ang = (double)li * (double)step * (double)tau;
        const double kq = rint(ang * 0.15915494309189535);
        const float r = (float)(ang - kq * 6.283185307179586);
        AP[p * 65 + tau] = (f32x2){mag * cosf(r), mag * sinf(r)};
    }
    for (int i = tid; i < 64 * 16; i += 512) {
        const int p = i >> 4, h = i & 15;
        const float lr = lam_re[g * 64 + p], li = lam_im[g * 64 + p];
        const float x = lr * step, mag = expf(x), em1 = expm1f(x);
        const double ang = (double)li * (double)step; const double kq = rint(ang * 0.15915494309189535);
        const float r = (float)(ang - kq * 6.283185307179586);
        const float sh = sinf(0.5f * r), cm1 = -2.f * sh * sh, sn = sinf(r), cs = 1.f + cm1;
        const float nr = em1 * cs + cm1, ni = mag * sn;
        const float den = lr * lr + li * li;
        const float co_re = (nr * lr + ni * li) / den, co_im = (ni * lr - nr * li) / den;
        const float br = b_re[(g * 64 + p) * 16 + h], bi = b_im[(g * 64 + p) * 16 + h];
        BB[p * 16 + h] = (f32x2){co_re * br - co_im * bi, co_re * bi + co_im * br};
        const int hh = i >> 6, pp = i & 63;
        CC[hh * 64 + pp] = (f32x2){c_re[(g * 16 + hh) * 64 + pp], c_im[(g * 16 + hh) * 64 + pp]};
    }
    __syncthreads();
    for (int it = 0; it < 2; ++it) {
        const int tau = tid & 63, hp = (tid >> 6) + 8 * it;
        float a[16];
#pragma unroll
        for (int h = 0; h < 16; ++h) a[h] = 0.f;
        for (int p = 0; p < 64; ++p) {
            const f32x2 c = CC[hp * 64 + p], ap = AP[p * 65 + tau];
            const float xr = c.x * ap.x - c.y * ap.y, xi = c.x * ap.y + c.y * ap.x;
#pragma unroll
            for (int h = 0; h < 16; ++h) { const f32x2 b = BB[p * 16 + h]; a[h] += xr * b.x - xi * b.y; }
        }
        if (tau == 0) {
#pragma unroll
            for (int h = 0; h < 16; ++h) if (h == hp) a[h] += dvec[g * 16 + hp];
        }
#pragma unroll
        for (int h = 0; h < 16; ++h) KT[tau * KTS + hp * 16 + h] = a[h];
    }
    __syncthreads();
    { const LAS f32x4* src = (const LAS f32x4*)lds; f32x4* dst = (f32x4*)(ws + WS_S5T + (size_t)g * S5T_BYTES);
      for (int i = tid; i < S5T_BYTES / 16; i += 512) dst[i] = src[i]; }
    if (tid < 64) ((f32x2*)(ws + WS_A64))[g * 64 + tid] = AP[tid * 65 + 64];
    __syncthreads();
}
__device__ __forceinline__ void s5_expand(LAS unsigned char* lds, unsigned char* ws, int g, int part, int tid) {
    LAS f32x2* AP = (LAS f32x2*)lds; LAS f32x2* BB = (LAS f32x2*)(lds + 33280); LAS f32x2* CC = (LAS f32x2*)(lds + 41472); LAS float* KT = (LAS float*)(lds + 49664);
    { const f32x4* src = (const f32x4*)(ws + WS_S5T + (size_t)g * S5T_BYTES); LAS f32x4* dst = (LAS f32x4*)lds;
      for (int i = tid; i < S5T_BYTES / 16; i += 512) dst[i] = src[i]; }
    __syncthreads();
    bf16_t* BT2 = (bf16_t*)(ws + WS_BT2) + (size_t)g * 1024 * 1152;
    for (int i = tid; i < 128 * 144; i += 512) {
        const int rl = i / 144, cc = i % 144, t = 8 * part + (rl >> 4), hp = rl & 15;
        float v[8];
        if (cc < 128) {
            const int s = cc >> 1, h0 = (cc & 1) * 8;
            if (s <= t) {
#pragma unroll
                for (int j = 0; j < 8; ++j) v[j] = KT[(t - s) * KTS + hp * 16 + h0 + j];
            } else {
#pragma unroll
                for (int j = 0; j < 8; ++j) v[j] = 0.f;
            }
        } else {
            const int p0 = (cc - 128) * 4;
#pragma unroll
            for (int j = 0; j < 4; ++j) { const f32x2 c = CC[hp * 64 + p0 + j], ap = AP[(p0 + j) * 65 + t + 1];
                v[2 * j] = c.x * ap.x - c.y * ap.y; v[2 * j + 1] = -(c.x * ap.y + c.y * ap.x); }
        }
        *(u32x4*)(BT2 + (size_t)(t * 16 + hp) * 1152 + cc * 8) = pack8(v);
    }
    bf16_t* BT1 = (bf16_t*)(ws + WS_BT1) + (size_t)g * 128 * 1152;
    for (int i = tid; i < 16 * 128; i += 512) {
        const int rl = i >> 7, cc = i & 127, p = 8 * part + (rl >> 1), ri = rl & 1, s = cc >> 1, h0 = (cc & 1) * 8;
        const f32x2 ap = AP[p * 65 + 63 - s];
        float v[8];
#pragma unroll
        for (int j = 0; j < 8; ++j) { const f32x2 b = BB[p * 16 + h0 + j]; v[j] = ri ? (ap.x * b.y + ap.y * b.x) : (ap.x * b.x - ap.y * b.y); }
        *(u32x4*)(BT1 + (size_t)(2 * p + ri) * 1152 + cc * 8) = pack8(v);
    }
    __syncthreads();
}

__device__ __forceinline__ void spatial_phase(LAS unsigned char* lds, unsigned char* ws, const float* ln_g, const float* ln_b, const float* b_s, int vcu, int G, const int tid) {
    __syncthreads();
    const int wid = __builtin_amdgcn_readfirstlane(tid >> 6), lane = tid & 63, fr = lane & 15, fq = lane >> 4;
    LAS f32x2* ST = (LAS f32x2*)lds;
    LAS bf16_t* VT = (LAS bf16_t*)(lds + 1024);
    LAS float* LG = (LAS float*)(lds + 36864);
    LAS float* LB = (LAS float*)(lds + 40960);
    const bf16_t* U = (const bf16_t*)(ws + WS_U); const bf16_t* V = (const bf16_t*)(ws + WS_V); bf16_t* YC = (bf16_t*)(ws + WS_SA);
    const bf16_t* WSP = (const bf16_t*)(ws + WS_WSP);
    for (int i = tid; i < 1024; i += 512) { LG[i] = ln_g[i]; LB[i] = ln_b[i]; }
    const int kmax = (16 * wid + 15) >> 5, t = 16 * wid + fr;
    for (int unit = vcu; unit < M_TOK / 128; unit += G) {
        const size_t r0 = (size_t)unit * 128;
        u32x4 vreg[4];
#pragma unroll
        for (int it = 0; it < 4; ++it) { const int idx = wid * 4 + it, s = (idx & 1) * 64 + lane, c0 = (idx >> 1) * 8; vreg[it] = *(const u32x4*)(V + (r0 + s) * DM + c0); }
        {
            const f32x4* pv = (const f32x4*)((const float*)(ws + WS_VST) + ((r0 + 16 * wid + (lane >> 2)) * 16 + 4 * (lane & 3)) * 2);
            const f32x4 p0 = pv[0], p1 = pv[1];
            float s1 = (p0[0] + p0[2]) + (p1[0] + p1[2]), s2 = (p0[1] + p0[3]) + (p1[1] + p1[3]);
            s1 += shx(s1, lane, 1); s1 += shx(s1, lane, 2); s2 += shx(s2, lane, 1); s2 += shx(s2, lane, 2);
            const float mean = s1 * (1.f / DM), var = fmaxf(s2 * (1.f / DM) - mean * mean, 0.f);
            if ((lane & 3) == 0) ST[16 * wid + (lane >> 2)] = (f32x2){mean, 1.f / sqrtf(var + EPS)};
        }
        __syncthreads();
        for (int g = 0; g < 8; ++g) {
#pragma unroll
            for (int it = 0; it < 4; ++it) {
                const int idx = wid * 4 + it, s = (idx & 1) * 64 + lane, c0 = (idx >> 1) * 8;
                float v[8]; unpack8(vreg[it], v);
                const f32x2 st = ST[s];
                const f32x4 g0 = *(const LAS f32x4*)(LG + g * 128 + c0), g1 = *(const LAS f32x4*)(LG + g * 128 + c0 + 4), e0 = *(const LAS f32x4*)(LB + g * 128 + c0), e1 = *(const LAS f32x4*)(LB + g * 128 + c0 + 4);
#pragma unroll
                for (int i = 0; i < 8; ++i) {
                    const int c = c0 + i, rho = (c & ~31) + 16 * ((c >> 2) & 1) + 4 * ((c & 31) >> 3) + (c & 3);
                    const float gm = i < 4 ? g0[i] : g1[i - 4], be = i < 4 ? e0[i] : e1[i - 4];
                    const float val = (v[i] - st.x) * st.y * gm + be;
                    VT[rho * 136 + s] = (bf16_t)(cvt_pk_bf16(val, 0.f) & 0xffffu);
                }
            }
            bf16x8 wf[4];
#pragma unroll
            for (int kk = 0; kk < 4; ++kk) if (kk <= kmax) wf[kk] = *(const bf16x8*)(WSP + ((size_t)(g * 128 + t)) * 128 + 32 * kk + 8 * fq);
            const float bias = b_s[g * 128 + t];
            u32x4 ureg[4];
#pragma unroll
            for (int b = 0; b < 4; ++b) ureg[b] = *(const u32x4*)(U + (r0 + t) * DM + g * 128 + b * 32 + 8 * fq);
            if (g < 7) {
#pragma unroll
                for (int it = 0; it < 4; ++it) { const int idx = wid * 4 + it, s = (idx & 1) * 64 + lane, c0 = (idx >> 1) * 8; vreg[it] = *(const u32x4*)(V + (r0 + s) * DM + (g + 1) * 128 + c0); }
            }
            __syncthreads();
            f32x4 acc[4][2];
#pragma unroll
            for (int b = 0; b < 4; ++b) { acc[b][0] = (f32x4){0.f, 0.f, 0.f, 0.f}; acc[b][1] = (f32x4){0.f, 0.f, 0.f, 0.f}; }
#pragma unroll
            for (int kk = 0; kk < 4; ++kk) if (kk <= kmax) {
#pragma unroll
                for (int b = 0; b < 4; ++b)
#pragma unroll
                    for (int n = 0; n < 2; ++n) {
                        const bf16x8 vf = *(const LAS bf16x8*)(VT + (b * 32 + 16 * n + fr) * 136 + 32 * kk + 8 * fq);
                        acc[b][n] = __builtin_amdgcn_mfma_f32_16x16x32_bf16(vf, wf[kk], acc[b][n], 0, 0, 0);
                    }
            }
#pragma unroll
            for (int b = 0; b < 4; ++b) {
                float u8[8]; unpack8(ureg[b], u8);
                float o[8];
#pragma unroll
                for (int j = 0; j < 4; ++j) { o[j] = (acc[b][0][j] + bias) * u8[j]; o[4 + j] = (acc[b][1][j] + bias) * u8[4 + j]; }
                *(u32x4*)(YC + (r0 + t) * DM + g * 128 + b * 32 + 8 * fq) = pack8(o);
            }
            __syncthreads();
        }
    }
}


#define XB_TMO      128
#define XB_XCNT(j)  (256  + 64 * (j))
#define XB_XSUB(j)  (1280 + 64 * (j))
#define XB_XGEN(j)  (2304 + 64 * (j))
#define XB_TOP      3328
#define XB_TOPGEN   3392
#define XB_SPIN_CAP (1u << 20)
__device__ __forceinline__ unsigned xb_ld(unsigned* p)              { return __hip_atomic_load(p, __ATOMIC_RELAXED, __HIP_MEMORY_SCOPE_AGENT); }
__device__ __forceinline__ unsigned xb_add(unsigned* p, unsigned v) { return __hip_atomic_fetch_add(p, v, __ATOMIC_RELAXED, __HIP_MEMORY_SCOPE_AGENT); }
__device__ __forceinline__ unsigned xb_xcc_id() { return (unsigned)__builtin_amdgcn_s_getreg((3 << 11) | 20) & 0xFu; }
#define XB_SPIN(cond, bar) do { unsigned _sp = 0; while (cond) { __builtin_amdgcn_s_sleep(1); \
    if ((++_sp & 255u) == 0u) { if (xb_ld(&(bar)[XB_TMO])) break; if (_sp > XB_SPIN_CAP) { atomicAdd(&(bar)[XB_TMO], 1u); break; } } } } while (0)
struct XcdBarrier { unsigned* bar; unsigned x; volatile LAS unsigned* st; };
__device__ __forceinline__ void xcd_barrier_post(unsigned* bar, int tid) { if (tid == 0) (void)xb_add(&bar[XB_XCNT(xb_xcc_id())], 1u); }
__device__ __forceinline__ void xcd_barrier_complete(unsigned* bar, unsigned x, unsigned& nloc, unsigned& nx) {
    const unsigned G = gridDim.x * gridDim.y * gridDim.z;
    unsigned sum, cnt, mine, sp = 0u;
    for (;;) {
        sum = 0u; cnt = 0u; mine = 0u;
#pragma unroll
        for (unsigned j = 0; j < 16; ++j) { const unsigned c = xb_ld(&bar[XB_XCNT(j)]); sum += c; cnt += (c > 0u) ? 1u : 0u; mine = (j == x) ? c : mine; }
        if (sum == G) break;
        __builtin_amdgcn_s_sleep(1);
        if ((++sp & 255u) == 0u) { if (xb_ld(&bar[XB_TMO])) break; if (sp > XB_SPIN_CAP) { atomicAdd(&bar[XB_TMO], 1u); break; } }
    }
    nloc = mine > 0u ? mine : 1u; nx = cnt > 0u ? cnt : 1u;
}
__device__ __forceinline__ void xcd_barrier(const XcdBarrier& b, int tid) {
    asm volatile("s_waitcnt vmcnt(0)" ::: "memory");
    __syncthreads();
    if (tid == 0) {
        unsigned* bar = b.bar;
        __builtin_amdgcn_s_waitcnt(0);
        unsigned nloc = b.st[0], nx = b.st[1];
        if (nloc == 0u) { xcd_barrier_complete(bar, b.x, nloc, nx); b.st[0] = nloc; b.st[1] = nx; }
        const unsigned old = xb_add(&bar[XB_XSUB(b.x)], 1u);
        const unsigned gen = old / nloc;
        if (old + 1u == (gen + 1u) * nloc) {
            __builtin_amdgcn_fence(__ATOMIC_RELEASE, "agent");
            asm volatile("s_waitcnt vmcnt(0)" ::: "memory");
            const unsigned og = xb_add(&bar[XB_TOP], 1u);
            const unsigned tg = og / nx;
            if (og + 1u == (tg + 1u) * nx) xb_add(&bar[XB_TOPGEN], 1u);
            else XB_SPIN(xb_ld(&bar[XB_TOPGEN]) == tg, bar);
            __builtin_amdgcn_fence(__ATOMIC_ACQUIRE, "agent");
            xb_add(&bar[XB_XGEN(b.x)], 1u);
            asm volatile("s_waitcnt vmcnt(0)" ::: "memory");
        } else {
            XB_SPIN(xb_ld(&bar[XB_XGEN(b.x)]) == gen, bar);
            __builtin_amdgcn_fence(__ATOMIC_ACQUIRE, "agent");
            asm volatile("s_waitcnt vmcnt(0)" ::: "memory");
        }
    }
    __syncthreads();
}

struct Args { const float* in[31]; float* out; unsigned char* ws; int ph_lo, ph_hi; };

__global__ void __launch_bounds__(512, 2) mk_fwd(Args args) {
    extern __shared__ __attribute__((aligned(16))) unsigned char lds_raw[];
    LAS unsigned char* lds = (LAS unsigned char*)lds_raw;
    const int G = gridDim.x, bx = blockIdx.x;
    const int vcu = (G % 8 == 0) ? (bx % 8) * (G / 8) + bx / 8 : bx;
    volatile LAS unsigned* xst = (volatile LAS unsigned*)(lds + LDS_XS + 8192);
    const bool multi = args.ph_hi - args.ph_lo > 1;
    if (multi) { if (threadIdx.x < 2) xst[threadIdx.x] = 0u; __syncthreads(); xcd_barrier_post((unsigned*)args.ws, (int)threadIdx.x); }

    for (int pi = args.ph_lo; pi < args.ph_hi; ++pi) {
        const int ph = pi;
        if (ph == 11 || ph == 12) continue;
        int tid = threadIdx.x; asm volatile("" : "+v"(tid));
        size_t wz = 0; asm volatile("" : "+s"(wz)); unsigned char* ws = args.ws + wz;
        const __attribute__((address_space(4))) char* kp = (const __attribute__((address_space(4))) char*)__builtin_amdgcn_kernarg_segment_ptr() + wz;
#define IN(i) ((const float*)(*(const __attribute__((address_space(1))) float* const __attribute__((address_space(4)))*)(kp + 8 * (i))))
        const int lane = tid & 63, wave = __builtin_amdgcn_readfirstlane(tid >> 6);
        const int gw = vcu * 8 + wave, NGW = G * 8;
        const bool panel_mode = (G == M_TOK / 256); const int panel = vcu;
        pg8::Epi E; E.ws = ws; E.lds = lds;
        bool is_gemm = false;
        if (ph == 0) {
            const bool split = (G % 32 == 0) && (G >= 128);
            const int nc = split ? (G / 32) * 12 : G, nm = split ? G - nc : G;
            const int ci = split ? (vcu % 32) * (G / 32) + (vcu / 32) : vcu, mi = split ? (vcu / 32) * 20 + (vcu % 32) - 12 : vcu;
            const bool do_c = !split || (vcu % 32) < 12, do_m = !split || (vcu % 32) >= 12;
            const int gwc = ci * 8 + wave, NGWC = nc * 8, gwm = mi * 8 + wave, NGWM = nm * 8;
            if (do_c) {
            for (int g = ci; g < 32; g += nc) s5_build(lds, ws, IN(8), IN(9), IN(10), IN(11), IN(12), IN(13), IN(14), IN(15), g, tid);
            LAS float* scr = (LAS float*)(lds + wave * 16384);
            constexpr int I_IN = 16 * (NIN / 32), I_BG = 16 * 32, I_BS = 8 * 32, I_MX = 16 * 32, I_GL = 8 * 16, I_Q = 16 * 32, I_KV = 16 * 64, I_O = 16 * 32, I_GU = 16 * (2 * FF / 32), I_DN = (FF / 64) * 32;
            constexpr int NIT = I_IN + I_BG + I_BS + I_MX + I_GL + I_KV + I_O + I_GU + I_DN;
            for (int it = gwc; it < NIT; it += NGWC) {
                int r = it;
                if (r < I_IN) { transpose_item(IN(3), NIN, (bf16_t*)(ws + WS_WIN), 1024, 0, 0, scr, r, lane); continue; } r -= I_IN;
                if (r < I_BG) { transpose_item(IN(17), 1024, (bf16_t*)(ws + WS_WBR), 1536, 0, 0, scr, r, lane); continue; } r -= I_BG;
                if (r < I_BS) { transpose_item(IN(18), 1024, (bf16_t*)(ws + WS_WBR), 1536, 1024, 0, scr, r, lane); continue; } r -= I_BS;
                if (r < I_MX) { transpose_item(IN(19), 1024, (bf16_t*)(ws + WS_WMIX), 1024, 0, 0, scr, r, lane); continue; } r -= I_MX;
                if (r < I_GL) { transpose_item(IN(16), 512, (bf16_t*)(ws + WS_WGLU), 512, 0, 0, scr, r, lane); continue; } r -= I_GL;
                if (r < I_KV) { transpose_item(IN(24), 2048, (bf16_t*)(ws + WS_WKV), 1152, 0, 0, scr, r, lane); continue; } r -= I_KV;
                if (r < I_O) { transpose_item(IN(25), 1024, (bf16_t*)(ws + WS_WO), 1024, 0, 0, scr, r, lane); continue; } r -= I_O;
                if (r < I_GU) { transpose_item(IN(28), 2 * FF, (bf16_t*)(ws + WS_WGU), 1024, 0, 1, scr, r, lane, IN(27)); continue; } r -= I_GU;
                transpose_item(IN(29), 1024, (bf16_t*)(ws + WS_WDN), FF, 0, 0, scr, r, lane);
            }
            {
                const float* w = IN(23); const float* gq = IN(21); bf16_t* o = (bf16_t*)(ws + WS_WQ);
                for (int i = ci * 512 + tid; i < 1024 * 1024 / 8; i += nc * 512) {
                    const int e = i * 8; const float gsc = gq[e >> 10];
                    const f32x4 a = *(const f32x4*)(w + e) * gsc, b = *(const f32x4*)(w + e + 4) * gsc;
                    float v[8] = {a[0], a[1], a[2], a[3], b[0], b[1], b[2], b[3]};
                    *(u32x4*)(o + e) = pack8(v);
                }
            }
            {
                const float* w = IN(6); bf16_t* o = (bf16_t*)(ws + WS_WSP);
                for (int i = ci * 512 + tid; i < 8 * 128 * 128 / 8; i += nc * 512) {
                    const int e = i * 8, s0 = e & 127, t = (e >> 7) & 127;
                    const f32x4 a = *(const f32x4*)(w + e), b = *(const f32x4*)(w + e + 4);
                    float v[8] = {a[0], a[1], a[2], a[3], b[0], b[1], b[2], b[3]};
#pragma unroll
                    for (int j = 0; j < 8; ++j) if (s0 + j > t) v[j] = 0.f;
                    *(u32x4*)(o + e) = pack8(v);
                }
            }
            }
            if (do_m) {
                int m = gwm;
                for (; m + 3 * NGWM < M_TOK; m += 4 * NGWM) rms_rows_to_bf16<4>(IN(0) + (size_t)m * DM, (size_t)NGWM * DM, IN(2), (bf16_t*)(ws + WS_SA) + (size_t)m * DM, (size_t)NGWM * DM, lane);
                for (; m < M_TOK; m += NGWM) rms_rows_to_bf16<1>(IN(0) + (size_t)m * DM, 0, IN(2), (bf16_t*)(ws + WS_SA) + (size_t)m * DM, 0, lane);
                for (m = gwm; m < NMEM; m += NGWM) rms_rows_to_bf16<1>(IN(1) + (size_t)m * DM, 0, IN(22), (bf16_t*)(ws + WS_MEMN) + (size_t)m * 1152, 0, lane);
            }
        } else if (ph == 1 || ph == 2) { is_gemm = true;
        } else if (ph == 3) { is_gemm = true;
        } else if (ph == 4 || ph == 5 || ph == 6 || ph == 7) { is_gemm = true;
        } else if (ph == 8) {
            if (panel_mode) rowpass<false, true>((const bf16_t*)(ws + WS_SA), IN(20), IN(0), ws + WS_X1B, nullptr, nullptr, (float*)(ws + WS_RS1), panel * 256 + wave, 8, lane, panel * 256 + 256);
            else rowpass<false, true>((const bf16_t*)(ws + WS_SA), IN(20), IN(0), ws + WS_X1B, nullptr, nullptr, (float*)(ws + WS_RS1), gw, NGW, lane, M_TOK);
        } else if (ph == 9 || ph == 10) { is_gemm = true;
        } else if (ph == 13) {
            if (panel_mode) rowpass<true, true>((const bf16_t*)(ws + WS_SD), IN(26), ws + WS_X1B, ws + WS_X2B, nullptr, nullptr, (float*)(ws + WS_RS2), panel * 256 + wave, 8, lane, panel * 256 + 256);
            else rowpass<true, true>((const bf16_t*)(ws + WS_SD), IN(26), ws + WS_X1B, ws + WS_X2B, nullptr, nullptr, (float*)(ws + WS_RS2), gw, NGW, lane, M_TOK);
        } else if (ph == 14 || ph == 15) { is_gemm = true;
        } else if (ph == 16) {
            if (panel_mode) rowpass<true, false>((const bf16_t*)(ws + WS_SC), IN(30), ws + WS_X2B, args.out, nullptr, nullptr, nullptr, panel * 256 + wave, 8, lane, panel * 256 + 256);
            else rowpass<true, false>((const bf16_t*)(ws + WS_SC), IN(30), ws + WS_X2B, args.out, nullptr, nullptr, nullptr, gw, NGW, lane, M_TOK);
        }
        if (is_gemm) {
            pg8::Sched S; S.ws = ws; S.ph = ph; S.G = G; S.c = bx; S.panel = (panel_mode && ph >= 6 && !FFN_GRID(ph)) ? panel : -1;
            const bool scan_wg = (ph == 3) && (G > 128) && (vcu < 64);
            if (ph == 3 && G > 128) { S.G = G - 64; S.c = vcu - 64; }
            S.n0 = pg8::phase_units(ph, 0); S.n1 = (ph == 2 || ph == 3) ? pg8::phase_units(ph, 1) : 0; S.total = S.n0 + S.n1;
            if (S.panel >= 0) S.total = (ph == 14) ? 2 * FF / 256 : 4;
            if (ph == 1) { for (int u = vcu; u < 256; u += G) s5_expand(lds, ws, u >> 3, u & 7, tid); }
            const bool sp_first = (ph == 2) && ((vcu >> 0) & 1);
            if (sp_first) spatial_phase(lds, ws, IN(4), IN(5), IN(7), vcu, G, tid);
            if (!scan_wg) pg8::gemm_phase(lds, S, E, tid);
            if (ph == 2 && !sp_first) spatial_phase(lds, ws, IN(4), IN(5), IN(7), vcu, G, tid);
            if (ph == 3) {
            const int gt = vcu * 512 + tid;
                if (gt < 16 * 32 * 64) {
                    const int p = gt & 63, g = (gt >> 6) & 31, b = gt >> 11;
                    const f32x2 a = ((const f32x2*)(ws + WS_A64))[g * 64 + p];
                    const float* Eb = (const float*)(ws + WS_EBUF); bf16_t* UC = (bf16_t*)(ws + WS_UC);
                    float cr = 0.f, ci = 0.f;
    #pragma unroll 8
                    for (int k = 0; k < 64; ++k) {
                        const size_t row = (size_t)g * 1024 + b * 64 + k;
                        const f32x2 e = *(const f32x2*)(Eb + row * 128 + 2 * p);
                        *(unsigned*)(UC + row * 1152 + 1024 + 2 * p) = cvt_pk_bf16(cr, ci);
                        const float nr = a.x * cr - a.y * ci + e.x, ni = a.x * ci + a.y * cr + e.y; cr = nr; ci = ni;
                    }
                }

            }
        }
        if (pi + 1 < args.ph_hi) {
            if (panel_mode && ph >= 6 && ph != 16 && !FFN_GRID(ph) && !FFN_GRID(ph + 1)) {
                asm volatile("s_waitcnt vmcnt(0) lgkmcnt(0)" ::: "memory");
                __syncthreads();
                __builtin_amdgcn_fence(__ATOMIC_ACQUIRE, "agent");
                asm volatile("s_waitcnt vmcnt(0)" ::: "memory");
                __syncthreads();
            } else if (args.ph_hi > 4096) cg::this_grid().sync();
            else { XcdBarrier xb; xb.bar = (unsigned*)ws; xb.x = xb_xcc_id(); xb.st = xst; xcd_barrier(xb, tid); }
        }
    }
}

extern "C" void kernel_launch(void* const* d_in, const int* in_sizes, int n_in, void* d_out, int out_size, void* d_ws, size_t ws_size, hipStream_t stream) {
    static int grid = 0;
    if (grid == 0) {
        if (n_in != 31 || in_sizes[0] != M_TOK * DM || out_size != M_TOK * DM || ws_size < WS_END) { fprintf(stderr, "kernel_launch: unexpected problem (n_in %d, ws %zu)\n", n_in, ws_size); grid = -1; return; }
        int dev = 0, cus = 0, per_cu = 0;
        hipGetDevice(&dev); hipDeviceGetAttribute(&cus, hipDeviceAttributeMultiprocessorCount, dev);
        hipFuncSetAttribute((const void*)mk_fwd, hipFuncAttributeMaxDynamicSharedMemorySize, LDS_BYTES);
        hipOccupancyMaxActiveBlocksPerMultiprocessor(&per_cu, (const void*)mk_fwd, 512, LDS_BYTES);
        if (per_cu < 1) { fprintf(stderr, "kernel_launch: occupancy query says %d blocks per CU\n", per_cu); per_cu = 1; }
        (void)hipGetLastError();
        grid = cus;
    }
    if (grid < 0) return;
    Args a{};
    for (int i = 0; i < 31; ++i) a.in[i] = (const float*)d_in[i];
    a.out = (float*)d_out; a.ws = (unsigned char*)d_ws;
#if MK_ONE_LAUNCH
    (void)hipMemsetAsync(d_ws, 0, 65536, stream);
    a.ph_lo = 0; a.ph_hi = NPHASE;
    void* kargs[] = {&a};
    hipError_t e = hipLaunchCooperativeKernel((const void*)mk_fwd, dim3(grid), dim3(512), kargs, LDS_BYTES, stream);
    if (e != hipSuccess) fprintf(stderr, "cooperative launch failed: %s (grid %d)\n", hipGetErrorString(e), grid);

#else
    for (int ph = 0; ph < NPHASE; ++ph) {
        a.ph_lo = ph; a.ph_hi = ph + 1;
        hipLaunchKernelGGL(mk_fwd, dim3(grid), dim3(512), LDS_BYTES, stream, a);
    }
#endif
}
```

```cpp
#include <hip/hip_runtime.h>
#include <hip/hip_cooperative_groups.h>
#include <cstdint>
#include <cstdio>
namespace cg = cooperative_groups;

#define FFN_GRID(p) ((p) == 6 || (p) == 7 || (p) == 9 || (p) == 10 || (p) == 14 || (p) == 15)
#ifndef MK_ONE_LAUNCH
#define MK_ONE_LAUNCH 1
#endif

#define LAS __attribute__((address_space(3)))
typedef unsigned short bf16_t;
typedef short bf16x8 __attribute__((ext_vector_type(8)));
typedef float f32x4 __attribute__((ext_vector_type(4)));
typedef float f32x2 __attribute__((ext_vector_type(2)));
typedef unsigned u32x4 __attribute__((ext_vector_type(4)));
typedef unsigned u32x2 __attribute__((ext_vector_type(2)));

constexpr int M_TOK = 65536, DM = 1024, NIN = 4608, FF = 2816, NMEM = 4096, SEQ = 4096;
constexpr float EPS = 1e-6f;
constexpr int NPHASE = 17;
constexpr size_t MiB = 1u << 20;
constexpr size_t WS_WIN = 1 * MiB, WS_WBR = 10 * MiB, WS_WMIX = 13 * MiB, WS_WGLU = 15 * MiB, WS_WQ = 16 * MiB, WS_WKV = 18 * MiB  , WS_WO = 23 * MiB,
                 WS_WGU = 25 * MiB, WS_WDN = 36 * MiB, WS_WSP = 42 * MiB, WS_A64 = 42 * MiB + 256 * 1024, WS_RS1 = 42 * MiB + 320 * 1024  , WS_RS2 = 42 * MiB + 576 * 1024  , WS_KB = 43 * MiB, WS_VB = 51 * MiB  ;
constexpr size_t WS_SA = 59 * MiB, WS_SB = 187 * MiB, WS_SC = 315 * MiB, WS_SD = 443 * MiB;
constexpr size_t WS_ACT = 571 * MiB;
constexpr size_t WS_BT1 = 571 * MiB  , WS_BT2 = 581 * MiB, WS_EBUF = 653 * MiB, WS_MEMN = 669 * MiB  , WS_UC = 678 * MiB,
                 WS_U = 750 * MiB  , WS_V = 878 * MiB, WS_S5T = 1006 * MiB  , WS_END = 1010 * MiB;
constexpr size_t WS_X1B = WS_SB, WS_X2B = WS_SA;
constexpr size_t WS_VST = WS_SB;
constexpr size_t WS_MB = 942 * MiB, WS_NB = 974 * MiB;
constexpr int KTS = 257;
constexpr int S5T_BYTES = 49664 + 64 * KTS * 4;
constexpr int LDS_RING = 131072, LDS_XS = 131072, LDS_BYTES = 147456;

typedef __bf16 bf16v2 __attribute__((ext_vector_type(2)));
__device__ __forceinline__ unsigned cvt_pk_bf16(float lo, float hi) { const f32x2 f = {lo, hi}; const bf16v2 v = __builtin_convertvector(f, bf16v2); return __builtin_bit_cast(unsigned, v); }
__device__ __forceinline__ float bf_lo(unsigned w) { return __uint_as_float(w << 16); }
__device__ __forceinline__ float bf_hi(unsigned w) { return __uint_as_float(w & 0xffff0000u); }
__device__ __forceinline__ float fsigmoid(float x) { return __builtin_amdgcn_rcpf(1.f + __builtin_amdgcn_exp2f(-1.4426950408889634f * x)); }
__device__ __forceinline__ float gelu_t(float x) { const float y = 1.5957691216057308f * (x + 0.044715f * x * x * x); return x * fsigmoid(y); }
__device__ __forceinline__ float shx(float v, int lane, int o) { return __int_as_float(__builtin_amdgcn_ds_bpermute((lane ^ o) << 2, __float_as_int(v))); }
__device__ __forceinline__ float wave_sum(float v, int lane) {
#pragma unroll
    for (int o = 1; o < 64; o <<= 1) v += shx(v, lane, o);
    return v;
}
__device__ __forceinline__ void unpack8(const u32x4 w, float (&v)[8]) {
    v[0] = bf_lo(w.x); v[1] = bf_hi(w.x); v[2] = bf_lo(w.y); v[3] = bf_hi(w.y); v[4] = bf_lo(w.z); v[5] = bf_hi(w.z); v[6] = bf_lo(w.w); v[7] = bf_hi(w.w);
}
__device__ __forceinline__ u32x4 pack8(const float (&v)[8]) {
    u32x4 w; w.x = cvt_pk_bf16(v[0], v[1]); w.y = cvt_pk_bf16(v[2], v[3]); w.z = cvt_pk_bf16(v[4], v[5]); w.w = cvt_pk_bf16(v[6], v[7]); return w;
}

namespace pg8 {
constexpr int BM = 256, BK = 64, HALF = 128, HTB = HALF * BK * 2, NXCD = 8, WGM = 4;
__host__ __device__ __forceinline__ int lds_byte(int r, int c) { const int st = (r >> 4) * 2 + (c >> 5), rr = r & 15, cc = c & 31, ob = rr * 64 + cc * 2; return st * 1024 + (ob ^ (((ob >> 9) & 1) << 5)); }
__host__ __device__ __forceinline__ void stage_rc(int b, int& R, int& C) { const int st = b / 1024, sb = b % 1024, swz = sb ^ (((sb >> 9) & 1) << 5); R = (st >> 1) * 16 + swz / 64; C = (st & 1) * 32 + (swz % 64) / 2; }
__host__ __device__ __forceinline__ int perm32(int rho) { const int n = rho >> 4, i = rho & 15; return 8 * (i >> 2) + 4 * n + (i & 3); }

enum Kind { K_IN = 0, K_KVPROJ, K_MB, K_NB, K_S5E, K_S5Y, K_GLU, K_BR, K_MIX, K_SMAX, K_OPROJ, K_GU, K_DOWN };

struct Unit { const char* A; const char* B; int lda, cha, ldb, nt, pn, kind, orow, ocol; };
struct Desc {
    const char* A; const char* B; int lda, cha, ldb, nt, nM, nN, nZ0; long zsA0, zsA1, zsB0, zsB1; int kind, orz0, orz1, ocz0;
    __device__ __forceinline__ void fill(int w, Unit& u) const {
        const int per = nM * nN, z = w / per, r = w % per;
        const int nig = WGM * nN, gid = r / nig, fm = gid * WGM, gsz = (nM - fm) < WGM ? (nM - fm) : WGM;
        const int pm = fm + ((r % nig) % gsz), pn = (r % nig) / gsz;
        const int z0 = z % nZ0, z1 = z / nZ0;
        fill_pz(pm, pn, z0, z1, u);
    }
    __device__ __forceinline__ void fill_pz(int pm, int pn, int z0, int z1, Unit& u) const {
        u.pn = pn;
        u.A = A + z0 * zsA0 + z1 * zsA1 + (long)pm * BM * lda * 2;
        u.B = B + z0 * zsB0 + z1 * zsB1 + (long)pn * BM * ldb * 2;
        u.lda = lda; u.cha = cha; u.ldb = ldb; u.nt = nt; u.kind = kind;
        u.orow = pm * BM + z0 * orz0 + z1 * orz1; u.ocol = pn * BM + z0 * ocz0;
    }
};
__device__ __forceinline__ Desc mk_desc(const void* A, const void* B, int lda, int ldb, int K, int Mrows, int Ncols, int kind) {
    Desc d; d.A = (const char*)A; d.B = (const char*)B; d.lda = lda; d.cha = 16; d.ldb = ldb; d.nt = K / BK; d.nM = Mrows / BM; d.nN = Ncols / BM; d.nZ0 = 1;
    d.zsA0 = d.zsA1 = d.zsB0 = d.zsB1 = 0; d.kind = kind; d.orz0 = d.orz1 = d.ocz0 = 0; return d;
}
__device__ __forceinline__ Desc phase_desc(int ph, int sub, unsigned char* ws) {
    Desc d;
    if (ph == 1) { d = mk_desc(ws + WS_SA, ws + WS_WIN, 1024, 1024, 1024, M_TOK, NIN, K_IN);
    } else if (ph == 2) {
        if (sub == 0) { d = mk_desc(ws + WS_UC, ws + WS_BT1, 1152, 1152, 1024, 1024, 256, K_S5E); d.nZ0 = 32; d.zsA0 = 1024L * 1152 * 2; d.zsB0 = 128L * 1152 * 2; d.orz0 = 1024; }
        else d = mk_desc(ws + WS_MEMN, ws + WS_WKV, 1152, 1152, 1024, NMEM, 2048, K_KVPROJ);
    } else if (ph == 3) {
        if (sub == 0) { d = mk_desc(ws + WS_KB, ws + WS_WQ, 1024, 1024, 256, 256, 1024, K_MB); d.nZ0 = 4; d.zsA0 = 256 * 2; d.zsA1 = 256L * 1024 * 2; d.zsB0 = 256 * 2; d.orz0 = 256; d.orz1 = 1024; }
        else { d = mk_desc(ws + WS_WO, ws + WS_VB, 1024, 1024, 256, 1024, 256, K_NB); d.nZ0 = 4; d.zsA0 = 256 * 2; d.zsB0 = 256 * 2; d.zsB1 = 256L * 1024 * 2; d.orz1 = 1024; d.ocz0 = 256; }
    } else if (ph == 4) { d = mk_desc(ws + WS_UC, ws + WS_BT2, 1152, 1152, 1152, 1024, 1024, K_S5Y); d.nZ0 = 32; d.zsA0 = 1024L * 1152 * 2; d.zsB0 = 1024L * 1152 * 2; d.orz0 = 1024;
    } else if (ph == 5) { d = mk_desc(ws + WS_U, ws + WS_WGLU, 16, 512, 512, M_TOK, 512, K_GLU); d.cha = M_TOK * 16;
    } else if (ph == 6) { d = mk_desc(ws + WS_SA, ws + WS_WBR, 1024, 1536, 1536, M_TOK, 1024, K_BR);
    } else if (ph == 7) { d = mk_desc(ws + WS_SC, ws + WS_WMIX, 1024, 1024, 1024, M_TOK, 1024, K_MIX);
    } else if (ph == 9) {
        d = mk_desc(ws + WS_SB, ws + WS_MB, 1024, 1024, 1024, SEQ, 1024, K_SMAX); d.zsA1 = (long)SEQ * 1024 * 2; d.zsB1 = 1024L * 1024 * 2; d.orz1 = SEQ;
    } else if (ph == 10) {
        d = mk_desc(ws + WS_SC, ws + WS_NB, 1024, 1024, 1024, SEQ, 1024, K_OPROJ); d.zsA1 = (long)SEQ * 1024 * 2; d.zsB1 = 1024L * 1024 * 2; d.orz1 = SEQ;
    } else if (ph == 14) { d = mk_desc(ws + WS_SA, ws + WS_WGU, 1024, 1024, 1024, M_TOK, 2 * FF, K_GU);
    } else { d = mk_desc(ws + WS_ACT, ws + WS_WDN, FF, FF, FF, M_TOK, 1024, K_DOWN); }
    return d;
}
__device__ __forceinline__ int phase_units(int ph, int sub) {
    switch (ph) {
        case 1: return (M_TOK / BM) * (NIN / BM);
        case 2: return sub == 0 ? 32 * 4 : (sub == 1 ? 128 : 0);
        case 3: return sub < 2 ? 256 : 0;
        case 4: return 32 * 16;
        case 5: return (M_TOK / BM) * 2;
        case 14: return (M_TOK / BM) * (2 * FF / BM);
        default: return (M_TOK / BM) * 4;
    }
}
struct Sched {
    unsigned char* ws; int ph, n0, n1, total, G, c, panel;
    __device__ __forceinline__ bool next(int i, Unit& u) const {
        if (panel >= 0) {
            if (i >= total) return false;
            const Desc d = phase_desc(ph, 0, ws);
            if (ph == 9 || ph == 10) d.fill_pz(panel & 15, i, 0, panel >> 4, u); else d.fill_pz(panel, i, 0, 0, u);
            return true;
        }
        const long L = (long)i * G + c; if (L >= total) return false;
        int wgid = (int)L; { const int q = total / NXCD, r = total % NXCD, xcd = wgid % NXCD, off = wgid / NXCD; wgid = (xcd < r ? xcd * (q + 1) : r * (q + 1) + (xcd - r) * q) + off; }
        int sub = 0; if (wgid >= n0) { sub = 1; wgid -= n0; if (wgid >= n1) { sub = 2; wgid -= n1; } }
        const Desc d = phase_desc(ph, sub, ws); d.fill(wgid, u);
        return true;
    }
};
struct Drv { unsigned vA0, vA1, vB0, vB1, kA, hA, hB; };
__device__ __forceinline__ Drv derive(const Unit& u, int tid) {
    int R0, C0, R1, C1; stage_rc(tid * 16, R0, C0); stage_rc(tid * 16 + 8192, R1, C1);
    const int Rb0 = (R0 & ~31) + perm32(R0 & 31), Rb1 = (R1 & ~31) + perm32(R1 & 31);
    Drv d;
    d.vA0 = (unsigned)(R0 * u.lda + (C0 >> 4) * u.cha + (C0 & 15)) * 2u; d.vA1 = (unsigned)(R1 * u.lda + (C1 >> 4) * u.cha + (C1 & 15)) * 2u;
    d.vB0 = (unsigned)(Rb0 * u.ldb + C0) * 2u; d.vB1 = (unsigned)(Rb1 * u.ldb + C1) * 2u;
    d.kA = (unsigned)(8 * u.cha); d.hA = (unsigned)(HALF * 2 * u.lda); d.hB = (unsigned)(HALF * 2 * u.ldb);
    return d;
}

struct Epi {
    unsigned char* ws; LAS unsigned char* lds;
    __device__ __forceinline__ void get8(const f32x4 (&acc)[2][2][4][2], int ai, int bj, int m, float (&v)[8]) const {
        const f32x4 a = acc[ai][bj][m][0], b = acc[ai][bj][m][1];
        v[0] = a[0]; v[1] = a[1]; v[2] = a[2]; v[3] = a[3]; v[4] = b[0]; v[5] = b[1]; v[6] = b[2]; v[7] = b[3];
    }
    __device__ __forceinline__ void mid(f32x4 (&acc)[2][2][4][2], const Unit& u, int wr, int wc, int fr, int fq) const {
        const bf16_t* GA = (const bf16_t*)(ws + WS_SC); const bf16_t* GB = (const bf16_t*)(ws + WS_SD);
        int rb = u.orow + wr * 64 + fr; asm volatile("" : "+v"(rb));
        int cb = u.ocol + wc * 32 + 8 * fq; asm volatile("" : "+v"(cb));
#pragma unroll
        for (int ai = 0; ai < 2; ++ai) {
            u32x4 ga[4][2], gb[4][2];
#pragma unroll
            for (int m = 0; m < 4; ++m)
#pragma unroll
                for (int bj = 0; bj < 2; ++bj) { const size_t o = (size_t)(rb + ai * HALF + m * 16) * DM + cb + bj * HALF; ga[m][bj] = *(const u32x4*)(GA + o); gb[m][bj] = *(const u32x4*)(GB + o); }
#pragma unroll
            for (int m = 0; m < 4; ++m)
#pragma unroll
                for (int bj = 0; bj < 2; ++bj) {
                    float a[8], b[8]; unpack8(ga[m][bj], a); unpack8(gb[m][bj], b);
#pragma unroll
                    for (int j = 0; j < 8; ++j) { const float r = a[j] * __builtin_amdgcn_rcpf(fmaxf(b[j], 1e-30f)); asm volatile("v_mul_f32 %0, %0, %1" : "+v"(acc[ai][bj][m][j >> 2][j & 3]) : "v"(r)); }
                }
            asm volatile("" ::: "memory");
        }
    }
    __device__ __forceinline__ void operator()(const f32x4 (&acc)[2][2][4][2], const Unit& u, int wr, int wc, int fr, int fq) const {
        const int kind = u.kind;
        if (kind == K_SMAX) {
            LAS f32x2* XS = (LAS f32x2*)(lds + LDS_XS);
            int rls = wr * 64 + fr; asm volatile("" : "+v"(rls));
            bf16_t* P = (bf16_t*)(ws + WS_SC); const float* RS = (const float*)(ws + WS_RS1);
            int rbs = u.orow + wr * 64 + fr; asm volatile("" : "+v"(rbs));
            float rsv[2][4];
#pragma unroll
            for (int ai = 0; ai < 2; ++ai)
#pragma unroll
                for (int m = 0; m < 4; ++m) rsv[ai][m] = RS[rbs + ai * HALF + m * 16] * 1.4426950408889634f;
#pragma unroll
            for (int ai = 0; ai < 2; ++ai)
#pragma unroll
                for (int m = 0; m < 4; ++m) {
                    const float rs = rsv[ai][m];
                    float mx = -3.0e38f;
#pragma unroll
                    for (int bj = 0; bj < 2; ++bj)
#pragma unroll
                        for (int n = 0; n < 2; ++n)
#pragma unroll
                            for (int j = 0; j < 4; ++j) mx = fmaxf(mx, acc[ai][bj][m][n][j]);
                    mx = fmaxf(mx, shx(mx, fr + 16 * fq, 16)); mx = fmaxf(mx, shx(mx, fr + 16 * fq, 32));
                    float s = 0.f;
#pragma unroll
                    for (int bj = 0; bj < 2; ++bj)
#pragma unroll
                        for (int n = 0; n < 2; ++n)
#pragma unroll
                            for (int j = 0; j < 4; ++j) s += __builtin_amdgcn_exp2f((acc[ai][bj][m][n][j] - mx) * rs);
                    s += shx(s, fr + 16 * fq, 16); s += shx(s, fr + 16 * fq, 32);
                    if (fq == 0) XS[(rls + ai * HALF + m * 16) * 4 + wc] = (f32x2){mx * rs, s};
                }
            asm volatile("s_waitcnt lgkmcnt(0)" ::: "memory"); __builtin_amdgcn_s_barrier(); asm volatile("" ::: "memory");
#pragma unroll
            for (int ai = 0; ai < 2; ++ai)
#pragma unroll
                for (int m = 0; m < 4; ++m) {
                    const int rl = rls + ai * HALF + m * 16;
                    const f32x2 p0 = XS[rl * 4 + 0], p1 = XS[rl * 4 + 1], p2 = XS[rl * 4 + 2], p3 = XS[rl * 4 + 3];
                    const f32x2 me = XS[rl * 4 + wc];
                    const float MX = fmaxf(fmaxf(p0.x, p1.x), fmaxf(p2.x, p3.x));
                    const float L = p0.y * __builtin_amdgcn_exp2f(p0.x - MX) + p1.y * __builtin_amdgcn_exp2f(p1.x - MX) + p2.y * __builtin_amdgcn_exp2f(p2.x - MX) + p3.y * __builtin_amdgcn_exp2f(p3.x - MX);
                    const float f = 1.0f / L; (void)me;
                    const size_t row = (size_t)(u.orow + rl);
                    const float rs = rsv[ai][m];
#pragma unroll
                    for (int bj = 0; bj < 2; ++bj) {
                        float v[8]; get8(acc, ai, bj, m, v);
#pragma unroll
                        for (int j = 0; j < 8; ++j) v[j] = __builtin_amdgcn_exp2f(v[j] * rs - MX) * f;
                        *(u32x4*)(P + row * DM + u.ocol + bj * HALF + wc * 32 + 8 * fq) = pack8(v);
                    }
                }
            asm volatile("s_waitcnt lgkmcnt(0)" ::: "memory"); __builtin_amdgcn_s_barrier(); asm volatile("" ::: "memory");
            return;
        }
        if (kind == K_GU) {
            bf16_t* ACT = (bf16_t*)(ws + WS_ACT);
            int rb = u.orow + wr * 64 + fr; asm volatile("" : "+v"(rb));
            float rsv[2][4];
#pragma unroll
            for (int ai = 0; ai < 2; ++ai)
#pragma unroll
                for (int m = 0; m < 4; ++m) rsv[ai][m] = ((const float*)(ws + WS_RS2))[rb + ai * HALF + m * 16];
#pragma unroll
            for (int ai = 0; ai < 2; ++ai)
#pragma unroll
                for (int m = 0; m < 4; ++m) {
                    const size_t row = (size_t)(rb + ai * HALF + m * 16);
                    const float rs = rsv[ai][m];
                    float g[8], w[8]; get8(acc, ai, 0, m, g); get8(acc, ai, 1, m, w);
#pragma unroll
                    for (int j = 0; j < 8; ++j) { const float gg = g[j] * rs; g[j] = gg * fsigmoid(gg) * (w[j] * rs); }
                    *(u32x4*)(ACT + row * FF + u.pn * HALF + wc * 32 + 8 * fq) = pack8(g);
                }
            return;
        }
        if (kind == K_S5E) {
            float* E = (float*)(ws + WS_EBUF);
            int rb = u.orow + wr * 64 + fr; asm volatile("" : "+v"(rb));
            int cb = wc * 32 + 8 * fq; asm volatile("" : "+v"(cb));
#pragma unroll
            for (int ai = 0; ai < 2; ++ai)
#pragma unroll
                for (int m = 0; m < 4; ++m) {
                    const size_t row = (size_t)(rb + ai * HALF + m * 16);
                    float* p = E + row * 128 + cb;
                    *(f32x4*)p = acc[ai][0][m][0]; *(f32x4*)(p + 4) = acc[ai][0][m][1];
                }
            return;
        }
        if (kind == K_IN) {
            const int pn = u.pn;
            if (pn < 4) tiles<1>(acc, u.orow, wr, wc, fr, fq, (bf16_t*)(ws + WS_U), DM, pn * BM, nullptr);
            else if (pn < 8) tiles<7>(acc, u.orow, wr, wc, fr, fq, (bf16_t*)(ws + WS_V), DM, (pn & 3) * BM, (const bf16_t*)(ws + WS_VST));
            else if (pn < 10) tiles<3>(acc, u.orow, wr, wc, fr, fq, (bf16_t*)(ws + WS_UC), 0, (pn - 8) * BM, nullptr);
            else tiles<2>(acc, u.orow, wr, wc, fr, fq, (bf16_t*)(ws + (pn < 14 ? WS_SC : WS_SD)), DM, ((pn - 10) & 3) * BM, nullptr);
        } else if (kind == K_KVPROJ) tiles<0>(acc, u.orow, wr, wc, fr, fq, (bf16_t*)(ws + (u.pn < 4 ? WS_KB : WS_VB)), DM, (u.pn & 3) * BM, nullptr);
        else if (kind == K_MB) tiles<6>(acc, u.orow, wr, wc, fr, fq, (bf16_t*)(ws + WS_MB), DM, u.ocol, nullptr);
        else if (kind == K_NB) tiles<0>(acc, u.orow, wr, wc, fr, fq, (bf16_t*)(ws + WS_NB), DM, u.ocol, nullptr);
        else if (kind == K_S5Y) tiles<1>(acc, u.orow, wr, wc, fr, fq, (bf16_t*)(ws + WS_U), 1024, u.ocol, nullptr);
        else if (kind == K_GLU) tiles<4>(acc, u.orow, wr, wc, fr, fq, (bf16_t*)(ws + WS_SB), DM, u.ocol, (const bf16_t*)(ws + WS_U));
        else if (kind == K_BR) tiles<5>(acc, u.orow, wr, wc, fr, fq, (bf16_t*)(ws + WS_SC), DM, u.ocol, (const bf16_t*)(ws + WS_SD));
        else if (kind == K_MIX) tiles<0>(acc, u.orow, wr, wc, fr, fq, (bf16_t*)(ws + WS_SA), DM, u.ocol, nullptr);
        else if (kind == K_OPROJ) tiles<0>(acc, u.orow, wr, wc, fr, fq, (bf16_t*)(ws + WS_SD), DM, u.ocol, nullptr);
        else tiles<0>(acc, u.orow, wr, wc, fr, fq, (bf16_t*)(ws + WS_SC), DM, u.ocol, nullptr);
    }
    template <int MODE>
    __device__ __forceinline__ void tiles(const f32x4 (&acc)[2][2][4][2], int orow, int wr, int wc, int fr, int fq, bf16_t* base, int ld, int colbase, const bf16_t* aux) const {
        int rb = orow + wr * 64 + fr; asm volatile("" : "+v"(rb));
        int cb = colbase + wc * 32 + 8 * fq; asm volatile("" : "+v"(cb));
#pragma unroll
        for (int ai = 0; ai < 2; ++ai) {
            u32x4 ax[4][2];
            if (MODE == 4 || MODE == 5) {
#pragma unroll
                for (int m = 0; m < 4; ++m)
#pragma unroll
                    for (int bj = 0; bj < 2; ++bj) {
                        const size_t row = (size_t)(rb + ai * HALF + m * 16); const int col = cb + bj * HALF;
                        if (MODE == 4) ax[m][bj] = *(const u32x4*)(aux + ((size_t)(col >> 4) * M_TOK + row) * 16 + (col & 15));
                        else ax[m][bj] = *(const u32x4*)(aux + row * DM + col);
                    }
            }
#pragma unroll
            for (int m = 0; m < 4; ++m) {
                const int rowi = rb + ai * HALF + m * 16; const size_t row = (size_t)rowi;
                float st1 = 0.f, st2 = 0.f;
#pragma unroll
                for (int bj = 0; bj < 2; ++bj) {
                    const int col = cb + bj * HALF;
                    float v[8]; get8(acc, ai, bj, m, v);
                    bf16_t* dst = base + row * ld + col;
                    if (MODE == 1 || MODE == 7) {
#pragma unroll
                        for (int j = 0; j < 8; ++j) v[j] = gelu_t(v[j]);
                        if (MODE == 7) {
#pragma unroll
                            for (int j = 0; j < 8; ++j) { st1 += v[j]; st2 += v[j] * v[j]; }
                        }
                    } else if (MODE == 2) {
#pragma unroll
                        for (int j = 0; j < 8; ++j) v[j] = fsigmoid(v[j]);
                    } else if (MODE == 3) {
                        const int g = col >> 4, h0 = col & 15;
                        dst = base + ((size_t)(g * 1024 + (rowi >> 6))) * 1152 + (rowi & 63) * 16 + h0;
                    } else if (MODE == 4) {
                        float y[8]; unpack8(ax[m][bj], y);
#pragma unroll
                        for (int j = 0; j < 8; ++j) v[j] = y[j] * fsigmoid(v[j]);
                    } else if (MODE == 5) {
                        float b[8]; unpack8(ax[m][bj], b);
#pragma unroll
                        for (int j = 0; j < 8; ++j) v[j] *= b[j];
                    } else if (MODE == 6) {
#pragma unroll
                        for (int j = 0; j < 8; ++j) v[j] *= 0.0625f;
                    }
                    *(u32x4*)dst = pack8(v);
                }
                if (MODE == 7) {
                    st1 += shx(st1, fr + 16 * fq, 16); st1 += shx(st1, fr + 16 * fq, 32); st2 += shx(st2, fr + 16 * fq, 16); st2 += shx(st2, fr + 16 * fq, 32);
                    if (fq == 0) ((f32x2*)aux)[row * 16 + (colbase >> 8) * 4 + wc] = (f32x2){st1, st2};
                }
                if (MODE != 4 && MODE != 5) asm volatile("" ::: "memory");
            }
            asm volatile("" ::: "memory");
        }
    }
};

__device__ __forceinline__ void gemm_phase(LAS unsigned char* lds, const Sched& S, const Epi& E, const int tid) {
    const int wid = __builtin_amdgcn_readfirstlane(tid >> 6), lane = tid & 63, wr = wid >> 2, wc = wid & 3, fr = lane & 15, fq = lane >> 4;
    const unsigned ldsw = (unsigned)wid * 1024u;
    const int aoff = lds_byte(wr * 64 + fr, fq * 8), boff = lds_byte(wc * 32 + fr, fq * 8);
#define PG8_SA(b, h) (((b) * 2 + (h)) * HTB)
#define PG8_SB(b, h) ((4 + (b) * 2 + (h)) * HTB)
#define PG8_STAGE(bufoff, gbase, v0, v1) do { \
        __builtin_amdgcn_global_load_lds((const unsigned*)((const char*)(gbase) + (v0)), (LAS unsigned*)(lds + (bufoff) + ldsw), 16, 0, 0); \
        __builtin_amdgcn_global_load_lds((const unsigned*)((const char*)(gbase) + (v1)), (LAS unsigned*)(lds + (bufoff) + ldsw + 8192), 16, 0, 0); } while (0)
#define PG8_LDA(dst, b, h) do { _Pragma("unroll") for (int m = 0; m < 4; ++m) _Pragma("unroll") for (int k = 0; k < 2; ++k) dst[m][k] = *(const LAS bf16x8*)(lds + PG8_SA(b, h) + aoff + m * 2048 + k * 1024); } while (0)
#define PG8_LDB(dst, b, h) do { _Pragma("unroll") for (int n = 0; n < 2; ++n) _Pragma("unroll") for (int k = 0; k < 2; ++k) dst[n][k] = *(const LAS bf16x8*)(lds + PG8_SB(b, h) + boff + n * 2048 + k * 1024); } while (0)
#define PG8_MMA(ai, bj, At, Bt) do { __builtin_amdgcn_s_setprio(1); _Pragma("unroll") for (int m = 0; m < 4; ++m) _Pragma("unroll") for (int n = 0; n < 2; ++n) _Pragma("unroll") for (int k = 0; k < 2; ++k) \
        acc[ai][bj][m][n] = __builtin_amdgcn_mfma_f32_16x16x32_bf16(Bt[n][k], At[m][k], acc[ai][bj][m][n], 0, 0, 0); __builtin_amdgcn_s_setprio(0); } while (0)
#define PG8_WAIT_V(n) asm volatile("s_waitcnt vmcnt(" #n ")" ::: "memory")
#define PG8_WAIT_L(n) asm volatile("s_waitcnt lgkmcnt(" #n ")" ::: "memory")
#define PG8_BAR __builtin_amdgcn_s_barrier()
#define PG8_SCHED __builtin_amdgcn_sched_barrier(0)
    Unit cur, nxt; int ui = 0;
    if (!S.next(0, cur)) return;
    nxt = cur;
    f32x4 acc[2][2][4][2];
#pragma unroll
    for (int a = 0; a < 2; ++a)
#pragma unroll
        for (int b = 0; b < 2; ++b)
#pragma unroll
            for (int m = 0; m < 4; ++m)
#pragma unroll
                for (int n = 0; n < 2; ++n) acc[a][b][m][n] = (f32x4){0.f, 0.f, 0.f, 0.f};
    bf16x8 At[4][2], B0[2][2], B1[2][2];
    const Drv dc = derive(cur, tid);
    const char* cA = cur.A; const char* cB = cur.B;
    PG8_STAGE(PG8_SB(0, 0), cB, dc.vB0, dc.vB1); PG8_STAGE(PG8_SB(0, 1), cB + dc.hB, dc.vB0, dc.vB1); PG8_STAGE(PG8_SA(0, 0), cA, dc.vA0, dc.vA1); PG8_STAGE(PG8_SA(0, 1), cA + dc.hA, dc.vA0, dc.vA1);
    if (wr == 1) PG8_BAR;
    PG8_WAIT_V(2); PG8_BAR;
    PG8_STAGE(PG8_SB(1, 0), cB + 128, dc.vB0, dc.vB1); PG8_STAGE(PG8_SA(1, 0), cA + dc.kA, dc.vA0, dc.vA1); PG8_STAGE(PG8_SB(1, 1), cB + dc.hB + 128, dc.vB0, dc.vB1);
    PG8_WAIT_V(6); PG8_BAR;
    for (;;) {
        const bool has_next = S.next(ui + 1, nxt);
        const char* nA = cA; const char* nB = cB;
        if (has_next) { nA = nxt.A; nB = nxt.B; }
        const int nt = cur.nt;
        for (int t = 0; t < nt; t += 2) {
            const bool last = (t == nt - 2);
            if (cur.kind == K_BR && t == 16) E.mid(acc, cur, wr, wc, fr, fq);
            const size_t aj = (cur.kind == K_BR) ? (size_t)(WS_SB - WS_SA) - 16 * 128 : 0;
            const char* a1 = cA + (size_t)(t + 1) * dc.kA + (t >= 16 ? aj : 0);
            const char* a2 = last ? nA : cA + (size_t)(t + 2) * dc.kA + (t >= 14 ? aj : 0); const char* b2 = last ? nB : cB + (size_t)(t + 2) * 128;
            const unsigned xA0 = dc.vA0, xA1 = dc.vA1, xB0 = dc.vB0, xB1 = dc.vB1, xk = dc.kA, xhA = dc.hA, xhB = dc.hB;
            const char* a3 = a2 + xk; const char* b3 = b2 + 128;
            PG8_LDB(B0, 0, 0); PG8_LDB(B1, 0, 1); PG8_SCHED; PG8_LDA(At, 0, 0); PG8_STAGE(PG8_SA(1, 1), a1 + dc.hA, dc.vA0, dc.vA1);
            PG8_WAIT_V(8); PG8_WAIT_L(0); PG8_BAR; PG8_MMA(0, 0, At, B0); PG8_MMA(0, 1, At, B1); PG8_BAR; PG8_SCHED;
            PG8_LDA(At, 0, 1); PG8_STAGE(PG8_SB(0, 0), b2, xB0, xB1); PG8_STAGE(PG8_SB(0, 1), b2 + xhB, xB0, xB1); PG8_STAGE(PG8_SA(0, 0), a2, xA0, xA1);
            PG8_WAIT_V(8); PG8_WAIT_L(0); PG8_BAR; PG8_MMA(1, 0, At, B0); PG8_MMA(1, 1, At, B1); PG8_BAR; PG8_SCHED;
            PG8_LDB(B0, 1, 0); PG8_LDB(B1, 1, 1); PG8_SCHED; PG8_LDA(At, 1, 0); PG8_STAGE(PG8_SA(0, 1), a2 + xhA, xA0, xA1);
            PG8_WAIT_V(8); PG8_WAIT_L(0); PG8_BAR; PG8_MMA(0, 0, At, B0); PG8_MMA(0, 1, At, B1); PG8_BAR; PG8_SCHED;
            PG8_LDA(At, 1, 1); PG8_STAGE(PG8_SB(1, 0), b3, xB0, xB1); PG8_STAGE(PG8_SB(1, 1), b3 + xhB, xB0, xB1); PG8_STAGE(PG8_SA(1, 0), a3, xA0, xA1);
            PG8_WAIT_V(8); PG8_WAIT_L(0); PG8_BAR; PG8_MMA(1, 0, At, B0); PG8_MMA(1, 1, At, B1); PG8_BAR; PG8_SCHED;
        }
        if (wr == 0) PG8_BAR;
        E(acc, cur, wr, wc, fr, fq);
        if (!has_next) break;
#pragma unroll
        for (int a = 0; a < 2; ++a)
#pragma unroll
            for (int b = 0; b < 2; ++b)
#pragma unroll
                for (int m = 0; m < 4; ++m)
#pragma unroll
                    for (int n = 0; n < 2; ++n) acc[a][b][m][n] = (f32x4){0.f, 0.f, 0.f, 0.f};
        cur = nxt; cA = nA; cB = nB; ++ui;
        if (wr == 1) PG8_BAR;
    }
    PG8_WAIT_V(0);
    PG8_BAR;
#undef PG8_SA
#undef PG8_SB
#undef PG8_STAGE
#undef PG8_LDA
#undef PG8_LDB
#undef PG8_MMA
#undef PG8_WAIT_V
#undef PG8_WAIT_L
#undef PG8_BAR
#undef PG8_SCHED
}
}

__device__ __forceinline__ void transpose_item(const float* W, int N, bf16_t* WT, int ldt, int col_off, int rmode, LAS float* scr, int item, int lane, const float* kscale = nullptr) {
    const int nblk = N / 32, kb = item / nblk, nb = item % nblk, k0 = 64 * kb, n0 = 32 * nb;
    f32x4 wv[8];
#pragma unroll
    for (int i = 0; i < 8; ++i) { wv[i] = *(const f32x4*)(W + (size_t)(k0 + 8 * i + (lane >> 3)) * N + n0 + 4 * (lane & 7)); if (kscale) wv[i] = wv[i] * kscale[k0 + 8 * i + (lane >> 3)]; }
#pragma unroll
    for (int i = 0; i < 8; ++i) { LAS float* d = scr + (8 * i + (lane >> 3)) * 33 + 4 * (lane & 7); d[0] = wv[i][0]; d[1] = wv[i][1]; d[2] = wv[i][2]; d[3] = wv[i][3]; }
    asm volatile("s_waitcnt lgkmcnt(0)" ::: "memory");
    int r0 = n0;
    if (rmode == 1) { const int isu = n0 >= FF, nn = isu ? n0 - FF : n0; r0 = 256 * (nn >> 7) + (nn & 127) + (isu ? 128 : 0); }
    const int c = lane & 7;
#pragma unroll
    for (int j = 0; j < 4; ++j) { const int n = (lane >> 3) + 8 * j; const LAS float* s = scr + (8 * c) * 33 + n;
        u32x4 o; o.x = cvt_pk_bf16(s[0 * 33], s[1 * 33]); o.y = cvt_pk_bf16(s[2 * 33], s[3 * 33]); o.z = cvt_pk_bf16(s[4 * 33], s[5 * 33]); o.w = cvt_pk_bf16(s[6 * 33], s[7 * 33]);
        *(u32x4*)(WT + (size_t)(r0 + n) * ldt + col_off + k0 + 8 * c) = o; }
    asm volatile("s_waitcnt lgkmcnt(0)" ::: "memory");
}
template <int R>
__device__ __forceinline__ void rms_rows_to_bf16(const float* x0, size_t xstride, const float* g, bf16_t* o0, size_t ostride, int lane) {
    f32x4 v[R][4]; float s[R];
#pragma unroll
    for (int r = 0; r < R; ++r)
#pragma unroll
        for (int j = 0; j < 2; ++j) { v[r][2 * j] = *(const f32x4*)(x0 + r * xstride + 512 * j + 8 * lane); v[r][2 * j + 1] = *(const f32x4*)(x0 + r * xstride + 512 * j + 8 * lane + 4); }
#pragma unroll
    for (int r = 0; r < R; ++r) { s[r] = 0.f;
#pragma unroll
        for (int j = 0; j < 4; ++j) s[r] += (v[r][j][0] * v[r][j][0] + v[r][j][1] * v[r][j][1]) + (v[r][j][2] * v[r][j][2] + v[r][j][3] * v[r][j][3]); }
#pragma unroll
    for (int o = 1; o < 64; o <<= 1)
#pragma unroll
        for (int r = 0; r < R; ++r) s[r] += shx(s[r], lane, o);
    f32x4 gg[4];
#pragma unroll
    for (int j = 0; j < 2; ++j) { gg[2 * j] = *(const f32x4*)(g + 512 * j + 8 * lane); gg[2 * j + 1] = *(const f32x4*)(g + 512 * j + 8 * lane + 4); }
#pragma unroll
    for (int r = 0; r < R; ++r) {
        const float rstd = 1.f / sqrtf(s[r] * (1.f / DM) + EPS);
#pragma unroll
        for (int j = 0; j < 2; ++j) {
            const f32x4 a = v[r][2 * j] * rstd * gg[2 * j], b = v[r][2 * j + 1] * rstd * gg[2 * j + 1];
            u32x4 w; w.x = cvt_pk_bf16(a[0], a[1]); w.y = cvt_pk_bf16(a[2], a[3]); w.z = cvt_pk_bf16(b[0], b[1]); w.w = cvt_pk_bf16(b[2], b[3]);
            *(u32x4*)(o0 + r * ostride + 512 * j + 8 * lane) = w;
        }
    }
}
template <bool XIN_BF, bool XOUT_BF>
__device__ __forceinline__ void rowpass(const bf16_t* m, const float* gpost, const void* xin_, void* xout_, const float* gpre, bf16_t* hout, float* rsout, int gw, int NGW, int lane, int row_end) {
    constexpr int R = 4;
    const float* xin = (const float*)xin_; const bf16_t* xinb = (const bf16_t*)xin_; float* xout = (float*)xout_; bf16_t* xoutb = (bf16_t*)xout_;
    for (int row0 = gw; row0 < row_end; row0 += R * NGW) {
        u32x4 mw[R][2]; f32x4 xv[R][4]; u32x4 xw[R][2];
#pragma unroll
        for (int r = 0; r < R; ++r) { const size_t ro = (size_t)(row0 + r * NGW) * DM;
#pragma unroll
            for (int j = 0; j < 2; ++j) { mw[r][j] = *(const u32x4*)(m + ro + 512 * j + 8 * lane);
                if (XIN_BF) xw[r][j] = *(const u32x4*)(xinb + ro + 512 * j + 8 * lane);
                else { xv[r][2 * j] = *(const f32x4*)(xin + ro + 512 * j + 8 * lane); xv[r][2 * j + 1] = *(const f32x4*)(xin + ro + 512 * j + 8 * lane + 4); } } }
        f32x4 gp[4];
#pragma unroll
        for (int j = 0; j < 2; ++j) { gp[2 * j] = *(const f32x4*)(gpost + 512 * j + 8 * lane); gp[2 * j + 1] = *(const f32x4*)(gpost + 512 * j + 8 * lane + 4); }
        float mv[R][2][8]; float ss[R];
#pragma unroll
        for (int r = 0; r < R; ++r) { ss[r] = 0.f;
#pragma unroll
            for (int j = 0; j < 2; ++j) { unpack8(mw[r][j], mv[r][j]);
#pragma unroll
                for (int i = 0; i < 8; ++i) ss[r] += mv[r][j][i] * mv[r][j][i]; } }
#pragma unroll
        for (int o = 1; o < 64; o <<= 1)
#pragma unroll
            for (int r = 0; r < R; ++r) ss[r] += shx(ss[r], lane, o);
        float x1[R][2][8]; float s2[R];
#pragma unroll
        for (int r = 0; r < R; ++r) {
            const size_t ro = (size_t)(row0 + r * NGW) * DM;
            const float rstd = 1.f / sqrtf(ss[r] * (1.f / DM) + EPS); s2[r] = 0.f;
#pragma unroll
            for (int j = 0; j < 2; ++j) {
                const int c = 512 * j + 8 * lane;
                float xi[8];
                if (XIN_BF) unpack8(xw[r][j], xi);
                else {
#pragma unroll
                    for (int i = 0; i < 4; ++i) { xi[i] = xv[r][2 * j][i]; xi[4 + i] = xv[r][2 * j + 1][i]; }
                }
#pragma unroll
                for (int i = 0; i < 4; ++i) { x1[r][j][i] = xi[i] + mv[r][j][i] * rstd * gp[2 * j][i]; x1[r][j][4 + i] = xi[4 + i] + mv[r][j][4 + i] * rstd * gp[2 * j + 1][i]; }
#pragma unroll
                for (int i = 0; i < 8; ++i) s2[r] += x1[r][j][i] * x1[r][j][i];
                if (XOUT_BF) *(u32x4*)(xoutb + ro + c) = pack8(x1[r][j]);
                else { *(f32x4*)(xout + ro + c) = (f32x4){x1[r][j][0], x1[r][j][1], x1[r][j][2], x1[r][j][3]}; *(f32x4*)(xout + ro + c + 4) = (f32x4){x1[r][j][4], x1[r][j][5], x1[r][j][6], x1[r][j][7]}; }
            }
        }
        if (hout || rsout) {
#pragma unroll
            for (int o = 1; o < 64; o <<= 1)
#pragma unroll
                for (int r = 0; r < R; ++r) s2[r] += shx(s2[r], lane, o);
        }
        if (rsout) {
#pragma unroll
            for (int r = 0; r < R; ++r) if (lane == 0) rsout[row0 + r * NGW] = 1.f / sqrtf(s2[r] * (1.f / DM) + EPS);
        }
        if (hout) {
#pragma unroll
            for (int j = 0; j < 2; ++j) { gp[2 * j] = *(const f32x4*)(gpre + 512 * j + 8 * lane); gp[2 * j + 1] = *(const f32x4*)(gpre + 512 * j + 8 * lane + 4); }
#pragma unroll
            for (int r = 0; r < R; ++r) {
                const size_t ro = (size_t)(row0 + r * NGW) * DM;
                const float r2 = 1.f / sqrtf(s2[r] * (1.f / DM) + EPS);
#pragma unroll
                for (int j = 0; j < 2; ++j) {
                    float h[8];
#pragma unroll
                    for (int i = 0; i < 4; ++i) { h[i] = x1[r][j][i] * r2 * gp[2 * j][i]; h[4 + i] = x1[r][j][4 + i] * r2 * gp[2 * j + 1][i]; }
                    *(u32x4*)(hout + ro + 512 * j + 8 * lane) = pack8(h);
                }
            }
        }
    }
}

__device__ __forceinline__ void s5_build(LAS unsigned char* lds, unsigned char* ws, const float* lam_re, const float* lam_im, const float* log_step, const float* b_re,
                                         const float* b_im, const float* c_re, const float* c_im, const float* dvec, int g, int tid) {
    LAS f32x2* AP = (LAS f32x2*)lds;
    LAS f32x2* BB = (LAS f32x2*)(lds + 33280);
    LAS f32x2* CC = (LAS f32x2*)(lds + 41472);
    LAS float* KT = (LAS float*)(lds + 49664);
    const float step = expf(log_step[g]);
    for (int i = tid; i < 64 * 65; i += 512) {
        const int p = i / 65, tau = i % 65;
        const float lr = lam_re[g * 64 + p], li = lam_im[g * 64 + p];
        const float mag = expf(lr * step * (float)tau);
        const double ang = (double)li * (double)step * (double)tau;
        const double kq = rint(ang * 0.15915494309189535);
        const float r = (float)(ang - kq * 6.283185307179586);
        AP[p * 65 + tau] = (f32x2){mag * cosf(r), mag * sinf(r)};
    }
    for (int i = tid; i < 64 * 16; i += 512) {
        const int p = i >> 4, h = i & 15;
        const float lr = lam_re[g * 64 + p], li = lam_im[g * 64 + p];
        const float x = lr * step, mag = expf(x), em1 = expm1f(x);
        const double ang = (double)li * (double)step; const double kq = rint(ang * 0.15915494309189535);
        const float r = (float)(ang - kq * 6.283185307179586);
        const float sh = sinf(0.5f * r), cm1 = -2.f * sh * sh, sn = sinf(r), cs = 1.f + cm1;
        const float nr = em1 * cs + cm1, ni = mag * sn;
        const float den = lr * lr + li * li;
        const float co_re = (nr * lr + ni * li) / den, co_im = (ni * lr - nr * li) / den;
        const float br = b_re[(g * 64 + p) * 16 + h], bi = b_im[(g * 64 + p) * 16 + h];
        BB[p * 16 + h] = (f32x2){co_re * br - co_im * bi, co_re * bi + co_im * br};
        const int hh = i >> 6, pp = i & 63;
        CC[hh * 64 + pp] = (f32x2){c_re[(g * 16 + hh) * 64 + pp], c_im[(g * 16 + hh) * 64 + pp]};
    }
    __syncthreads();
    for (int it = 0; it < 2; ++it) {
        const int tau = tid & 63, hp = (tid >> 6) + 8 * it;
        float a[16];
#pragma unroll
        for (int h = 0; h < 16; ++h) a[h] = 0.f;
        for (int p = 0; p < 64; ++p) {
            const f32x2 c = CC[hp * 64 + p], ap = AP[p * 65 + tau];
            const float xr = c.x * ap.x - c.y * ap.y, xi = c.x * ap.y + c.y * ap.x;
#pragma unroll
            for (int h = 0; h < 16; ++h) { const f32x2 b = BB[p * 16 + h]; a[h] += xr * b.x - xi * b.y; }
        }
        if (tau == 0) {
#pragma unroll
            for (int h = 0; h < 16; ++h) if (h == hp) a[h] += dvec[g * 16 + hp];
        }
#pragma unroll
        for (int h = 0; h < 16; ++h) KT[tau * KTS + hp * 16 + h] = a[h];
    }
    __syncthreads();
    { const LAS f32x4* src = (const LAS f32x4*)lds; f32x4* dst = (f32x4*)(ws + WS_S5T + (size_t)g * S5T_BYTES);
      for (int i = tid; i < S5T_BYTES / 16; i += 512) dst[i] = src[i]; }
    if (tid < 64) ((f32x2*)(ws + WS_A64))[g * 64 + tid] = AP[tid * 65 + 64];
    __syncthreads();
}
__device__ __forceinline__ void s5_expand(LAS unsigned char* lds, unsigned char* ws, int g, int part, int tid) {
    LAS f32x2* AP = (LAS f32x2*)lds; LAS f32x2* BB = (LAS f32x2*)(lds + 33280); LAS f32x2* CC = (LAS f32x2*)(lds + 41472); LAS float* KT = (LAS float*)(lds + 49664);
    { const f32x4* src = (const f32x4*)(ws + WS_S5T + (size_t)g * S5T_BYTES); LAS f32x4* dst = (LAS f32x4*)lds;
      for (int i = tid; i < S5T_BYTES / 16; i += 512) dst[i] = src[i]; }
    __syncthreads();
    bf16_t* BT2 = (bf16_t*)(ws + WS_BT2) + (size_t)g * 1024 * 1152;
    for (int i = tid; i < 128 * 144; i += 512) {
        const int rl = i / 144, cc = i % 144, t = 8 * part + (rl >> 4), hp = rl & 15;
        float v[8];
        if (cc < 128) {
            const int s = cc >> 1, h0 = (cc & 1) * 8;
            if (s <= t) {
#pragma unroll
                for (int j = 0; j < 8; ++j) v[j] = KT[(t - s) * KTS + hp * 16 + h0 + j];
            } else {
#pragma unroll
                for (int j = 0; j < 8; ++j) v[j] = 0.f;
            }
        } else {
            const int p0 = (cc - 128) * 4;
#pragma unroll
            for (int j = 0; j < 4; ++j) { const f32x2 c = CC[hp * 64 + p0 + j], ap = AP[(p0 + j) * 65 + t + 1];
                v[2 * j] = c.x * ap.x - c.y * ap.y; v[2 * j + 1] = -(c.x * ap.y + c.y * ap.x); }
        }
        *(u32x4*)(BT2 + (size_t)(t * 16 + hp) * 1152 + cc * 8) = pack8(v);
    }
    bf16_t* BT1 = (bf16_t*)(ws + WS_BT1) + (size_t)g * 128 * 1152;
    for (int i = tid; i < 16 * 128; i += 512) {
        const int rl = i >> 7, cc = i & 127, p = 8 * part + (rl >> 1), ri = rl & 1, s = cc >> 1, h0 = (cc & 1) * 8;
        const f32x2 ap = AP[p * 65 + 63 - s];
        float v[8];
#pragma unroll
        for (int j = 0; j < 8; ++j) { const f32x2 b = BB[p * 16 + h0 + j]; v[j] = ri ? (ap.x * b.y + ap.y * b.x) : (ap.x * b.x - ap.y * b.y); }
        *(u32x4*)(BT1 + (size_t)(2 * p + ri) * 1152 + cc * 8) = pack8(v);
    }
    __syncthreads();
}

__device__ __forceinline__ void spatial_phase(LAS unsigned char* lds, unsigned char* ws, const float* ln_g, const float* ln_b, const float* b_s, int vcu, int G, const int tid) {
    __syncthreads();
    const int wid = __builtin_amdgcn_readfirstlane(tid >> 6), lane = tid & 63, fr = lane & 15, fq = lane >> 4;
    LAS f32x2* ST = (LAS f32x2*)lds;
    LAS bf16_t* VT = (LAS bf16_t*)(lds + 1024);
    LAS float* LG = (LAS float*)(lds + 36864);
    LAS float* LB = (LAS float*)(lds + 40960);
    const bf16_t* U = (const bf16_t*)(ws + WS_U); const bf16_t* V = (const bf16_t*)(ws + WS_V); bf16_t* YC = (bf16_t*)(ws + WS_SA);
    const bf16_t* WSP = (const bf16_t*)(ws + WS_WSP);
    for (int i = tid; i < 1024; i += 512) { LG[i] = ln_g[i]; LB[i] = ln_b[i]; }
    const int kmax = (16 * wid + 15) >> 5, t = 16 * wid + fr;
    for (int unit = vcu; unit < M_TOK / 128; unit += G) {
        const size_t r0 = (size_t)unit * 128;
        u32x4 vreg[4];
#pragma unroll
        for (int it = 0; it < 4; ++it) { const int idx = wid * 4 + it, s = (idx & 1) * 64 + lane, c0 = (idx >> 1) * 8; vreg[it] = *(const u32x4*)(V + (r0 + s) * DM + c0); }
        {
            const f32x4* pv = (const f32x4*)((const float*)(ws + WS_VST) + ((r0 + 16 * wid + (lane >> 2)) * 16 + 4 * (lane & 3)) * 2);
            const f32x4 p0 = pv[0], p1 = pv[1];
            float s1 = (p0[0] + p0[2]) + (p1[0] + p1[2]), s2 = (p0[1] + p0[3]) + (p1[1] + p1[3]);
            s1 += shx(s1, lane, 1); s1 += shx(s1, lane, 2); s2 += shx(s2, lane, 1); s2 += shx(s2, lane, 2);
            const float mean = s1 * (1.f / DM), var = fmaxf(s2 * (1.f / DM) - mean * mean, 0.f);
            if ((lane & 3) == 0) ST[16 * wid + (lane >> 2)] = (f32x2){mean, 1.f / sqrtf(var + EPS)};
        }
        __syncthreads();
        for (int g = 0; g < 8; ++g) {
#pragma unroll
            for (int it = 0; it < 4; ++it) {
                const int idx = wid * 4 + it, s = (idx & 1) * 64 + lane, c0 = (idx >> 1) * 8;
                float v[8]; unpack8(vreg[it], v);
                const f32x2 st = ST[s];
                const f32x4 g0 = *(const LAS f32x4*)(LG + g * 128 + c0), g1 = *(const LAS f32x4*)(LG + g * 128 + c0 + 4), e0 = *(const LAS f32x4*)(LB + g * 128 + c0), e1 = *(const LAS f32x4*)(LB + g * 128 + c0 + 4);
#pragma unroll
                for (int i = 0; i < 8; ++i) {
                    const int c = c0 + i, rho = (c & ~31) + 16 * ((c >> 2) & 1) + 4 * ((c & 31) >> 3) + (c & 3);
                    const float gm = i < 4 ? g0[i] : g1[i - 4], be = i < 4 ? e0[i] : e1[i - 4];
                    const float val = (v[i] - st.x) * st.y * gm + be;
                    VT[rho * 136 + s] = (bf16_t)(cvt_pk_bf16(val, 0.f) & 0xffffu);
                }
            }
            bf16x8 wf[4];
#pragma unroll
            for (int kk = 0; kk < 4; ++kk) if (kk <= kmax) wf[kk] = *(const bf16x8*)(WSP + ((size_t)(g * 128 + t)) * 128 + 32 * kk + 8 * fq);
            const float bias = b_s[g * 128 + t];
            u32x4 ureg[4];
#pragma unroll
            for (int b = 0; b < 4; ++b) ureg[b] = *(const u32x4*)(U + (r0 + t) * DM + g * 128 + b * 32 + 8 * fq);
            if (g < 7) {
#pragma unroll
                for (int it = 0; it < 4; ++it) { const int idx = wid * 4 + it, s = (idx & 1) * 64 + lane, c0 = (idx >> 1) * 8; vreg[it] = *(const u32x4*)(V + (r0 + s) * DM + (g + 1) * 128 + c0); }
            }
            __syncthreads();
            f32x4 acc[4][2];
#pragma unroll
            for (int b = 0; b < 4; ++b) { acc[b][0] = (f32x4){0.f, 0.f, 0.f, 0.f}; acc[b][1] = (f32x4){0.f, 0.f, 0.f, 0.f}; }
#pragma unroll
            for (int kk = 0; kk < 4; ++kk) if (kk <= kmax) {
#pragma unroll
                for (int b = 0; b < 4; ++b)
#pragma unroll
                    for (int n = 0; n < 2; ++n) {
                        const bf16x8 vf = *(const LAS bf16x8*)(VT + (b * 32 + 16 * n + fr) * 136 + 32 * kk + 8 * fq);
                        acc[b][n] = __builtin_amdgcn_mfma_f32_16x16x32_bf16(vf, wf[kk], acc[b][n], 0, 0, 0);
                    }
            }
#pragma unroll
            for (int b = 0; b < 4; ++b) {
                float u8[8]; unpack8(ureg[b], u8);
                float o[8];
#pragma unroll
                for (int j = 0; j < 4; ++j) { o[j] = (acc[b][0][j] + bias) * u8[j]; o[4 + j] = (acc[b][1][j] + bias) * u8[4 + j]; }
                *(u32x4*)(YC + (r0 + t) * DM + g * 128 + b * 32 + 8 * fq) = pack8(o);
            }
            __syncthreads();
        }
    }
}


#define XB_TMO      128
#define XB_XCNT(j)  (256  + 64 * (j))
#define XB_XSUB(j)  (1280 + 64 * (j))
#define XB_XGEN(j)  (2304 + 64 * (j))
#define XB_TOP      3328
#define XB_TOPGEN   3392
#define XB_SPIN_CAP (1u << 20)
__device__ __forceinline__ unsigned xb_ld(unsigned* p)              { return __hip_atomic_load(p, __ATOMIC_RELAXED, __HIP_MEMORY_SCOPE_AGENT); }
__device__ __forceinline__ unsigned xb_add(unsigned* p, unsigned v) { return __hip_atomic_fetch_add(p, v, __ATOMIC_RELAXED, __HIP_MEMORY_SCOPE_AGENT); }
__device__ __forceinline__ unsigned xb_xcc_id() { return (unsigned)__builtin_amdgcn_s_getreg((3 << 11) | 20) & 0xFu; }
#define XB_SPIN(cond, bar) do { unsigned _sp = 0; while (cond) { __builtin_amdgcn_s_sleep(1); \
    if ((++_sp & 255u) == 0u) { if (xb_ld(&(bar)[XB_TMO])) break; if (_sp > XB_SPIN_CAP) { atomicAdd(&(bar)[XB_TMO], 1u); break; } } } } while (0)
struct XcdBarrier { unsigned* bar; unsigned x; volatile LAS unsigned* st; };
__device__ __forceinline__ void xcd_barrier_post(unsigned* bar, int tid) { if (tid == 0) (void)xb_add(&bar[XB_XCNT(xb_xcc_id())], 1u); }
__device__ __forceinline__ void xcd_barrier_complete(unsigned* bar, unsigned x, unsigned& nloc, unsigned& nx) {
    const unsigned G = gridDim.x * gridDim.y * gridDim.z;
    unsigned sum, cnt, mine, sp = 0u;
    for (;;) {
        sum = 0u; cnt = 0u; mine = 0u;
#pragma unroll
        for (unsigned j = 0; j < 16; ++j) { const unsigned c = xb_ld(&bar[XB_XCNT(j)]); sum += c; cnt += (c > 0u) ? 1u : 0u; mine = (j == x) ? c : mine; }
        if (sum == G) break;
        __builtin_amdgcn_s_sleep(1);
        if ((++sp & 255u) == 0u) { if (xb_ld(&bar[XB_TMO])) break; if (sp > XB_SPIN_CAP) { atomicAdd(&bar[XB_TMO], 1u); break; } }
    }
    nloc = mine > 0u ? mine : 1u; nx = cnt > 0u ? cnt : 1u;
}
__device__ __forceinline__ void xcd_barrier(const XcdBarrier& b, int tid) {
    asm volatile("s_waitcnt vmcnt(0)" ::: "memory");
    __syncthreads();
    if (tid == 0) {
        unsigned* bar = b.bar;
        __builtin_amdgcn_s_waitcnt(0);
        unsigned nloc = b.st[0], nx = b.st[1];
        if (nloc == 0u) { xcd_barrier_complete(bar, b.x, nloc, nx); b.st[0] = nloc; b.st[1] = nx; }
        const unsigned old = xb_add(&bar[XB_XSUB(b.x)], 1u);
        const unsigned gen = old / nloc;
        if (old + 1u == (gen + 1u) * nloc) {
            __builtin_amdgcn_fence(__ATOMIC_RELEASE, "agent");
            asm volatile("s_waitcnt vmcnt(0)" ::: "memory");
            const unsigned og = xb_add(&bar[XB_TOP], 1u);
            const unsigned tg = og / nx;
            if (og + 1u == (tg + 1u) * nx) xb_add(&bar[XB_TOPGEN], 1u);
            else XB_SPIN(xb_ld(&bar[XB_TOPGEN]) == tg, bar);
            __builtin_amdgcn_fence(__ATOMIC_ACQUIRE, "agent");
            xb_add(&bar[XB_XGEN(b.x)], 1u);
            asm volatile("s_waitcnt vmcnt(0)" ::: "memory");
        } else {
            XB_SPIN(xb_ld(&bar[XB_XGEN(b.x)]) == gen, bar);
            __builtin_amdgcn_fence(__ATOMIC_ACQUIRE, "agent");
            asm volatile("s_waitcnt vmcnt(0)" ::: "memory");
        }
    }
    __syncthreads();
}

struct Args { const float* in[31]; float* out; unsigned char* ws; int ph_lo, ph_hi; };

__global__ void __launch_bounds__(512, 2) mk_fwd(Args args) {
    extern __shared__ __attribute__((aligned(16))) unsigned char lds_raw[];
    LAS unsigned char* lds = (LAS unsigned char*)lds_raw;
    const int G = gridDim.x, bx = blockIdx.x;
    const int vcu = (G % 8 == 0) ? (bx % 8) * (G / 8) + bx / 8 : bx;
    volatile LAS unsigned* xst = (volatile LAS unsigned*)(lds + LDS_XS + 8192);
    const bool multi = args.ph_hi - args.ph_lo > 1;
    if (multi) { if (threadIdx.x < 2) xst[threadIdx.x] = 0u; __syncthreads(); xcd_barrier_post((unsigned*)args.ws, (int)threadIdx.x); }

    for (int pi = args.ph_lo; pi < args.ph_hi; ++pi) {
        const int ph = pi;
        if (ph == 11 || ph == 12) continue;
        int tid = threadIdx.x; asm volatile("" : "+v"(tid));
        size_t wz = 0; asm volatile("" : "+s"(wz)); unsigned char* ws = args.ws + wz;
        const __attribute__((address_space(4))) char* kp = (const __attribute__((address_space(4))) char*)__builtin_amdgcn_kernarg_segment_ptr() + wz;
#define IN(i) ((const float*)(*(const __attribute__((address_space(1))) float* const __attribute__((address_space(4)))*)(kp + 8 * (i))))
        const int lane = tid & 63, wave = __builtin_amdgcn_readfirstlane(tid >> 6);
        const int gw = vcu * 8 + wave, NGW = G * 8;
        const bool panel_mode = (G == M_TOK / 256); const int panel = vcu;
        pg8::Epi E; E.ws = ws; E.lds = lds;
        bool is_gemm = false;
        if (ph == 0) {
            const bool split = (G % 32 == 0) && (G >= 128);
            const int nc = split ? (G / 32) * 12 : G, nm = split ? G - nc : G;
            const int ci = split ? (vcu % 32) * (G / 32) + (vcu / 32) : vcu, mi = split ? (vcu / 32) * 20 + (vcu % 32) - 12 : vcu;
            const bool do_c = !split || (vcu % 32) < 12, do_m = !split || (vcu % 32) >= 12;
            const int gwc = ci * 8 + wave, NGWC = nc * 8, gwm = mi * 8 + wave, NGWM = nm * 8;
            if (do_c) {
            for (int g = ci; g < 32; g += nc) s5_build(lds, ws, IN(8), IN(9), IN(10), IN(11), IN(12), IN(13), IN(14), IN(15), g, tid);
            LAS float* scr = (LAS float*)(lds + wave * 16384);
            constexpr int I_IN = 16 * (NIN / 32), I_BG = 16 * 32, I_BS = 8 * 32, I_MX = 16 * 32, I_GL = 8 * 16, I_Q = 16 * 32, I_KV = 16 * 64, I_O = 16 * 32, I_GU = 16 * (2 * FF / 32), I_DN = (FF / 64) * 32;
            constexpr int NIT = I_IN + I_BG + I_BS + I_MX + I_GL + I_KV + I_O + I_GU + I_DN;
            for (int it = gwc; it < NIT; it += NGWC) {
                int r = it;
                if (r < I_IN) { transpose_item(IN(3), NIN, (bf16_t*)(ws + WS_WIN), 1024, 0, 0, scr, r, lane); continue; } r -= I_IN;
                if (r < I_BG) { transpose_item(IN(17), 1024, (bf16_t*)(ws + WS_WBR), 1536, 0, 0, scr, r, lane); continue; } r -= I_BG;
                if (r < I_BS) { transpose_item(IN(18), 1024, (bf16_t*)(ws + WS_WBR), 1536, 1024, 0, scr, r, lane); continue; } r -= I_BS;
                if (r < I_MX) { transpose_item(IN(19), 1024, (bf16_t*)(ws + WS_WMIX), 1024, 0, 0, scr, r, lane); continue; } r -= I_MX;
                if (r < I_GL) { transpose_item(IN(16), 512, (bf16_t*)(ws + WS_WGLU), 512, 0, 0, scr, r, lane); continue; } r -= I_GL;
                if (r < I_KV) { transpose_item(IN(24), 2048, (bf16_t*)(ws + WS_WKV), 1152, 0, 0, scr, r, lane); continue; } r -= I_KV;
                if (r < I_O) { transpose_item(IN(25), 1024, (bf16_t*)(ws + WS_WO), 1024, 0, 0, scr, r, lane); continue; } r -= I_O;
                if (r < I_GU) { transpose_item(IN(28), 2 * FF, (bf16_t*)(ws + WS_WGU), 1024, 0, 1, scr, r, lane, IN(27)); continue; } r -= I_GU;
                transpose_item(IN(29), 1024, (bf16_t*)(ws + WS_WDN), FF, 0, 0, scr, r, lane);
            }
            {
                const float* w = IN(23); const float* gq = IN(21); bf16_t* o = (bf16_t*)(ws + WS_WQ);
                for (int i = ci * 512 + tid; i < 1024 * 1024 / 8; i += nc * 512) {
                    const int e = i * 8; const float gsc = gq[e >> 10];
                    const f32x4 a = *(const f32x4*)(w + e) * gsc, b = *(const f32x4*)(w + e + 4) * gsc;
                    float v[8] = {a[0], a[1], a[2], a[3], b[0], b[1], b[2], b[3]};
                    *(u32x4*)(o + e) = pack8(v);
                }
            }
            {
                const float* w = IN(6); bf16_t* o = (bf16_t*)(ws + WS_WSP);
                for (int i = ci * 512 + tid; i < 8 * 128 * 128 / 8; i += nc * 512) {
                    const int e = i * 8, s0 = e & 127, t = (e >> 7) & 127;
                    const f32x4 a = *(const f32x4*)(w + e), b = *(const f32x4*)(w + e + 4);
                    float v[8] = {a[0], a[1], a[2], a[3], b[0], b[1], b[2], b[3]};
#pragma unroll
                    for (int j = 0; j < 8; ++j) if (s0 + j > t) v[j] = 0.f;
                    *(u32x4*)(o + e) = pack8(v);
                }
            }
            }
            if (do_m) {
                int m = gwm;
                for (; m + 3 * NGWM < M_TOK; m += 4 * NGWM) rms_rows_to_bf16<4>(IN(0) + (size_t)m * DM, (size_t)NGWM * DM, IN(2), (bf16_t*)(ws + WS_SA) + (size_t)m * DM, (size_t)NGWM * DM, lane);
                for (; m < M_TOK; m += NGWM) rms_rows_to_bf16<1>(IN(0) + (size_t)m * DM, 0, IN(2), (bf16_t*)(ws + WS_SA) + (size_t)m * DM, 0, lane);
                for (m = gwm; m < NMEM; m += NGWM) rms_rows_to_bf16<1>(IN(1) + (size_t)m * DM, 0, IN(22), (bf16_t*)(ws + WS_MEMN) + (size_t)m * 1152, 0, lane);
            }
        } else if (ph == 1 || ph == 2) { is_gemm = true;
        } else if (ph == 3) { is_gemm = true;
        } else if (ph == 4 || ph == 5 || ph == 6 || ph == 7) { is_gemm = true;
        } else if (ph == 8) {
            if (panel_mode) rowpass<false, true>((const bf16_t*)(ws + WS_SA), IN(20), IN(0), ws + WS_X1B, nullptr, nullptr, (float*)(ws + WS_RS1), panel * 256 + wave, 8, lane, panel * 256 + 256);
            else rowpass<false, true>((const bf16_t*)(ws + WS_SA), IN(20), IN(0), ws + WS_X1B, nullptr, nullptr, (float*)(ws + WS_RS1), gw, NGW, lane, M_TOK);
        } else if (ph == 9 || ph == 10) { is_gemm = true;
        } else if (ph == 13) {
            if (panel_mode) rowpass<true, true>((const bf16_t*)(ws + WS_SD), IN(26), ws + WS_X1B, ws + WS_X2B, nullptr, nullptr, (float*)(ws + WS_RS2), panel * 256 + wave, 8, lane, panel * 256 + 256);
            else rowpass<true, true>((const bf16_t*)(ws + WS_SD), IN(26), ws + WS_X1B, ws + WS_X2B, nullptr, nullptr, (float*)(ws + WS_RS2), gw, NGW, lane, M_TOK);
        } else if (ph == 14 || ph == 15) { is_gemm = true;
        } else if (ph == 16) {
            if (panel_mode) rowpass<true, false>((const bf16_t*)(ws + WS_SC), IN(30), ws + WS_X2B, args.out, nullptr, nullptr, nullptr, panel * 256 + wave, 8, lane, panel * 256 + 256);
            else rowpass<true, false>((const bf16_t*)(ws + WS_SC), IN(30), ws + WS_X2B, args.out, nullptr, nullptr, nullptr, gw, NGW, lane, M_TOK);
        }
        if (is_gemm) {
            pg8::Sched S; S.ws = ws; S.ph = ph; S.G = G; S.c = bx; S.panel = (panel_mode && ph >= 6 && !FFN_GRID(ph)) ? panel : -1;
            const bool scan_wg = (ph == 3) && (G > 128) && (vcu < 64);
            if (ph == 3 && G > 128) { S.G = G - 64; S.c = vcu - 64; }
            S.n0 = pg8::phase_units(ph, 0); S.n1 = (ph == 2 || ph == 3) ? pg8::phase_units(ph, 1) : 0; S.total = S.n0 + S.n1;
            if (S.panel >= 0) S.total = (ph == 14) ? 2 * FF / 256 : 4;
            if (ph == 1) { for (int u = vcu; u < 256; u += G) s5_expand(lds, ws, u >> 3, u & 7, tid); }
            const bool sp_first = (ph == 2) && ((vcu >> 0) & 1);
            if (sp_first) spatial_phase(lds, ws, IN(4), IN(5), IN(7), vcu, G, tid);
            if (!scan_wg) pg8::gemm_phase(lds, S, E, tid);
            if (ph == 2 && !sp_first) spatial_phase(lds, ws, IN(4), IN(5), IN(7), vcu, G, tid);
            if (ph == 3) {
            const int gt = vcu * 512 + tid;
                if (gt < 16 * 32 * 64) {
                    const int p = gt & 63, g = (gt >> 6) & 31, b = gt >> 11;
                    const f32x2 a = ((const f32x2*)(ws + WS_A64))[g * 64 + p];
                    const float* Eb = (const float*)(ws + WS_EBUF); bf16_t* UC = (bf16_t*)(ws + WS_UC);
                    float cr = 0.f, ci = 0.f;
    #pragma unroll 8
                    for (int k = 0; k < 64; ++k) {
                        const size_t row = (size_t)g * 1024 + b * 64 + k;
                        const f32x2 e = *(const f32x2*)(Eb + row * 128 + 2 * p);
                        *(unsigned*)(UC + row * 1152 + 1024 + 2 * p) = cvt_pk_bf16(cr, ci);
                        const float nr = a.x * cr - a.y * ci + e.x, ni = a.x * ci + a.y * cr + e.y; cr = nr; ci = ni;
                    }
                }

            }
        }
        if (pi + 1 < args.ph_hi) {
            if (panel_mode && ph >= 6 && ph != 16 && !FFN_GRID(ph) && !FFN_GRID(ph + 1)) {
                asm volatile("s_waitcnt vmcnt(0) lgkmcnt(0)" ::: "memory");
                __syncthreads();
                __builtin_amdgcn_fence(__ATOMIC_ACQUIRE, "agent");
                asm volatile("s_waitcnt vmcnt(0)" ::: "memory");
                __syncthreads();
            } else if (args.ph_hi > 4096) cg::this_grid().sync();
            else { XcdBarrier xb; xb.bar = (unsigned*)ws; xb.x = xb_xcc_id(); xb.st = xst; xcd_barrier(xb, tid); }
        }
    }
}

extern "C" void kernel_launch(void* const* d_in, const int* in_sizes, int n_in, void* d_out, int out_size, void* d_ws, size_t ws_size, hipStream_t stream) {
    static int grid = 0;
    if (grid == 0) {
        if (n_in != 31 || in_sizes[0] != M_TOK * DM || out_size != M_TOK * DM || ws_size < WS_END) { fprintf(stderr, "kernel_launch: unexpected problem (n_in %d, ws %zu)\n", n_in, ws_size); grid = -1; return; }
        int dev = 0, cus = 0, per_cu = 0;
        hipGetDevice(&dev); hipDeviceGetAttribute(&cus, hipDeviceAttributeMultiprocessorCount, dev);
        hipFuncSetAttribute((const void*)mk_fwd, hipFuncAttributeMaxDynamicSharedMemorySize, LDS_BYTES);
        hipOccupancyMaxActiveBlocksPerMultiprocessor(&per_cu, (const void*)mk_fwd, 512, LDS_BYTES);
        if (per_cu < 1) { fprintf(stderr, "kernel_launch: occupancy query says %d blocks per CU\n", per_cu); per_cu = 1; }
        (void)hipGetLastError();
        grid = cus;
    }
    if (grid < 0) return;
    Args a{};
    for (int i = 0; i < 31; ++i) a.in[i] = (const float*)d_in[i];
    a.out = (float*)d_out; a.ws = (unsigned char*)d_ws;
#if MK_ONE_LAUNCH
    (void)hipMemsetAsync(d_ws, 0, 65536, stream);
    a.ph_lo = 0; a.ph_hi = NPHASE;
    void* kargs[] = {&a};
    hipError_t e = hipLaunchCooperativeKernel((const void*)mk_fwd, dim3(grid), dim3(512), kargs, LDS_BYTES, stream);
    if (e != hipSuccess) fprintf(stderr, "cooperative launch failed: %s (grid %d)\n", hipGetErrorString(e), grid);

#else
    for (int ph = 0; ph < NPHASE; ++ph) {
        a.ph_lo = ph; a.ph_hi = ph + 1;
        hipLaunchKernelGGL(mk_fwd, dim3(grid), dim3(512), LDS_BYTES, stream, a);
    }
#endif
}
```

```cpp
#include <hip/hip_runtime.h>
#include <hip/hip_cooperative_groups.h>
#include <cstdint>
#include <cstdio>
namespace cg = cooperative_groups;

#define FFN_GRID(p) ((p) == 6 || (p) == 7 || (p) == 9 || (p) == 10 || (p) == 14 || (p) == 15)
#ifndef MK_ONE_LAUNCH
#define MK_ONE_LAUNCH 1
#endif

#define LAS __attribute__((address_space(3)))
typedef unsigned short bf16_t;
typedef short bf16x8 __attribute__((ext_vector_type(8)));
typedef float f32x4 __attribute__((ext_vector_type(4)));
typedef float f32x2 __attribute__((ext_vector_type(2)));
typedef unsigned u32x4 __attribute__((ext_vector_type(4)));
typedef unsigned u32x2 __attribute__((ext_vector_type(2)));

constexpr int M_TOK = 65536, DM = 1024, NIN = 4608, FF = 2816, NMEM = 4096, SEQ = 4096;
constexpr float EPS = 1e-6f;
constexpr int NPHASE = 17;
constexpr size_t MiB = 1u << 20;
constexpr size_t WS_WIN = 1 * MiB, WS_WBR = 10 * MiB, WS_WMIX = 13 * MiB, WS_WGLU = 15 * MiB, WS_WQ = 16 * MiB, WS_WKV = 18 * MiB  , WS_WO = 23 * MiB,
                 WS_WGU = 25 * MiB, WS_WDN = 36 * MiB, WS_WSP = 42 * MiB, WS_A64 = 42 * MiB + 256 * 1024, WS_RS1 = 42 * MiB + 320 * 1024  , WS_RS2 = 42 * MiB + 576 * 1024  , WS_KB = 43 * MiB, WS_VB = 51 * MiB  ;
constexpr size_t WS_SA = 59 * MiB, WS_SB = 187 * MiB, WS_SC = 315 * MiB, WS_SD = 443 * MiB;
constexpr size_t WS_ACT = 571 * MiB;
constexpr size_t WS_BT1 = 571 * MiB  , WS_BT2 = 581 * MiB, WS_EBUF = 653 * MiB, WS_MEMN = 669 * MiB  , WS_UC = 678 * MiB,
                 WS_U = 750 * MiB  , WS_V = 878 * MiB, WS_S5T = 1006 * MiB  , WS_END = 1010 * MiB;
constexpr size_t WS_X1B = WS_SB, WS_X2B = WS_SA;
constexpr size_t WS_VST = WS_SB;
constexpr size_t WS_MB = 942 * MiB, WS_NB = 974 * MiB;
constexpr int KTS = 257;
constexpr int S5T_BYTES = 49664 + 64 * KTS * 4;
constexpr int LDS_RING = 131072, LDS_XS = 131072, LDS_BYTES = 147456;

typedef __bf16 bf16v2 __attribute__((ext_vector_type(2)));
__device__ __forceinline__ unsigned cvt_pk_bf16(float lo, float hi) { const f32x2 f = {lo, hi}; const bf16v2 v = __builtin_convertvector(f, bf16v2); return __builtin_bit_cast(unsigned, v); }
__device__ __forceinline__ float bf_lo(unsigned w) { return __uint_as_float(w << 16); }
__device__ __forceinline__ float bf_hi(unsigned w) { return __uint_as_float(w & 0xffff0000u); }
__device__ __forceinline__ float fsigmoid(float x) { return __builtin_amdgcn_rcpf(1.f + __builtin_amdgcn_exp2f(-1.4426950408889634f * x)); }
__device__ __forceinline__ float gelu_t(float x) { const float y = 1.5957691216057308f * (x + 0.044715f * x * x * x); return x * fsigmoid(y); }
__device__ __forceinline__ float shx(float v, int lane, int o) { return __int_as_float(__builtin_amdgcn_ds_bpermute((lane ^ o) << 2, __float_as_int(v))); }
__device__ __forceinline__ float wave_sum(float v, int lane) {
#pragma unroll
    for (int o = 1; o < 64; o <<= 1) v += shx(v, lane, o);
    return v;
}
__device__ __forceinline__ void unpack8(const u32x4 w, float (&v)[8]) {
    v[0] = bf_lo(w.x); v[1] = bf_hi(w.x); v[2] = bf_lo(w.y); v[3] = bf_hi(w.y); v[4] = bf_lo(w.z); v[5] = bf_hi(w.z); v[6] = bf_lo(w.w); v[7] = bf_hi(w.w);
}
__device__ __forceinline__ u32x4 pack8(const float (&v)[8]) {
    u32x4 w; w.x = cvt_pk_bf16(v[0], v[1]); w.y = cvt_pk_bf16(v[2], v[3]); w.z = cvt_pk_bf16(v[4], v[5]); w.w = cvt_pk_bf16(v[6], v[7]); return w;
}

namespace pg8 {
constexpr int BM = 256, BK = 64, HALF = 128, HTB = HALF * BK * 2, NXCD = 8, WGM = 4;
static_assert(WGM == 4, "the phase-4 unit mirroring assumes groups of 4 row tiles x 4 column tiles");
__host__ __device__ __forceinline__ int lds_byte(int r, int c) { const int st = (r >> 4) * 2 + (c >> 5), rr = r & 15, cc = c & 31, ob = rr * 64 + cc * 2; return st * 1024 + (ob ^ (((ob >> 9) & 1) << 5)); }
__host__ __device__ __forceinline__ void stage_rc(int b, int& R, int& C) { const int st = b / 1024, sb = b % 1024, swz = sb ^ (((sb >> 9) & 1) << 5); R = (st >> 1) * 16 + swz / 64; C = (st & 1) * 32 + (swz % 64) / 2; }
__host__ __device__ __forceinline__ int perm32(int rho) { const int n = rho >> 4, i = rho & 15; return 8 * (i >> 2) + 4 * n + (i & 3); }

enum Kind { K_IN = 0, K_KVPROJ, K_MB, K_NB, K_S5E, K_S5Y, K_GLU, K_BR, K_MIX, K_SMAX, K_OPROJ, K_GU, K_DOWN };

struct Unit { const char* A; const char* B; int lda, cha, ldb, nt, pn, kind, orow, ocol; };
struct Desc {
    const char* A; const char* B; int lda, cha, ldb, nt, nM, nN, nZ0; long zsA0, zsA1, zsB0, zsB1; int kind, orz0, orz1, ocz0;
    __device__ __forceinline__ void fill(int w, Unit& u) const {
        const int per = nM * nN, z = w / per, r = w % per;
        const int nig = WGM * nN, gid = r / nig, fm = gid * WGM, gsz = (nM - fm) < WGM ? (nM - fm) : WGM;
        const int pm = fm + ((r % nig) % gsz), pn = (r % nig) / gsz;
        const int z0 = z % nZ0, z1 = z / nZ0;
        fill_pz(pm, pn, z0, z1, u);
    }
    __device__ __forceinline__ void fill_pz(int pm, int pn, int z0, int z1, Unit& u) const {
        u.pn = pn;
        u.A = A + z0 * zsA0 + z1 * zsA1 + (long)pm * BM * lda * 2;
        u.B = B + z0 * zsB0 + z1 * zsB1 + (long)pn * BM * ldb * 2;
        u.lda = lda; u.cha = cha; u.ldb = ldb; u.nt = (kind == K_S5Y) ? 2 + 4 * (pn + 1) : nt; u.kind = kind;
        u.orow = pm * BM + z0 * orz0 + z1 * orz1; u.ocol = pn * BM + z0 * ocz0;
    }
};
__device__ __forceinline__ Desc mk_desc(const void* A, const void* B, int lda, int ldb, int K, int Mrows, int Ncols, int kind) {
    Desc d; d.A = (const char*)A; d.B = (const char*)B; d.lda = lda; d.cha = 16; d.ldb = ldb; d.nt = K / BK; d.nM = Mrows / BM; d.nN = Ncols / BM; d.nZ0 = 1;
    d.zsA0 = d.zsA1 = d.zsB0 = d.zsB1 = 0; d.kind = kind; d.orz0 = d.orz1 = d.ocz0 = 0; return d;
}
__device__ __forceinline__ Desc phase_desc(int ph, int sub, unsigned char* ws) {
    Desc d;
    if (ph == 1) { d = mk_desc(ws + WS_SA, ws + WS_WIN, 1024, 1024, 1024, M_TOK, NIN, K_IN);
    } else if (ph == 2) {
        if (sub == 0) { d = mk_desc(ws + WS_UC + 128 * 2, ws + WS_BT1, 1152, 1152, 1024, 1024, 256, K_S5E); d.nZ0 = 32; d.zsA0 = 1024L * 1152 * 2; d.zsB0 = 128L * 1152 * 2; d.orz0 = 1024; }
        else d = mk_desc(ws + WS_MEMN, ws + WS_WKV, 1152, 1152, 1024, NMEM, 2048, K_KVPROJ);
    } else if (ph == 3) {
        if (sub == 0) { d = mk_desc(ws + WS_KB, ws + WS_WQ, 1024, 1024, 256, 256, 1024, K_MB); d.nZ0 = 4; d.zsA0 = 256 * 2; d.zsA1 = 256L * 1024 * 2; d.zsB0 = 256 * 2; d.orz0 = 256; d.orz1 = 1024; }
        else { d = mk_desc(ws + WS_WO, ws + WS_VB, 1024, 1024, 256, 1024, 256, K_NB); d.nZ0 = 4; d.zsA0 = 256 * 2; d.zsB0 = 256 * 2; d.zsB1 = 256L * 1024 * 2; d.orz1 = 1024; d.ocz0 = 256; }
    } else if (ph == 4) { d = mk_desc(ws + WS_UC, ws + WS_BT2, 1152, 1152, 1152, 1024, 1024, K_S5Y); d.nZ0 = 32; d.zsA0 = 1024L * 1152 * 2; d.zsB0 = 1024L * 1152 * 2; d.orz0 = 1024;
    } else if (ph == 5) { d = mk_desc(ws + WS_U, ws + WS_WGLU, 16, 512, 512, M_TOK, 512, K_GLU); d.cha = M_TOK * 16;
    } else if (ph == 6) { d = mk_desc(ws + WS_SA, ws + WS_WBR, 1024, 1536, 1536, M_TOK, 1024, K_BR);
    } else if (ph == 7) { d = mk_desc(ws + WS_SC, ws + WS_WMIX, 1024, 1024, 1024, M_TOK, 1024, K_MIX);
    } else if (ph == 9) {
        d = mk_desc(ws + WS_SB, ws + WS_MB, 1024, 1024, 1024, SEQ, 1024, K_SMAX); d.zsA1 = (long)SEQ * 1024 * 2; d.zsB1 = 1024L * 1024 * 2; d.orz1 = SEQ;
    } else if (ph == 10) {
        d = mk_desc(ws + WS_SC, ws + WS_NB, 1024, 1024, 1024, SEQ, 1024, K_OPROJ); d.zsA1 = (long)SEQ * 1024 * 2; d.zsB1 = 1024L * 1024 * 2; d.orz1 = SEQ;
    } else if (ph == 14) { d = mk_desc(ws + WS_SA, ws + WS_WGU, 1024, 1024, 1024, M_TOK, 2 * FF, K_GU);
    } else { d = mk_desc(ws + WS_ACT, ws + WS_WDN, FF, FF, FF, M_TOK, 1024, K_DOWN); }
    return d;
}
__device__ __forceinline__ int phase_units(int ph, int sub) {
    switch (ph) {
        case 1: return (M_TOK / BM) * (NIN / BM);
        case 2: return sub == 0 ? 32 * 4 : (sub == 1 ? 128 : 0);
        case 3: return sub < 2 ? 256 : 0;
        case 4: return 32 * 16;
        case 5: return (M_TOK / BM) * 2;
        case 14: return (M_TOK / BM) * (2 * FF / BM);
        default: return (M_TOK / BM) * 4;
    }
}
struct Sched {
    unsigned char* ws; int ph, n0, n1, total, G, c, panel;
    __device__ __forceinline__ bool next(int i, Unit& u) const {
        if (panel >= 0) {
            if (i >= total) return false;
            const Desc d = phase_desc(ph, 0, ws);
            if (ph == 9 || ph == 10) d.fill_pz(panel & 15, i, 0, panel >> 4, u); else d.fill_pz(panel, i, 0, 0, u);
            return true;
        }
        const long L = (long)i * G + c; if (L >= total) return false;
        int wgid = (int)L; { const int q = total / NXCD, r = total % NXCD, xcd = wgid % NXCD, off = wgid / NXCD; wgid = (xcd < r ? xcd * (q + 1) : r * (q + 1) + (xcd - r) * q) + off; }
        int sub = 0; if (wgid >= n0) { sub = 1; wgid -= n0; if (wgid >= n1) { sub = 2; wgid -= n1; } }
        if (ph == 4 && (i & 1)) { const int r = wgid & 15; wgid += ((r & 3) + 4 * (3 - (r >> 2))) - r; }
        const Desc d = phase_desc(ph, sub, ws); d.fill(wgid, u);
        return true;
    }
};
struct Drv { unsigned vA0, vA1, vB0, vB1, kA, hA, hB; };
__device__ __forceinline__ Drv derive(const Unit& u, int tid) {
    int R0, C0, R1, C1; stage_rc(tid * 16, R0, C0); stage_rc(tid * 16 + 8192, R1, C1);
    const int Rb0 = (R0 & ~31) + perm32(R0 & 31), Rb1 = (R1 & ~31) + perm32(R1 & 31);
    Drv d;
    d.vA0 = (unsigned)(R0 * u.lda + (C0 >> 4) * u.cha + (C0 & 15)) * 2u; d.vA1 = (unsigned)(R1 * u.lda + (C1 >> 4) * u.cha + (C1 & 15)) * 2u;
    d.vB0 = (unsigned)(Rb0 * u.ldb + C0) * 2u; d.vB1 = (unsigned)(Rb1 * u.ldb + C1) * 2u;
    d.kA = (unsigned)(8 * u.cha); d.hA = (unsigned)(HALF * 2 * u.lda); d.hB = (unsigned)(HALF * 2 * u.ldb);
    return d;
}

struct Epi {
    unsigned char* ws; LAS unsigned char* lds;
    __device__ __forceinline__ void get8(const f32x4 (&acc)[2][2][4][2], int ai, int bj, int m, float (&v)[8]) const {
        const f32x4 a = acc[ai][bj][m][0], b = acc[ai][bj][m][1];
        v[0] = a[0]; v[1] = a[1]; v[2] = a[2]; v[3] = a[3]; v[4] = b[0]; v[5] = b[1]; v[6] = b[2]; v[7] = b[3];
    }
    __device__ __forceinline__ void mid(f32x4 (&acc)[2][2][4][2], const Unit& u, int wr, int wc, int fr, int fq) const {
        const bf16_t* GA = (const bf16_t*)(ws + WS_SC); const bf16_t* GB = (const bf16_t*)(ws + WS_SD);
        int rb = u.orow + wr * 64 + fr; asm volatile("" : "+v"(rb));
        int cb = u.ocol + wc * 32 + 8 * fq; asm volatile("" : "+v"(cb));
#pragma unroll
        for (int ai = 0; ai < 2; ++ai) {
            u32x4 ga[4][2], gb[4][2];
#pragma unroll
            for (int m = 0; m < 4; ++m)
#pragma unroll
                for (int bj = 0; bj < 2; ++bj) { const size_t o = (size_t)(rb + ai * HALF + m * 16) * DM + cb + bj * HALF; ga[m][bj] = *(const u32x4*)(GA + o); gb[m][bj] = *(const u32x4*)(GB + o); }
#pragma unroll
            for (int m = 0; m < 4; ++m)
#pragma unroll
                for (int bj = 0; bj < 2; ++bj) {
                    float a[8], b[8]; unpack8(ga[m][bj], a); unpack8(gb[m][bj], b);
#pragma unroll
                    for (int j = 0; j < 8; ++j) { const float r = a[j] * __builtin_amdgcn_rcpf(fmaxf(b[j], 1e-30f)); asm volatile("v_mul_f32 %0, %0, %1" : "+v"(acc[ai][bj][m][j >> 2][j & 3]) : "v"(r)); }
                }
            asm volatile("" ::: "memory");
        }
    }
    __device__ __forceinline__ void operator()(const f32x4 (&acc)[2][2][4][2], const Unit& u, int wr, int wc, int fr, int fq) const {
        const int kind = u.kind;
        if (kind == K_SMAX) {
            LAS f32x2* XS = (LAS f32x2*)(lds + LDS_XS);
            int rls = wr * 64 + fr; asm volatile("" : "+v"(rls));
            bf16_t* P = (bf16_t*)(ws + WS_SC); const float* RS = (const float*)(ws + WS_RS1);
            int rbs = u.orow + wr * 64 + fr; asm volatile("" : "+v"(rbs));
            float rsv[2][4];
#pragma unroll
            for (int ai = 0; ai < 2; ++ai)
#pragma unroll
                for (int m = 0; m < 4; ++m) rsv[ai][m] = RS[rbs + ai * HALF + m * 16] * 1.4426950408889634f;
#pragma unroll
            for (int ai = 0; ai < 2; ++ai)
#pragma unroll
                for (int m = 0; m < 4; ++m) {
                    const float rs = rsv[ai][m];
                    float mx = -3.0e38f;
#pragma unroll
                    for (int bj = 0; bj < 2; ++bj)
#pragma unroll
                        for (int n = 0; n < 2; ++n)
#pragma unroll
                            for (int j = 0; j < 4; ++j) mx = fmaxf(mx, acc[ai][bj][m][n][j]);
                    mx = fmaxf(mx, shx(mx, fr + 16 * fq, 16)); mx = fmaxf(mx, shx(mx, fr + 16 * fq, 32));
                    float s = 0.f;
#pragma unroll
                    for (int bj = 0; bj < 2; ++bj)
#pragma unroll
                        for (int n = 0; n < 2; ++n)
#pragma unroll
                            for (int j = 0; j < 4; ++j) s += __builtin_amdgcn_exp2f((acc[ai][bj][m][n][j] - mx) * rs);
                    s += shx(s, fr + 16 * fq, 16); s += shx(s, fr + 16 * fq, 32);
                    if (fq == 0) XS[(rls + ai * HALF + m * 16) * 4 + wc] = (f32x2){mx * rs, s};
                }
            asm volatile("s_waitcnt lgkmcnt(0)" ::: "memory"); __builtin_amdgcn_s_barrier(); asm volatile("" ::: "memory");
#pragma unroll
            for (int ai = 0; ai < 2; ++ai)
#pragma unroll
                for (int m = 0; m < 4; ++m) {
                    const int rl = rls + ai * HALF + m * 16;
                    const f32x2 p0 = XS[rl * 4 + 0], p1 = XS[rl * 4 + 1], p2 = XS[rl * 4 + 2], p3 = XS[rl * 4 + 3];
                    const f32x2 me = XS[rl * 4 + wc];
                    const float MX = fmaxf(fmaxf(p0.x, p1.x), fmaxf(p2.x, p3.x));
                    const float L = p0.y * __builtin_amdgcn_exp2f(p0.x - MX) + p1.y * __builtin_amdgcn_exp2f(p1.x - MX) + p2.y * __builtin_amdgcn_exp2f(p2.x - MX) + p3.y * __builtin_amdgcn_exp2f(p3.x - MX);
                    const float f = 1.0f / L; (void)me;
                    const size_t row = (size_t)(u.orow + rl);
                    const float rs = rsv[ai][m];
#pragma unroll
                    for (int bj = 0; bj < 2; ++bj) {
                        float v[8]; get8(acc, ai, bj, m, v);
#pragma unroll
                        for (int j = 0; j < 8; ++j) v[j] = __builtin_amdgcn_exp2f(v[j] * rs - MX) * f;
                        *(u32x4*)(P + row * DM + u.ocol + bj * HALF + wc * 32 + 8 * fq) = pack8(v);
                    }
                }
            asm volatile("s_waitcnt lgkmcnt(0)" ::: "memory"); __builtin_amdgcn_s_barrier(); asm volatile("" ::: "memory");
            return;
        }
        if (kind == K_GU) {
            bf16_t* ACT = (bf16_t*)(ws + WS_ACT);
            int rb = u.orow + wr * 64 + fr; asm volatile("" : "+v"(rb));
            float rsv[2][4];
#pragma unroll
            for (int ai = 0; ai < 2; ++ai)
#pragma unroll
                for (int m = 0; m < 4; ++m) rsv[ai][m] = ((const float*)(ws + WS_RS2))[rb + ai * HALF + m * 16];
#pragma unroll
            for (int ai = 0; ai < 2; ++ai)
#pragma unroll
                for (int m = 0; m < 4; ++m) {
                    const size_t row = (size_t)(rb + ai * HALF + m * 16);
                    const float rs = rsv[ai][m];
                    float g[8], w[8]; get8(acc, ai, 0, m, g); get8(acc, ai, 1, m, w);
#pragma unroll
                    for (int j = 0; j < 8; ++j) { const float gg = g[j] * rs; g[j] = gg * fsigmoid(gg) * (w[j] * rs); }
                    *(u32x4*)(ACT + row * FF + u.pn * HALF + wc * 32 + 8 * fq) = pack8(g);
                }
            return;
        }
        if (kind == K_S5E) {
            float* E = (float*)(ws + WS_EBUF);
            int rb = u.orow + wr * 64 + fr; asm volatile("" : "+v"(rb));
            int cb = wc * 32 + 8 * fq; asm volatile("" : "+v"(cb));
#pragma unroll
            for (int ai = 0; ai < 2; ++ai)
#pragma unroll
                for (int m = 0; m < 4; ++m) {
                    const size_t row = (size_t)(rb + ai * HALF + m * 16);
                    float* p = E + row * 128 + cb;
                    *(f32x4*)p = acc[ai][0][m][0]; *(f32x4*)(p + 4) = acc[ai][0][m][1];
                }
            return;
        }
        if (kind == K_IN) {
            const int pn = u.pn;
            if (pn < 4) tiles<1>(acc, u.orow, wr, wc, fr, fq, (bf16_t*)(ws + WS_U), DM, pn * BM, nullptr);
            else if (pn < 8) tiles<7>(acc, u.orow, wr, wc, fr, fq, (bf16_t*)(ws + WS_V), DM, (pn & 3) * BM, (const bf16_t*)(ws + WS_VST));
            else if (pn < 10) tiles<3>(acc, u.orow, wr, wc, fr, fq, (bf16_t*)(ws + WS_UC), 0, (pn - 8) * BM, nullptr);
            else tiles<2>(acc, u.orow, wr, wc, fr, fq, (bf16_t*)(ws + (pn < 14 ? WS_SC : WS_SD)), DM, ((pn - 10) & 3) * BM, nullptr);
        } else if (kind == K_KVPROJ) tiles<0>(acc, u.orow, wr, wc, fr, fq, (bf16_t*)(ws + (u.pn < 4 ? WS_KB : WS_VB)), DM, (u.pn & 3) * BM, nullptr);
        else if (kind == K_MB) tiles<6>(acc, u.orow, wr, wc, fr, fq, (bf16_t*)(ws + WS_MB), DM, u.ocol, nullptr);
        else if (kind == K_NB) tiles<0>(acc, u.orow, wr, wc, fr, fq, (bf16_t*)(ws + WS_NB), DM, u.ocol, nullptr);
        else if (kind == K_S5Y) tiles<1>(acc, u.orow, wr, wc, fr, fq, (bf16_t*)(ws + WS_U), 1024, u.ocol, nullptr);
        else if (kind == K_GLU) tiles<4>(acc, u.orow, wr, wc, fr, fq, (bf16_t*)(ws + WS_SB), DM, u.ocol, (const bf16_t*)(ws + WS_U));
        else if (kind == K_BR) tiles<5>(acc, u.orow, wr, wc, fr, fq, (bf16_t*)(ws + WS_SC), DM, u.ocol, (const bf16_t*)(ws + WS_SD));
        else if (kind == K_MIX) tiles<0>(acc, u.orow, wr, wc, fr, fq, (bf16_t*)(ws + WS_SA), DM, u.ocol, nullptr);
        else if (kind == K_OPROJ) tiles<0>(acc, u.orow, wr, wc, fr, fq, (bf16_t*)(ws + WS_SD), DM, u.ocol, nullptr);
        else tiles<0>(acc, u.orow, wr, wc, fr, fq, (bf16_t*)(ws + WS_SC), DM, u.ocol, nullptr);
    }
    template <int MODE>
    __device__ __forceinline__ void tiles(const f32x4 (&acc)[2][2][4][2], int orow, int wr, int wc, int fr, int fq, bf16_t* base, int ld, int colbase, const bf16_t* aux) const {
        int rb = orow + wr * 64 + fr; asm volatile("" : "+v"(rb));
        int cb = colbase + wc * 32 + 8 * fq; asm volatile("" : "+v"(cb));
#pragma unroll
        for (int ai = 0; ai < 2; ++ai) {
            u32x4 ax[4][2];
            if (MODE == 4 || MODE == 5) {
#pragma unroll
                for (int m = 0; m < 4; ++m)
#pragma unroll
                    for (int bj = 0; bj < 2; ++bj) {
                        const size_t row = (size_t)(rb + ai * HALF + m * 16); const int col = cb + bj * HALF;
                        if (MODE == 4) ax[m][bj] = *(const u32x4*)(aux + ((size_t)(col >> 4) * M_TOK + row) * 16 + (col & 15));
                        else ax[m][bj] = *(const u32x4*)(aux + row * DM + col);
                    }
            }
#pragma unroll
            for (int m = 0; m < 4; ++m) {
                const int rowi = rb + ai * HALF + m * 16; const size_t row = (size_t)rowi;
                float st1 = 0.f, st2 = 0.f;
#pragma unroll
                for (int bj = 0; bj < 2; ++bj) {
                    const int col = cb + bj * HALF;
                    float v[8]; get8(acc, ai, bj, m, v);
                    bf16_t* dst = base + row * ld + col;
                    if (MODE == 1 || MODE == 7) {
#pragma unroll
                        for (int j = 0; j < 8; ++j) v[j] = gelu_t(v[j]);
                        if (MODE == 7) {
#pragma unroll
                            for (int j = 0; j < 8; ++j) { st1 += v[j]; st2 += v[j] * v[j]; }
                        }
                    } else if (MODE == 2) {
#pragma unroll
                        for (int j = 0; j < 8; ++j) v[j] = fsigmoid(v[j]);
                    } else if (MODE == 3) {
                        const int g = col >> 4, h0 = col & 15;
                        dst = base + ((size_t)(g * 1024 + (rowi >> 6))) * 1152 + 128 + (rowi & 63) * 16 + h0;
                    } else if (MODE == 4) {
                        float y[8]; unpack8(ax[m][bj], y);
#pragma unroll
                        for (int j = 0; j < 8; ++j) v[j] = y[j] * fsigmoid(v[j]);
                    } else if (MODE == 5) {
                        float b[8]; unpack8(ax[m][bj], b);
#pragma unroll
                        for (int j = 0; j < 8; ++j) v[j] *= b[j];
                    } else if (MODE == 6) {
#pragma unroll
                        for (int j = 0; j < 8; ++j) v[j] *= 0.0625f;
                    }
                    *(u32x4*)dst = pack8(v);
                }
                if (MODE == 7) {
                    st1 += shx(st1, fr + 16 * fq, 16); st1 += shx(st1, fr + 16 * fq, 32); st2 += shx(st2, fr + 16 * fq, 16); st2 += shx(st2, fr + 16 * fq, 32);
                    if (fq == 0) ((f32x2*)aux)[row * 16 + (colbase >> 8) * 4 + wc] = (f32x2){st1, st2};
                }
                if (MODE != 4 && MODE != 5) asm volatile("" ::: "memory");
            }
            asm volatile("" ::: "memory");
        }
    }
};

__device__ __forceinline__ void gemm_phase(LAS unsigned char* lds, const Sched& S, const Epi& E, const int tid) {
    const int wid = __builtin_amdgcn_readfirstlane(tid >> 6), lane = tid & 63, wr = wid >> 2, wc = wid & 3, fr = lane & 15, fq = lane >> 4;
    const unsigned ldsw = (unsigned)wid * 1024u;
    const int aoff = lds_byte(wr * 64 + fr, fq * 8), boff = lds_byte(wc * 32 + fr, fq * 8);
#define PG8_SA(b, h) (((b) * 2 + (h)) * HTB)
#define PG8_SB(b, h) ((4 + (b) * 2 + (h)) * HTB)
#define PG8_STAGE(bufoff, gbase, v0, v1) do { \
        __builtin_amdgcn_global_load_lds((const unsigned*)((const char*)(gbase) + (v0)), (LAS unsigned*)(lds + (bufoff) + ldsw), 16, 0, 0); \
        __builtin_amdgcn_global_load_lds((const unsigned*)((const char*)(gbase) + (v1)), (LAS unsigned*)(lds + (bufoff) + ldsw + 8192), 16, 0, 0); } while (0)
#define PG8_LDA(dst, b, h) do { _Pragma("unroll") for (int m = 0; m < 4; ++m) _Pragma("unroll") for (int k = 0; k < 2; ++k) dst[m][k] = *(const LAS bf16x8*)(lds + PG8_SA(b, h) + aoff + m * 2048 + k * 1024); } while (0)
#define PG8_LDB(dst, b, h) do { _Pragma("unroll") for (int n = 0; n < 2; ++n) _Pragma("unroll") for (int k = 0; k < 2; ++k) dst[n][k] = *(const LAS bf16x8*)(lds + PG8_SB(b, h) + boff + n * 2048 + k * 1024); } while (0)
#define PG8_MMA(ai, bj, At, Bt) do { __builtin_amdgcn_s_setprio(1); _Pragma("unroll") for (int m = 0; m < 4; ++m) _Pragma("unroll") for (int n = 0; n < 2; ++n) _Pragma("unroll") for (int k = 0; k < 2; ++k) \
        acc[ai][bj][m][n] = __builtin_amdgcn_mfma_f32_16x16x32_bf16(Bt[n][k], At[m][k], acc[ai][bj][m][n], 0, 0, 0); __builtin_amdgcn_s_setprio(0); } while (0)
#define PG8_WAIT_V(n) asm volatile("s_waitcnt vmcnt(" #n ")" ::: "memory")
#define PG8_WAIT_L(n) asm volatile("s_waitcnt lgkmcnt(" #n ")" ::: "memory")
#define PG8_BAR __builtin_amdgcn_s_barrier()
#define PG8_SCHED __builtin_amdgcn_sched_barrier(0)
    Unit cur, nxt; int ui = 0;
    if (!S.next(0, cur)) return;
    nxt = cur;
    f32x4 acc[2][2][4][2];
#pragma unroll
    for (int a = 0; a < 2; ++a)
#pragma unroll
        for (int b = 0; b < 2; ++b)
#pragma unroll
            for (int m = 0; m < 4; ++m)
#pragma unroll
                for (int n = 0; n < 2; ++n) acc[a][b][m][n] = (f32x4){0.f, 0.f, 0.f, 0.f};
    bf16x8 At[4][2], B0[2][2], B1[2][2];
    const Drv dc = derive(cur, tid);
    const char* cA = cur.A; const char* cB = cur.B;
    PG8_STAGE(PG8_SB(0, 0), cB, dc.vB0, dc.vB1); PG8_STAGE(PG8_SB(0, 1), cB + dc.hB, dc.vB0, dc.vB1); PG8_STAGE(PG8_SA(0, 0), cA, dc.vA0, dc.vA1); PG8_STAGE(PG8_SA(0, 1), cA + dc.hA, dc.vA0, dc.vA1);
    if (wr == 1) PG8_BAR;
    PG8_WAIT_V(2); PG8_BAR;
    PG8_STAGE(PG8_SB(1, 0), cB + 128, dc.vB0, dc.vB1); PG8_STAGE(PG8_SA(1, 0), cA + dc.kA, dc.vA0, dc.vA1); PG8_STAGE(PG8_SB(1, 1), cB + dc.hB + 128, dc.vB0, dc.vB1);
    PG8_WAIT_V(6); PG8_BAR;
    for (;;) {
        const bool has_next = S.next(ui + 1, nxt);
        const char* nA = cA; const char* nB = cB;
        if (has_next) { nA = nxt.A; nB = nxt.B; }
        const int nt = cur.nt;
        for (int t = 0; t < nt; t += 2) {
            const bool last = (t == nt - 2);
            if (cur.kind == K_BR && t == 16) E.mid(acc, cur, wr, wc, fr, fq);
            const size_t aj = (cur.kind == K_BR) ? (size_t)(WS_SB - WS_SA) - 16 * 128 : 0;
            const char* a1 = cA + (size_t)(t + 1) * dc.kA + (t >= 16 ? aj : 0);
            const char* a2 = last ? nA : cA + (size_t)(t + 2) * dc.kA + (t >= 14 ? aj : 0); const char* b2 = last ? nB : cB + (size_t)(t + 2) * 128;
            const unsigned xA0 = dc.vA0, xA1 = dc.vA1, xB0 = dc.vB0, xB1 = dc.vB1, xk = dc.kA, xhA = dc.hA, xhB = dc.hB;
            const char* a3 = a2 + xk; const char* b3 = b2 + 128;
            PG8_LDB(B0, 0, 0); PG8_LDB(B1, 0, 1); PG8_SCHED; PG8_LDA(At, 0, 0); PG8_STAGE(PG8_SA(1, 1), a1 + dc.hA, dc.vA0, dc.vA1);
            PG8_WAIT_V(8); PG8_WAIT_L(0); PG8_BAR; PG8_MMA(0, 0, At, B0); PG8_MMA(0, 1, At, B1); PG8_BAR; PG8_SCHED;
            PG8_LDA(At, 0, 1); PG8_STAGE(PG8_SB(0, 0), b2, xB0, xB1); PG8_STAGE(PG8_SB(0, 1), b2 + xhB, xB0, xB1); PG8_STAGE(PG8_SA(0, 0), a2, xA0, xA1);
            PG8_WAIT_V(8); PG8_WAIT_L(0); PG8_BAR; PG8_MMA(1, 0, At, B0); PG8_MMA(1, 1, At, B1); PG8_BAR; PG8_SCHED;
            PG8_LDB(B0, 1, 0); PG8_LDB(B1, 1, 1); PG8_SCHED; PG8_LDA(At, 1, 0); PG8_STAGE(PG8_SA(0, 1), a2 + xhA, xA0, xA1);
            PG8_WAIT_V(8); PG8_WAIT_L(0); PG8_BAR; PG8_MMA(0, 0, At, B0); PG8_MMA(0, 1, At, B1); PG8_BAR; PG8_SCHED;
            PG8_LDA(At, 1, 1); PG8_STAGE(PG8_SB(1, 0), b3, xB0, xB1); PG8_STAGE(PG8_SB(1, 1), b3 + xhB, xB0, xB1); PG8_STAGE(PG8_SA(1, 0), a3, xA0, xA1);
            PG8_WAIT_V(8); PG8_WAIT_L(0); PG8_BAR; PG8_MMA(1, 0, At, B0); PG8_MMA(1, 1, At, B1); PG8_BAR; PG8_SCHED;
        }
        if (wr == 0) PG8_BAR;
        E(acc, cur, wr, wc, fr, fq);
        if (!has_next) break;
#pragma unroll
        for (int a = 0; a < 2; ++a)
#pragma unroll
            for (int b = 0; b < 2; ++b)
#pragma unroll
                for (int m = 0; m < 4; ++m)
#pragma unroll
                    for (int n = 0; n < 2; ++n) acc[a][b][m][n] = (f32x4){0.f, 0.f, 0.f, 0.f};
        cur = nxt; cA = nA; cB = nB; ++ui;
        if (wr == 1) PG8_BAR;
    }
    PG8_WAIT_V(0);
    PG8_BAR;
#undef PG8_SA
#undef PG8_SB
#undef PG8_STAGE
#undef PG8_LDA
#undef PG8_LDB
#undef PG8_MMA
#undef PG8_WAIT_V
#undef PG8_WAIT_L
#undef PG8_BAR
#undef PG8_SCHED
}
}

__device__ __forceinline__ void transpose_item(const float* W, int N, bf16_t* WT, int ldt, int col_off, int rmode, LAS float* scr, int item, int lane, const float* kscale = nullptr) {
    const int nblk = N / 32, kb = item / nblk, nb = item % nblk, k0 = 64 * kb, n0 = 32 * nb;
    f32x4 wv[8];
#pragma unroll
    for (int i = 0; i < 8; ++i) { wv[i] = *(const f32x4*)(W + (size_t)(k0 + 8 * i + (lane >> 3)) * N + n0 + 4 * (lane & 7)); if (kscale) wv[i] = wv[i] * kscale[k0 + 8 * i + (lane >> 3)]; }
#pragma unroll
    for (int i = 0; i < 8; ++i) { LAS float* d = scr + (8 * i + (lane >> 3)) * 33 + 4 * (lane & 7); d[0] = wv[i][0]; d[1] = wv[i][1]; d[2] = wv[i][2]; d[3] = wv[i][3]; }
    asm volatile("s_waitcnt lgkmcnt(0)" ::: "memory");
    int r0 = n0;
    if (rmode == 1) { const int isu = n0 >= FF, nn = isu ? n0 - FF : n0; r0 = 256 * (nn >> 7) + (nn & 127) + (isu ? 128 : 0); }
    const int c = lane & 7;
#pragma unroll
    for (int j = 0; j < 4; ++j) { const int n = (lane >> 3) + 8 * j; const LAS float* s = scr + (8 * c) * 33 + n;
        u32x4 o; o.x = cvt_pk_bf16(s[0 * 33], s[1 * 33]); o.y = cvt_pk_bf16(s[2 * 33], s[3 * 33]); o.z = cvt_pk_bf16(s[4 * 33], s[5 * 33]); o.w = cvt_pk_bf16(s[6 * 33], s[7 * 33]);
        *(u32x4*)(WT + (size_t)(r0 + n) * ldt + col_off + k0 + 8 * c) = o; }
    asm volatile("s_waitcnt lgkmcnt(0)" ::: "memory");
}
template <int R>
__device__ __forceinline__ void rms_rows_to_bf16(const float* x0, size_t xstride, const float* g, bf16_t* o0, size_t ostride, int lane) {
    f32x4 v[R][4]; float s[R];
#pragma unroll
    for (int r = 0; r < R; ++r)
#pragma unroll
        for (int j = 0; j < 2; ++j) { v[r][2 * j] = *(const f32x4*)(x0 + r * xstride + 512 * j + 8 * lane); v[r][2 * j + 1] = *(const f32x4*)(x0 + r * xstride + 512 * j + 8 * lane + 4); }
#pragma unroll
    for (int r = 0; r < R; ++r) { s[r] = 0.f;
#pragma unroll
        for (int j = 0; j < 4; ++j) s[r] += (v[r][j][0] * v[r][j][0] + v[r][j][1] * v[r][j][1]) + (v[r][j][2] * v[r][j][2] + v[r][j][3] * v[r][j][3]); }
#pragma unroll
    for (int o = 1; o < 64; o <<= 1)
#pragma unroll
        for (int r = 0; r < R; ++r) s[r] += shx(s[r], lane, o);
    f32x4 gg[4];
#pragma unroll
    for (int j = 0; j < 2; ++j) { gg[2 * j] = *(const f32x4*)(g + 512 * j + 8 * lane); gg[2 * j + 1] = *(const f32x4*)(g + 512 * j + 8 * lane + 4); }
#pragma unroll
    for (int r = 0; r < R; ++r) {
        const float rstd = 1.f / sqrtf(s[r] * (1.f / DM) + EPS);
#pragma unroll
        for (int j = 0; j < 2; ++j) {
            const f32x4 a = v[r][2 * j] * rstd * gg[2 * j], b = v[r][2 * j + 1] * rstd * gg[2 * j + 1];
            u32x4 w; w.x = cvt_pk_bf16(a[0], a[1]); w.y = cvt_pk_bf16(a[2], a[3]); w.z = cvt_pk_bf16(b[0], b[1]); w.w = cvt_pk_bf16(b[2], b[3]);
            *(u32x4*)(o0 + r * ostride + 512 * j + 8 * lane) = w;
        }
    }
}
template <bool XIN_BF, bool XOUT_BF>
__device__ __forceinline__ void rowpass(const bf16_t* m, const float* gpost, const void* xin_, void* xout_, const float* gpre, bf16_t* hout, float* rsout, int gw, int NGW, int lane, int row_end) {
    constexpr int R = 4;
    const float* xin = (const float*)xin_; const bf16_t* xinb = (const bf16_t*)xin_; float* xout = (float*)xout_; bf16_t* xoutb = (bf16_t*)xout_;
    for (int row0 = gw; row0 < row_end; row0 += R * NGW) {
        u32x4 mw[R][2]; f32x4 xv[R][4]; u32x4 xw[R][2];
#pragma unroll
        for (int r = 0; r < R; ++r) { const size_t ro = (size_t)(row0 + r * NGW) * DM;
#pragma unroll
            for (int j = 0; j < 2; ++j) { mw[r][j] = *(const u32x4*)(m + ro + 512 * j + 8 * lane);
                if (XIN_BF) xw[r][j] = *(const u32x4*)(xinb + ro + 512 * j + 8 * lane);
                else { xv[r][2 * j] = *(const f32x4*)(xin + ro + 512 * j + 8 * lane); xv[r][2 * j + 1] = *(const f32x4*)(xin + ro + 512 * j + 8 * lane + 4); } } }
        f32x4 gp[4];
#pragma unroll
        for (int j = 0; j < 2; ++j) { gp[2 * j] = *(const f32x4*)(gpost + 512 * j + 8 * lane); gp[2 * j + 1] = *(const f32x4*)(gpost + 512 * j + 8 * lane + 4); }
        float mv[R][2][8]; float ss[R];
#pragma unroll
        for (int r = 0; r < R; ++r) { ss[r] = 0.f;
#pragma unroll
            for (int j = 0; j < 2; ++j) { unpack8(mw[r][j], mv[r][j]);
#pragma unroll
                for (int i = 0; i < 8; ++i) ss[r] += mv[r][j][i] * mv[r][j][i]; } }
#pragma unroll
        for (int o = 1; o < 64; o <<= 1)
#pragma unroll
            for (int r = 0; r < R; ++r) ss[r] += shx(ss[r], lane, o);
        float x1[R][2][8]; float s2[R];
#pragma unroll
        for (int r = 0; r < R; ++r) {
            const size_t ro = (size_t)(row0 + r * NGW) * DM;
            const float rstd = 1.f / sqrtf(ss[r] * (1.f / DM) + EPS); s2[r] = 0.f;
#pragma unroll
            for (int j = 0; j < 2; ++j) {
                const int c = 512 * j + 8 * lane;
                float xi[8];
                if (XIN_BF) unpack8(xw[r][j], xi);
                else {
#pragma unroll
                    for (int i = 0; i < 4; ++i) { xi[i] = xv[r][2 * j][i]; xi[4 + i] = xv[r][2 * j + 1][i]; }
                }
#pragma unroll
                for (int i = 0; i < 4; ++i) { x1[r][j][i] = xi[i] + mv[r][j][i] * rstd * gp[2 * j][i]; x1[r][j][4 + i] = xi[4 + i] + mv[r][j][4 + i] * rstd * gp[2 * j + 1][i]; }
#pragma unroll
                for (int i = 0; i < 8; ++i) s2[r] += x1[r][j][i] * x1[r][j][i];
                if (XOUT_BF) *(u32x4*)(xoutb + ro + c) = pack8(x1[r][j]);
                else { *(f32x4*)(xout + ro + c) = (f32x4){x1[r][j][0], x1[r][j][1], x1[r][j][2], x1[r][j][3]}; *(f32x4*)(xout + ro + c + 4) = (f32x4){x1[r][j][4], x1[r][j][5], x1[r][j][6], x1[r][j][7]}; }
            }
        }
        if (hout || rsout) {
#pragma unroll
            for (int o = 1; o < 64; o <<= 1)
#pragma unroll
                for (int r = 0; r < R; ++r) s2[r] += shx(s2[r], lane, o);
        }
        if (rsout) {
#pragma unroll
            for (int r = 0; r < R; ++r) if (lane == 0) rsout[row0 + r * NGW] = 1.f / sqrtf(s2[r] * (1.f / DM) + EPS);
        }
        if (hout) {
#pragma unroll
            for (int j = 0; j < 2; ++j) { gp[2 * j] = *(const f32x4*)(gpre + 512 * j + 8 * lane); gp[2 * j + 1] = *(const f32x4*)(gpre + 512 * j + 8 * lane + 4); }
#pragma unroll
            for (int r = 0; r < R; ++r) {
                const size_t ro = (size_t)(row0 + r * NGW) * DM;
                const float r2 = 1.f / sqrtf(s2[r] * (1.f / DM) + EPS);
#pragma unroll
                for (int j = 0; j < 2; ++j) {
                    float h[8];
#pragma unroll
                    for (int i = 0; i < 4; ++i) { h[i] = x1[r][j][i] * r2 * gp[2 * j][i]; h[4 + i] = x1[r][j][4 + i] * r2 * gp[2 * j + 1][i]; }
                    *(u32x4*)(hout + ro + 512 * j + 8 * lane) = pack8(h);
                }
            }
        }
    }
}

__device__ __forceinline__ void s5_build(LAS unsigned char* lds, unsigned char* ws, const float* lam_re, const float* lam_im, const float* log_step, const float* b_re,
                                         const float* b_im, const float* c_re, const float* c_im, const float* dvec, int g, int tid) {
    LAS f32x2* AP = (LAS f32x2*)lds;
    LAS f32x2* BB = (LAS f32x2*)(lds + 33280);
    LAS f32x2* CC = (LAS f32x2*)(lds + 41472);
    LAS float* KT = (LAS float*)(lds + 49664);
    const float step = expf(log_step[g]);
    for (int i = tid; i < 64 * 65; i += 512) {
        const int p = i / 65, tau = i % 65;
        const float lr = lam_re[g * 64 + p], li = lam_im[g * 64 + p];
        const float mag = expf(lr * step * (float)tau);
        const double ang = (double)li * (double)step * (double)tau;
        const double kq = rint(ang * 0.15915494309189535);
        const float r = (float)(ang - kq * 6.283185307179586);
        AP[p * 65 + tau] = (f32x2){mag * cosf(r), mag * sinf(r)};
    }
    for (int i = tid; i < 64 * 16; i += 512) {
        const int p = i >> 4, h = i & 15;
        const float lr = lam_re[g * 64 + p], li = lam_im[g * 64 + p];
        const float x = lr * step, mag = expf(x), em1 = expm1f(x);
        const double ang = (double)li * (double)step; const double kq = rint(ang * 0.15915494309189535);
        const float r = (float)(ang - kq * 6.283185307179586);
        const float sh = sinf(0.5f * r), cm1 = -2.f * sh * sh, sn = sinf(r), cs = 1.f + cm1;
        const float nr = em1 * cs + cm1, ni = mag * sn;
        const float den = lr * lr + li * li;
        const float co_re = (nr * lr + ni * li) / den, co_im = (ni * lr - nr * li) / den;
        const float br = b_re[(g * 64 + p) * 16 + h], bi = b_im[(g * 64 + p) * 16 + h];
        BB[p * 16 + h] = (f32x2){co_re * br - co_im * bi, co_re * bi + co_im * br};
        const int hh = i >> 6, pp = i & 63;
        CC[hh * 64 + pp] = (f32x2){c_re[(g * 16 + hh) * 64 + pp], c_im[(g * 16 + hh) * 64 + pp]};
    }
    __syncthreads();
    for (int it = 0; it < 2; ++it) {
        const int tau = tid & 63, hp = (tid >> 6) + 8 * it;
        float a[16];
#pragma unroll
        for (int h = 0; h < 16; ++h) a[h] = 0.f;
        for (int p = 0; p < 64; ++p) {
            const f32x2 c = CC[hp * 64 + p], ap = AP[p * 65 + tau];
            const float xr = c.x * ap.x - c.y * ap.y, xi = c.x * ap.y + c.y * ap.x;
#pragma unroll
            for (int h = 0; h < 16; ++h) { const f32x2 b = BB[p * 16 + h]; a[h] += xr * b.x - xi * b.y; }
        }
        if (tau == 0) {
#pragma unroll
            for (int h = 0; h < 16; ++h) if (h == hp) a[h] += dvec[g * 16 + hp];
        }
#pragma unroll
        for (int h = 0; h < 16; ++h) KT[tau * KTS + hp * 16 + h] = a[h];
    }
    __syncthreads();
    { const LAS f32x4* src = (const LAS f32x4*)lds; f32x4* dst = (f32x4*)(ws + WS_S5T + (size_t)g * S5T_BYTES);
      for (int i = tid; i < S5T_BYTES / 16; i += 512) dst[i] = src[i]; }
    if (tid < 64) ((f32x2*)(ws + WS_A64))[g * 64 + tid] = AP[tid * 65 + 64];
    __syncthreads();
}
__device__ __forceinline__ void s5_expand(LAS unsigned char* lds, unsigned char* ws, int g, int part, int tid) {
    LAS f32x2* AP = (LAS f32x2*)lds; LAS f32x2* BB = (LAS f32x2*)(lds + 33280); LAS f32x2* CC = (LAS f32x2*)(lds + 41472); LAS float* KT = (LAS float*)(lds + 49664);
    { const f32x4* src = (const f32x4*)(ws + WS_S5T + (size_t)g * S5T_BYTES); LAS f32x4* dst = (LAS f32x4*)lds;
      for (int i = tid; i < S5T_BYTES / 16; i += 512) dst[i] = src[i]; }
    __syncthreads();
    bf16_t* BT2 = (bf16_t*)(ws + WS_BT2) + (size_t)g * 1024 * 1152;
    for (int i = tid; i < 128 * 144; i += 512) {
        const int rl = i / 144, cc = i % 144, t = 8 * part + (rl >> 4), hp = rl & 15;
        float v[8];
        if (cc >= 16) {
            const int s = (cc - 16) >> 1, h0 = (cc & 1) * 8;
            if (s >= 16 * ((t >> 4) + 1)) continue;
            if (s <= t) {
#pragma unroll
                for (int j = 0; j < 8; ++j) v[j] = KT[(t - s) * KTS + hp * 16 + h0 + j];
            } else {
#pragma unroll
                for (int j = 0; j < 8; ++j) v[j] = 0.f;
            }
        } else {
            const int p0 = cc * 4;
#pragma unroll
            for (int j = 0; j < 4; ++j) { const f32x2 c = CC[hp * 64 + p0 + j], ap = AP[(p0 + j) * 65 + t + 1];
                v[2 * j] = c.x * ap.x - c.y * ap.y; v[2 * j + 1] = -(c.x * ap.y + c.y * ap.x); }
        }
        *(u32x4*)(BT2 + (size_t)(t * 16 + hp) * 1152 + cc * 8) = pack8(v);
    }
    bf16_t* BT1 = (bf16_t*)(ws + WS_BT1) + (size_t)g * 128 * 1152;
    for (int i = tid; i < 16 * 128; i += 512) {
        const int rl = i >> 7, cc = i & 127, p = 8 * part + (rl >> 1), ri = rl & 1, s = cc >> 1, h0 = (cc & 1) * 8;
        const f32x2 ap = AP[p * 65 + 63 - s];
        float v[8];
#pragma unroll
        for (int j = 0; j < 8; ++j) { const f32x2 b = BB[p * 16 + h0 + j]; v[j] = ri ? (ap.x * b.y + ap.y * b.x) : (ap.x * b.x - ap.y * b.y); }
        *(u32x4*)(BT1 + (size_t)(2 * p + ri) * 1152 + cc * 8) = pack8(v);
    }
    __syncthreads();
}

__device__ __forceinline__ void spatial_phase(LAS unsigned char* lds, unsigned char* ws, const float* ln_g, const float* ln_b, const float* b_s, int vcu, int G, const int tid) {
    __syncthreads();
    const int wid = __builtin_amdgcn_readfirstlane(tid >> 6), lane = tid & 63, fr = lane & 15, fq = lane >> 4;
    LAS f32x2* ST = (LAS f32x2*)lds;
    LAS bf16_t* VT = (LAS bf16_t*)(lds + 1024);
    LAS float* LG = (LAS float*)(lds + 36864);
    LAS float* LB = (LAS float*)(lds + 40960);
    const bf16_t* U = (const bf16_t*)(ws + WS_U); const bf16_t* V = (const bf16_t*)(ws + WS_V); bf16_t* YC = (bf16_t*)(ws + WS_SA);
    const bf16_t* WSP = (const bf16_t*)(ws + WS_WSP);
    for (int i = tid; i < 1024; i += 512) { LG[i] = ln_g[i]; LB[i] = ln_b[i]; }
    const int kmax = (16 * wid + 15) >> 5, t = 16 * wid + fr;
    for (int unit = vcu; unit < M_TOK / 128; unit += G) {
        const size_t r0 = (size_t)unit * 128;
        u32x4 vreg[4];
#pragma unroll
        for (int it = 0; it < 4; ++it) { const int idx = wid * 4 + it, s = (idx & 1) * 64 + lane, c0 = (idx >> 1) * 8; vreg[it] = *(const u32x4*)(V + (r0 + s) * DM + c0); }
        {
            const f32x4* pv = (const f32x4*)((const float*)(ws + WS_VST) + ((r0 + 16 * wid + (lane >> 2)) * 16 + 4 * (lane & 3)) * 2);
            const f32x4 p0 = pv[0], p1 = pv[1];
            float s1 = (p0[0] + p0[2]) + (p1[0] + p1[2]), s2 = (p0[1] + p0[3]) + (p1[1] + p1[3]);
            s1 += shx(s1, lane, 1); s1 += shx(s1, lane, 2); s2 += shx(s2, lane, 1); s2 += shx(s2, lane, 2);
            const float mean = s1 * (1.f / DM), var = fmaxf(s2 * (1.f / DM) - mean * mean, 0.f);
            if ((lane & 3) == 0) ST[16 * wid + (lane >> 2)] = (f32x2){mean, 1.f / sqrtf(var + EPS)};
        }
        __syncthreads();
        for (int g = 0; g < 8; ++g) {
#pragma unroll
            for (int it = 0; it < 4; ++it) {
                const int idx = wid * 4 + it, s = (idx & 1) * 64 + lane, c0 = (idx >> 1) * 8;
                float v[8]; unpack8(vreg[it], v);
                const f32x2 st = ST[s];
                const f32x4 g0 = *(const LAS f32x4*)(LG + g * 128 + c0), g1 = *(const LAS f32x4*)(LG + g * 128 + c0 + 4), e0 = *(const LAS f32x4*)(LB + g * 128 + c0), e1 = *(const LAS f32x4*)(LB + g * 128 + c0 + 4);
#pragma unroll
                for (int i = 0; i < 8; ++i) {
                    const int c = c0 + i, rho = (c & ~31) + 16 * ((c >> 2) & 1) + 4 * ((c & 31) >> 3) + (c & 3);
                    const float gm = i < 4 ? g0[i] : g1[i - 4], be = i < 4 ? e0[i] : e1[i - 4];
                    const float val = (v[i] - st.x) * st.y * gm + be;
                    VT[rho * 136 + s] = (bf16_t)(cvt_pk_bf16(val, 0.f) & 0xffffu);
                }
            }
            bf16x8 wf[4];
#pragma unroll
            for (int kk = 0; kk < 4; ++kk) if (kk <= kmax) wf[kk] = *(const bf16x8*)(WSP + ((size_t)(g * 128 + t)) * 128 + 32 * kk + 8 * fq);
            const float bias = b_s[g * 128 + t];
            u32x4 ureg[4];
#pragma unroll
            for (int b = 0; b < 4; ++b) ureg[b] = *(const u32x4*)(U + (r0 + t) * DM + g * 128 + b * 32 + 8 * fq);
            if (g < 7) {
#pragma unroll
                for (int it = 0; it < 4; ++it) { const int idx = wid * 4 + it, s = (idx & 1) * 64 + lane, c0 = (idx >> 1) * 8; vreg[it] = *(const u32x4*)(V + (r0 + s) * DM + (g + 1) * 128 + c0); }
            }
            __syncthreads();
            f32x4 acc[4][2];
#pragma unroll
            for (int b = 0; b < 4; ++b) { acc[b][0] = (f32x4){0.f, 0.f, 0.f, 0.f}; acc[b][1] = (f32x4){0.f, 0.f, 0.f, 0.f}; }
#pragma unroll
            for (int kk = 0; kk < 4; ++kk) if (kk <= kmax) {
#pragma unroll
                for (int b = 0; b < 4; ++b)
#pragma unroll
                    for (int n = 0; n < 2; ++n) {
                        const bf16x8 vf = *(const LAS bf16x8*)(VT + (b * 32 + 16 * n + fr) * 136 + 32 * kk + 8 * fq);
                        acc[b][n] = __builtin_amdgcn_mfma_f32_16x16x32_bf16(vf, wf[kk], acc[b][n], 0, 0, 0);
                    }
            }
#pragma unroll
            for (int b = 0; b < 4; ++b) {
                float u8[8]; unpack8(ureg[b], u8);
                float o[8];
#pragma unroll
                for (int j = 0; j < 4; ++j) { o[j] = (acc[b][0][j] + bias) * u8[j]; o[4 + j] = (acc[b][1][j] + bias) * u8[4 + j]; }
                *(u32x4*)(YC + (r0 + t) * DM + g * 128 + b * 32 + 8 * fq) = pack8(o);
            }
            __syncthreads();
        }
    }
}


#define XB_TMO      128
#define XB_XCNT(j)  (256  + 64 * (j))
#define XB_XSUB(j)  (1280 + 64 * (j))
#define XB_XGEN(j)  (2304 + 64 * (j))
#define XB_TOP      3328
#define XB_TOPGEN   3392
#define XB_SPIN_CAP (1u << 20)
__device__ __forceinline__ unsigned xb_ld(unsigned* p)              { return __hip_atomic_load(p, __ATOMIC_RELAXED, __HIP_MEMORY_SCOPE_AGENT); }
__device__ __forceinline__ unsigned xb_add(unsigned* p, unsigned v) { return __hip_atomic_fetch_add(p, v, __ATOMIC_RELAXED, __HIP_MEMORY_SCOPE_AGENT); }
__device__ __forceinline__ unsigned xb_xcc_id() { return (unsigned)__builtin_amdgcn_s_getreg((3 << 11) | 20) & 0xFu; }
#define XB_SPIN(cond, bar) do { unsigned _sp = 0; while (cond) { __builtin_amdgcn_s_sleep(1); \
    if ((++_sp & 255u) == 0u) { if (xb_ld(&(bar)[XB_TMO])) break; if (_sp > XB_SPIN_CAP) { atomicAdd(&(bar)[XB_TMO], 1u); break; } } } } while (0)
struct XcdBarrier { unsigned* bar; unsigned x; volatile LAS unsigned* st; };
__device__ __forceinline__ void xcd_barrier_post(unsigned* bar, int tid) { if (tid == 0) (void)xb_add(&bar[XB_XCNT(xb_xcc_id())], 1u); }
__device__ __forceinline__ void xcd_barrier_complete(unsigned* bar, unsigned x, unsigned& nloc, unsigned& nx) {
    const unsigned G = gridDim.x * gridDim.y * gridDim.z;
    unsigned sum, cnt, mine, sp = 0u;
    for (;;) {
        sum = 0u; cnt = 0u; mine = 0u;
#pragma unroll
        for (unsigned j = 0; j < 16; ++j) { const unsigned c = xb_ld(&bar[XB_XCNT(j)]); sum += c; cnt += (c > 0u) ? 1u : 0u; mine = (j == x) ? c : mine; }
        if (sum == G) break;
        __builtin_amdgcn_s_sleep(1);
        if ((++sp & 255u) == 0u) { if (xb_ld(&bar[XB_TMO])) break; if (sp > XB_SPIN_CAP) { atomicAdd(&bar[XB_TMO], 1u); break; } }
    }
    nloc = mine > 0u ? mine : 1u; nx = cnt > 0u ? cnt : 1u;
}
__device__ __forceinline__ void xcd_barrier(const XcdBarrier& b, int tid) {
    asm volatile("s_waitcnt vmcnt(0)" ::: "memory");
    __syncthreads();
    if (tid == 0) {
        unsigned* bar = b.bar;
        __builtin_amdgcn_s_waitcnt(0);
        unsigned nloc = b.st[0], nx = b.st[1];
        if (nloc == 0u) { xcd_barrier_complete(bar, b.x, nloc, nx); b.st[0] = nloc; b.st[1] = nx; }
        const unsigned old = xb_add(&bar[XB_XSUB(b.x)], 1u);
        const unsigned gen = old / nloc;
        if (old + 1u == (gen + 1u) * nloc) {
            __builtin_amdgcn_fence(__ATOMIC_RELEASE, "agent");
            asm volatile("s_waitcnt vmcnt(0)" ::: "memory");
            const unsigned og = xb_add(&bar[XB_TOP], 1u);
            const unsigned tg = og / nx;
            if (og + 1u == (tg + 1u) * nx) xb_add(&bar[XB_TOPGEN], 1u);
            else XB_SPIN(xb_ld(&bar[XB_TOPGEN]) == tg, bar);
            __builtin_amdgcn_fence(__ATOMIC_ACQUIRE, "agent");
            xb_add(&bar[XB_XGEN(b.x)], 1u);
            asm volatile("s_waitcnt vmcnt(0)" ::: "memory");
        } else {
            XB_SPIN(xb_ld(&bar[XB_XGEN(b.x)]) == gen, bar);
            __builtin_amdgcn_fence(__ATOMIC_ACQUIRE, "agent");
            asm volatile("s_waitcnt vmcnt(0)" ::: "memory");
        }
    }
    __syncthreads();
}

struct Args { const float* in[31]; float* out; unsigned char* ws; int ph_lo, ph_hi; };

__global__ void __launch_bounds__(512, 2) mk_fwd(Args args) {
    extern __shared__ __attribute__((aligned(16))) unsigned char lds_raw[];
    LAS unsigned char* lds = (LAS unsigned char*)lds_raw;
    const int G = gridDim.x, bx = blockIdx.x;
    const int vcu = (G % 8 == 0) ? (bx % 8) * (G / 8) + bx / 8 : bx;
    volatile LAS unsigned* xst = (volatile LAS unsigned*)(lds + LDS_XS + 8192);
    const bool multi = args.ph_hi - args.ph_lo > 1;
    if (multi) { if (threadIdx.x < 2) xst[threadIdx.x] = 0u; __syncthreads(); xcd_barrier_post((unsigned*)args.ws, (int)threadIdx.x); }

    for (int pi = args.ph_lo; pi < args.ph_hi; ++pi) {
        const int ph = pi;
        if (ph == 11 || ph == 12) continue;
        int tid = threadIdx.x; asm volatile("" : "+v"(tid));
        size_t wz = 0; asm volatile("" : "+s"(wz)); unsigned char* ws = args.ws + wz;
        const __attribute__((address_space(4))) char* kp = (const __attribute__((address_space(4))) char*)__builtin_amdgcn_kernarg_segment_ptr() + wz;
#define IN(i) ((const float*)(*(const __attribute__((address_space(1))) float* const __attribute__((address_space(4)))*)(kp + 8 * (i))))
        const int lane = tid & 63, wave = __builtin_amdgcn_readfirstlane(tid >> 6);
        const int gw = vcu * 8 + wave, NGW = G * 8;
        const bool panel_mode = (G == M_TOK / 256); const int panel = vcu;
        pg8::Epi E; E.ws = ws; E.lds = lds;
        bool is_gemm = false;
        if (ph == 0) {
            const bool split = (G % 32 == 0) && (G >= 128);
            const int nc = split ? (G / 32) * 12 : G, nm = split ? G - nc : G;
            const int ci = split ? (vcu % 32) * (G / 32) + (vcu / 32) : vcu, mi = split ? (vcu / 32) * 20 + (vcu % 32) - 12 : vcu;
            const bool do_c = !split || (vcu % 32) < 12, do_m = !split || (vcu % 32) >= 12;
            const int gwc = ci * 8 + wave, NGWC = nc * 8, gwm = mi * 8 + wave, NGWM = nm * 8;
            if (do_c) {
            for (int g = ci; g < 32; g += nc) s5_build(lds, ws, IN(8), IN(9), IN(10), IN(11), IN(12), IN(13), IN(14), IN(15), g, tid);
            LAS float* scr = (LAS float*)(lds + wave * 16384);
            constexpr int I_IN = 16 * (NIN / 32), I_BG = 16 * 32, I_BS = 8 * 32, I_MX = 16 * 32, I_GL = 8 * 16, I_Q = 16 * 32, I_KV = 16 * 64, I_O = 16 * 32, I_GU = 16 * (2 * FF / 32), I_DN = (FF / 64) * 32;
            constexpr int NIT = I_IN + I_BG + I_BS + I_MX + I_GL + I_KV + I_O + I_GU + I_DN;
            for (int it = gwc; it < NIT; it += NGWC) {
                int r = it;
                if (r < I_IN) { transpose_item(IN(3), NIN, (bf16_t*)(ws + WS_WIN), 1024, 0, 0, scr, r, lane); continue; } r -= I_IN;
                if (r < I_BG) { transpose_item(IN(17), 1024, (bf16_t*)(ws + WS_WBR), 1536, 0, 0, scr, r, lane); continue; } r -= I_BG;
                if (r < I_BS) { transpose_item(IN(18), 1024, (bf16_t*)(ws + WS_WBR), 1536, 1024, 0, scr, r, lane); continue; } r -= I_BS;
                if (r < I_MX) { transpose_item(IN(19), 1024, (bf16_t*)(ws + WS_WMIX), 1024, 0, 0, scr, r, lane); continue; } r -= I_MX;
                if (r < I_GL) { transpose_item(IN(16), 512, (bf16_t*)(ws + WS_WGLU), 512, 0, 0, scr, r, lane); continue; } r -= I_GL;
                if (r < I_KV) { transpose_item(IN(24), 2048, (bf16_t*)(ws + WS_WKV), 1152, 0, 0, scr, r, lane); continue; } r -= I_KV;
                if (r < I_O) { transpose_item(IN(25), 1024, (bf16_t*)(ws + WS_WO), 1024, 0, 0, scr, r, lane); continue; } r -= I_O;
                if (r < I_GU) { transpose_item(IN(28), 2 * FF, (bf16_t*)(ws + WS_WGU), 1024, 0, 1, scr, r, lane, IN(27)); continue; } r -= I_GU;
                transpose_item(IN(29), 1024, (bf16_t*)(ws + WS_WDN), FF, 0, 0, scr, r, lane);
            }
            {
                const float* w = IN(23); const float* gq = IN(21); bf16_t* o = (bf16_t*)(ws + WS_WQ);
                for (int i = ci * 512 + tid; i < 1024 * 1024 / 8; i += nc * 512) {
                    const int e = i * 8; const float gsc = gq[e >> 10];
                    const f32x4 a = *(const f32x4*)(w + e) * gsc, b = *(const f32x4*)(w + e + 4) * gsc;
                    float v[8] = {a[0], a[1], a[2], a[3], b[0], b[1], b[2], b[3]};
                    *(u32x4*)(o + e) = pack8(v);
                }
            }
            {
                const float* w = IN(6); bf16_t* o = (bf16_t*)(ws + WS_WSP);
                for (int i = ci * 512 + tid; i < 8 * 128 * 128 / 8; i += nc * 512) {
                    const int e = i * 8, s0 = e & 127, t = (e >> 7) & 127;
                    const f32x4 a = *(const f32x4*)(w + e), b = *(const f32x4*)(w + e + 4);
                    float v[8] = {a[0], a[1], a[2], a[3], b[0], b[1], b[2], b[3]};
#pragma unroll
                    for (int j = 0; j < 8; ++j) if (s0 + j > t) v[j] = 0.f;
                    *(u32x4*)(o + e) = pack8(v);
                }
            }
            }
            if (do_m) {
                int m = gwm;
                for (; m + 3 * NGWM < M_TOK; m += 4 * NGWM) rms_rows_to_bf16<4>(IN(0) + (size_t)m * DM, (size_t)NGWM * DM, IN(2), (bf16_t*)(ws + WS_SA) + (size_t)m * DM, (size_t)NGWM * DM, lane);
                for (; m < M_TOK; m += NGWM) rms_rows_to_bf16<1>(IN(0) + (size_t)m * DM, 0, IN(2), (bf16_t*)(ws + WS_SA) + (size_t)m * DM, 0, lane);
                for (m = gwm; m < NMEM; m += NGWM) rms_rows_to_bf16<1>(IN(1) + (size_t)m * DM, 0, IN(22), (bf16_t*)(ws + WS_MEMN) + (size_t)m * 1152, 0, lane);
            }
        } else if (ph == 1 || ph == 2) { is_gemm = true;
        } else if (ph == 3) { is_gemm = true;
        } else if (ph == 4 || ph == 5 || ph == 6 || ph == 7) { is_gemm = true;
        } else if (ph == 8) {
            if (panel_mode) rowpass<false, true>((const bf16_t*)(ws + WS_SA), IN(20), IN(0), ws + WS_X1B, nullptr, nullptr, (float*)(ws + WS_RS1), panel * 256 + wave, 8, lane, panel * 256 + 256);
            else rowpass<false, true>((const bf16_t*)(ws + WS_SA), IN(20), IN(0), ws + WS_X1B, nullptr, nullptr, (float*)(ws + WS_RS1), gw, NGW, lane, M_TOK);
        } else if (ph == 9 || ph == 10) { is_gemm = true;
        } else if (ph == 13) {
            if (panel_mode) rowpass<true, true>((const bf16_t*)(ws + WS_SD), IN(26), ws + WS_X1B, ws + WS_X2B, nullptr, nullptr, (float*)(ws + WS_RS2), panel * 256 + wave, 8, lane, panel * 256 + 256);
            else rowpass<true, true>((const bf16_t*)(ws + WS_SD), IN(26), ws + WS_X1B, ws + WS_X2B, nullptr, nullptr, (float*)(ws + WS_RS2), gw, NGW, lane, M_TOK);
        } else if (ph == 14 || ph == 15) { is_gemm = true;
        } else if (ph == 16) {
            if (panel_mode) rowpass<true, false>((const bf16_t*)(ws + WS_SC), IN(30), ws + WS_X2B, args.out, nullptr, nullptr, nullptr, panel * 256 + wave, 8, lane, panel * 256 + 256);
            else rowpass<true, false>((const bf16_t*)(ws + WS_SC), IN(30), ws + WS_X2B, args.out, nullptr, nullptr, nullptr, gw, NGW, lane, M_TOK);
        }
        if (is_gemm) {
            pg8::Sched S; S.ws = ws; S.ph = ph; S.G = G; S.c = bx; S.panel = (panel_mode && ph >= 6 && !FFN_GRID(ph)) ? panel : -1;
            const bool scan_wg = (ph == 3) && (G > 128) && (vcu < 64);
            if (ph == 3 && G > 128) { S.G = G - 64; S.c = vcu - 64; }
            S.n0 = pg8::phase_units(ph, 0); S.n1 = (ph == 2 || ph == 3) ? pg8::phase_units(ph, 1) : 0; S.total = S.n0 + S.n1;
            if (S.panel >= 0) S.total = (ph == 14) ? 2 * FF / 256 : 4;
            if (ph == 1) { for (int u = vcu; u < 256; u += G) s5_expand(lds, ws, u >> 3, u & 7, tid); }
            const bool sp_first = (ph == 2) && ((vcu >> 0) & 1);
            if (sp_first) spatial_phase(lds, ws, IN(4), IN(5), IN(7), vcu, G, tid);
            if (!scan_wg) pg8::gemm_phase(lds, S, E, tid);
            if (ph == 2 && !sp_first) spatial_phase(lds, ws, IN(4), IN(5), IN(7), vcu, G, tid);
            if (ph == 3) {
            const int gt = vcu * 512 + tid;
                if (gt < 16 * 32 * 64) {
                    const int p = gt & 63, g = (gt >> 6) & 31, b = gt >> 11;
                    const f32x2 a = ((const f32x2*)(ws + WS_A64))[g * 64 + p];
                    const float* Eb = (const float*)(ws + WS_EBUF); bf16_t* UC = (bf16_t*)(ws + WS_UC);
                    float cr = 0.f, ci = 0.f;
    #pragma unroll 8
                    for (int k = 0; k < 64; ++k) {
                        const size_t row = (size_t)g * 1024 + b * 64 + k;
                        const f32x2 e = *(const f32x2*)(Eb + row * 128 + 2 * p);
                        *(unsigned*)(UC + row * 1152 + 2 * p) = cvt_pk_bf16(cr, ci);
                        const float nr = a.x * cr - a.y * ci + e.x, ni = a.x * ci + a.y * cr + e.y; cr = nr; ci = ni;
                    }
                }

            }
        }
        if (pi + 1 < args.ph_hi) {
            if (panel_mode && ph >= 6 && ph != 16 && !FFN_GRID(ph) && !FFN_GRID(ph + 1)) {
                asm volatile("s_waitcnt vmcnt(0) lgkmcnt(0)" ::: "memory");
                __syncthreads();
                __builtin_amdgcn_fence(__ATOMIC_ACQUIRE, "agent");
                asm volatile("s_waitcnt vmcnt(0)" ::: "memory");
                __syncthreads();
            } else if (args.ph_hi > 4096) cg::this_grid().sync();
            else { XcdBarrier xb; xb.bar = (unsigned*)ws; xb.x = xb_xcc_id(); xb.st = xst; xcd_barrier(xb, tid); }
        }
    }
}

extern "C" void kernel_launch(void* const* d_in, const int* in_sizes, int n_in, void* d_out, int out_size, void* d_ws, size_t ws_size, hipStream_t stream) {
    static int grid = 0;
    if (grid == 0) {
        if (n_in != 31 || in_sizes[0] != M_TOK * DM || out_size != M_TOK * DM || ws_size < WS_END) { fprintf(stderr, "kernel_launch: unexpected problem (n_in %d, ws %zu)\n", n_in, ws_size); grid = -1; return; }
        int dev = 0, cus = 0, per_cu = 0;
        hipGetDevice(&dev); hipDeviceGetAttribute(&cus, hipDeviceAttributeMultiprocessorCount, dev);
        hipFuncSetAttribute((const void*)mk_fwd, hipFuncAttributeMaxDynamicSharedMemorySize, LDS_BYTES);
        hipOccupancyMaxActiveBlocksPerMultiprocessor(&per_cu, (const void*)mk_fwd, 512, LDS_BYTES);
        if (per_cu < 1) { fprintf(stderr, "kernel_launch: occupancy query says %d blocks per CU\n", per_cu); per_cu = 1; }
        (void)hipGetLastError();
        grid = cus;
    }
    if (grid < 0) return;
    Args a{};
    for (int i = 0; i < 31; ++i) a.in[i] = (const float*)d_in[i];
    a.out = (float*)d_out; a.ws = (unsigned char*)d_ws;
#if MK_ONE_LAUNCH
    (void)hipMemsetAsync(d_ws, 0, 65536, stream);
    a.ph_lo = 0; a.ph_hi = NPHASE;
    void* kargs[] = {&a};
    hipError_t e = hipLaunchCooperativeKernel((const void*)mk_fwd, dim3(grid), dim3(512), kargs, LDS_BYTES, stream);
    if (e != hipSuccess) fprintf(stderr, "cooperative launch failed: %s (grid %d)\n", hipGetErrorString(e), grid);

#else
    for (int ph = 0; ph < NPHASE; ++ph) {
        a.ph_lo = ph; a.ph_hi = ph + 1;
        hipLaunchKernelGGL(mk_fwd, dim3(grid), dim3(512), LDS_BYTES, stream, a);
    }
#endif
}
```

```cpp
#include <hip/hip_runtime.h>
#include <hip/hip_cooperative_groups.h>
#include <cstdint>
#include <cstdio>
namespace cg = cooperative_groups;

#define FFN_GRID(p) ((p) == 6 || (p) == 7 || (p) == 9 || (p) == 10 || (p) == 14 || (p) == 15)
#ifndef MK_ONE_LAUNCH
#define MK_ONE_LAUNCH 1
#endif

#define LAS __attribute__((address_space(3)))
typedef unsigned short bf16_t;
typedef short bf16x8 __attribute__((ext_vector_type(8)));
typedef float f32x4 __attribute__((ext_vector_type(4)));
typedef float f32x2 __attribute__((ext_vector_type(2)));
typedef unsigned u32x4 __attribute__((ext_vector_type(4)));
typedef unsigned u32x2 __attribute__((ext_vector_type(2)));

constexpr int M_TOK = 65536, DM = 1024, NIN = 4608, FF = 2816, NMEM = 4096, SEQ = 4096;
constexpr float EPS = 1e-6f;
constexpr int NPHASE = 17;
constexpr size_t MiB = 1u << 20;
constexpr size_t WS_WIN = 1 * MiB, WS_WBR = 10 * MiB, WS_WMIX = 13 * MiB, WS_WGLU = 15 * MiB, WS_WQ = 16 * MiB, WS_WKV = 18 * MiB  , WS_WO = 23 * MiB,
                 WS_WGU = 25 * MiB, WS_WDN = 36 * MiB, WS_WSP = 42 * MiB, WS_A64 = 42 * MiB + 256 * 1024, WS_RS1 = 42 * MiB + 320 * 1024  , WS_RS2 = 42 * MiB + 576 * 1024  , WS_KB = 43 * MiB, WS_VB = 51 * MiB  ;
constexpr size_t WS_SA = 59 * MiB, WS_SB = 187 * MiB, WS_SC = 315 * MiB, WS_SD = 443 * MiB;
constexpr size_t WS_ACT = 571 * MiB;
constexpr size_t WS_BT1 = 571 * MiB  , WS_BT2 = 581 * MiB, WS_EBUF = 653 * MiB, WS_MEMN = 669 * MiB  , WS_UC = 678 * MiB,
                 WS_U = 750 * MiB  , WS_V = 878 * MiB, WS_S5T = 1006 * MiB  , WS_END = 1010 * MiB;
constexpr size_t WS_X1B = WS_SB, WS_X2B = WS_SA;
constexpr size_t WS_VST = WS_SB;
constexpr size_t WS_MB = 942 * MiB, WS_NB = 974 * MiB;
constexpr int KTS = 257;
constexpr int S5T_BYTES = 49664 + 64 * KTS * 4;
constexpr int LDS_RING = 131072, LDS_XS = 131072, LDS_BYTES = 147456;

typedef __bf16 bf16v2 __attribute__((ext_vector_type(2)));
__device__ __forceinline__ unsigned cvt_pk_bf16(float lo, float hi) { const f32x2 f = {lo, hi}; const bf16v2 v = __builtin_convertvector(f, bf16v2); return __builtin_bit_cast(unsigned, v); }
__device__ __forceinline__ float bf_lo(unsigned w) { return __uint_as_float(w << 16); }
__device__ __forceinline__ float bf_hi(unsigned w) { return __uint_as_float(w & 0xffff0000u); }
__device__ __forceinline__ float fsigmoid(float x) { return __builtin_amdgcn_rcpf(1.f + __builtin_amdgcn_exp2f(-1.4426950408889634f * x)); }
__device__ __forceinline__ float gelu_t(float x) { const float y = 1.5957691216057308f * (x + 0.044715f * x * x * x); return x * fsigmoid(y); }
__device__ __forceinline__ float shx(float v, int lane, int o) { return __int_as_float(__builtin_amdgcn_ds_bpermute((lane ^ o) << 2, __float_as_int(v))); }
__device__ __forceinline__ float wave_sum(float v, int lane) {
#pragma unroll
    for (int o = 1; o < 64; o <<= 1) v += shx(v, lane, o);
    return v;
}
__device__ __forceinline__ void unpack8(const u32x4 w, float (&v)[8]) {
    v[0] = bf_lo(w.x); v[1] = bf_hi(w.x); v[2] = bf_lo(w.y); v[3] = bf_hi(w.y); v[4] = bf_lo(w.z); v[5] = bf_hi(w.z); v[6] = bf_lo(w.w); v[7] = bf_hi(w.w);
}
__device__ __forceinline__ u32x4 pack8(const float (&v)[8]) {
    u32x4 w; w.x = cvt_pk_bf16(v[0], v[1]); w.y = cvt_pk_bf16(v[2], v[3]); w.z = cvt_pk_bf16(v[4], v[5]); w.w = cvt_pk_bf16(v[6], v[7]); return w;
}

namespace pg8 {
constexpr int BM = 256, BK = 64, HALF = 128, HTB = HALF * BK * 2, NXCD = 8, WGM = 4;
static_assert(WGM == 4, "the phase-4 unit mirroring assumes groups of 4 row tiles x 4 column tiles");
__host__ __device__ __forceinline__ int lds_byte(int r, int c) { const int st = (r >> 4) * 2 + (c >> 5), rr = r & 15, cc = c & 31, ob = rr * 64 + cc * 2; return st * 1024 + (ob ^ (((ob >> 9) & 1) << 5)); }
__host__ __device__ __forceinline__ void stage_rc(int b, int& R, int& C) { const int st = b / 1024, sb = b % 1024, swz = sb ^ (((sb >> 9) & 1) << 5); R = (st >> 1) * 16 + swz / 64; C = (st & 1) * 32 + (swz % 64) / 2; }
__host__ __device__ __forceinline__ int perm32(int rho) { const int n = rho >> 4, i = rho & 15; return 8 * (i >> 2) + 4 * n + (i & 3); }

enum Kind { K_IN = 0, K_KVPROJ, K_MB, K_NB, K_S5E, K_S5Y, K_GLU, K_BR, K_MIX, K_SMAX, K_OPROJ, K_GU, K_DOWN };

struct Unit { const char* A; const char* B; int lda, cha, ldb, nt, pn, kind, orow, ocol; };
struct Desc {
    const char* A; const char* B; int lda, cha, ldb, nt, nM, nN, nZ0; long zsA0, zsA1, zsB0, zsB1; int kind, orz0, orz1, ocz0;
    __device__ __forceinline__ void fill(int w, Unit& u) const {
        const int per = nM * nN, z = w / per, r = w % per;
        const int nig = WGM * nN, gid = r / nig, fm = gid * WGM, gsz = (nM - fm) < WGM ? (nM - fm) : WGM;
        const int pm = fm + ((r % nig) % gsz), pn = (r % nig) / gsz;
        const int z0 = z % nZ0, z1 = z / nZ0;
        fill_pz(pm, pn, z0, z1, u);
    }
    __device__ __forceinline__ void fill_pz(int pm, int pn, int z0, int z1, Unit& u) const {
        u.pn = pn;
        u.A = A + z0 * zsA0 + z1 * zsA1 + (long)pm * BM * lda * 2;
        u.B = B + z0 * zsB0 + z1 * zsB1 + (long)pn * BM * ldb * 2;
        u.lda = lda; u.cha = cha; u.ldb = ldb; u.nt = (kind == K_S5Y) ? 2 + 4 * (pn + 1) : nt; u.kind = kind;
        u.orow = pm * BM + z0 * orz0 + z1 * orz1; u.ocol = pn * BM + z0 * ocz0;
    }
};
__device__ __forceinline__ Desc mk_desc(const void* A, const void* B, int lda, int ldb, int K, int Mrows, int Ncols, int kind) {
    Desc d; d.A = (const char*)A; d.B = (const char*)B; d.lda = lda; d.cha = 16; d.ldb = ldb; d.nt = K / BK; d.nM = Mrows / BM; d.nN = Ncols / BM; d.nZ0 = 1;
    d.zsA0 = d.zsA1 = d.zsB0 = d.zsB1 = 0; d.kind = kind; d.orz0 = d.orz1 = d.ocz0 = 0; return d;
}
__device__ __forceinline__ Desc phase_desc(int ph, int sub, unsigned char* ws) {
    Desc d;
    if (ph == 1) { d = mk_desc(ws + WS_SA, ws + WS_WIN, 1024, 1024, 1024, M_TOK, NIN, K_IN);
    } else if (ph == 2) {
        if (sub == 0) { d = mk_desc(ws + WS_UC + 128 * 2, ws + WS_BT1, 1152, 1152, 1024, 1024, 256, K_S5E); d.nZ0 = 32; d.zsA0 = 1024L * 1152 * 2; d.zsB0 = 128L * 1152 * 2; d.orz0 = 1024; }
        else d = mk_desc(ws + WS_MEMN, ws + WS_WKV, 1152, 1152, 1024, NMEM, 2048, K_KVPROJ);
    } else if (ph == 3) {
        if (sub == 0) { d = mk_desc(ws + WS_KB, ws + WS_WQ, 1024, 1024, 256, 256, 1024, K_MB); d.nZ0 = 4; d.zsA0 = 256 * 2; d.zsA1 = 256L * 1024 * 2; d.zsB0 = 256 * 2; d.orz0 = 256; d.orz1 = 1024; }
        else { d = mk_desc(ws + WS_WO, ws + WS_VB, 1024, 1024, 256, 1024, 256, K_NB); d.nZ0 = 4; d.zsA0 = 256 * 2; d.zsB0 = 256 * 2; d.zsB1 = 256L * 1024 * 2; d.orz1 = 1024; d.ocz0 = 256; }
    } else if (ph == 4) { d = mk_desc(ws + WS_UC, ws + WS_BT2, 1152, 1152, 1152, 1024, 1024, K_S5Y); d.nZ0 = 32; d.zsA0 = 1024L * 1152 * 2; d.zsB0 = 1024L * 1152 * 2; d.orz0 = 1024;
    } else if (ph == 5) { d = mk_desc(ws + WS_U, ws + WS_WGLU, 16, 512, 512, M_TOK, 512, K_GLU); d.cha = M_TOK * 16;
    } else if (ph == 6) { d = mk_desc(ws + WS_SA, ws + WS_WBR, 1024, 1536, 1536, M_TOK, 1024, K_BR);
    } else if (ph == 7) { d = mk_desc(ws + WS_SC, ws + WS_WMIX, 1024, 1024, 1024, M_TOK, 1024, K_MIX);
    } else if (ph == 9) {
        d = mk_desc(ws + WS_SB, ws + WS_MB, 1024, 1024, 1024, SEQ, 1024, K_SMAX); d.zsA1 = (long)SEQ * 1024 * 2; d.zsB1 = 1024L * 1024 * 2; d.orz1 = SEQ;
    } else if (ph == 10) {
        d = mk_desc(ws + WS_SC, ws + WS_NB, 1024, 1024, 1024, SEQ, 1024, K_OPROJ); d.zsA1 = (long)SEQ * 1024 * 2; d.zsB1 = 1024L * 1024 * 2; d.orz1 = SEQ;
    } else if (ph == 14) { d = mk_desc(ws + WS_SA, ws + WS_WGU, 1024, 1024, 1024, M_TOK, 2 * FF, K_GU);
    } else { d = mk_desc(ws + WS_ACT, ws + WS_WDN, FF, FF, FF, M_TOK, 1024, K_DOWN); }
    return d;
}
__device__ __forceinline__ int phase_units(int ph, int sub) {
    switch (ph) {
        case 1: return (M_TOK / BM) * (NIN / BM);
        case 2: return sub == 0 ? 32 * 4 : (sub == 1 ? 128 : 0);
        case 3: return sub < 2 ? 256 : 0;
        case 4: return 32 * 16;
        case 5: return (M_TOK / BM) * 2;
        case 14: return (M_TOK / BM) * (2 * FF / BM);
        default: return (M_TOK / BM) * 4;
    }
}
struct Sched {
    unsigned char* ws; int ph, n0, n1, total, G, c, panel;
    __device__ __forceinline__ bool next(int i, Unit& u) const {
        if (panel >= 0) {
            if (i >= total) return false;
            const Desc d = phase_desc(ph, 0, ws);
            if (ph == 9 || ph == 10) d.fill_pz(panel & 15, i, 0, panel >> 4, u); else d.fill_pz(panel, i, 0, 0, u);
            return true;
        }
        const long L = (long)i * G + c; if (L >= total) return false;
        int wgid = (int)L; { const int q = total / NXCD, r = total % NXCD, xcd = wgid % NXCD, off = wgid / NXCD; wgid = (xcd < r ? xcd * (q + 1) : r * (q + 1) + (xcd - r) * q) + off; }
        int sub = 0; if (wgid >= n0) { sub = 1; wgid -= n0; if (wgid >= n1) { sub = 2; wgid -= n1; } }
        if (ph == 4 && (i & 1)) { const int r = wgid & 15; wgid += ((r & 3) + 4 * (3 - (r >> 2))) - r; }
        const Desc d = phase_desc(ph, sub, ws); d.fill(wgid, u);
        return true;
    }
};
struct Drv { unsigned vA0, vA1, vB0, vB1, kA, hA, hB; };
__device__ __forceinline__ Drv derive(const Unit& u, int tid) {
    int R0, C0, R1, C1; stage_rc(tid * 16, R0, C0); stage_rc(tid * 16 + 8192, R1, C1);
    const int Rb0 = (R0 & ~31) + perm32(R0 & 31), Rb1 = (R1 & ~31) + perm32(R1 & 31);
    Drv d;
    d.vA0 = (unsigned)(R0 * u.lda + (C0 >> 4) * u.cha + (C0 & 15)) * 2u; d.vA1 = (unsigned)(R1 * u.lda + (C1 >> 4) * u.cha + (C1 & 15)) * 2u;
    d.vB0 = (unsigned)(Rb0 * u.ldb + C0) * 2u; d.vB1 = (unsigned)(Rb1 * u.ldb + C1) * 2u;
    d.kA = (unsigned)(8 * u.cha); d.hA = (unsigned)(HALF * 2 * u.lda); d.hB = (unsigned)(HALF * 2 * u.ldb);
    return d;
}

struct Epi {
    unsigned char* ws; LAS unsigned char* lds;
    __device__ __forceinline__ void get8(const f32x4 (&acc)[2][2][4][2], int ai, int bj, int m, float (&v)[8]) const {
        const f32x4 a = acc[ai][bj][m][0], b = acc[ai][bj][m][1];
        v[0] = a[0]; v[1] = a[1]; v[2] = a[2]; v[3] = a[3]; v[4] = b[0]; v[5] = b[1]; v[6] = b[2]; v[7] = b[3];
    }
    __device__ __forceinline__ void mid(f32x4 (&acc)[2][2][4][2], const Unit& u, int wr, int wc, int fr, int fq) const {
        const bf16_t* GA = (const bf16_t*)(ws + WS_SC); const bf16_t* GB = (const bf16_t*)(ws + WS_SD);
        int rb = u.orow + wr * 64 + fr; asm volatile("" : "+v"(rb));
        int cb = u.ocol + wc * 32 + 8 * fq; asm volatile("" : "+v"(cb));
#pragma unroll
        for (int ai = 0; ai < 2; ++ai) {
            u32x4 ga[4][2], gb[4][2];
#pragma unroll
            for (int m = 0; m < 4; ++m)
#pragma unroll
                for (int bj = 0; bj < 2; ++bj) { const size_t o = (size_t)(rb + ai * HALF + m * 16) * DM + cb + bj * HALF; ga[m][bj] = *(const u32x4*)(GA + o); gb[m][bj] = *(const u32x4*)(GB + o); }
#pragma unroll
            for (int m = 0; m < 4; ++m)
#pragma unroll
                for (int bj = 0; bj < 2; ++bj) {
                    float a[8], b[8]; unpack8(ga[m][bj], a); unpack8(gb[m][bj], b);
#pragma unroll
                    for (int j = 0; j < 8; ++j) { const float r = a[j] * __builtin_amdgcn_rcpf(fmaxf(b[j], 1e-30f)); asm volatile("v_mul_f32 %0, %0, %1" : "+v"(acc[ai][bj][m][j >> 2][j & 3]) : "v"(r)); }
                }
            asm volatile("" ::: "memory");
        }
    }
    __device__ __forceinline__ void operator()(const f32x4 (&acc)[2][2][4][2], const Unit& u, int wr, int wc, int fr, int fq) const {
        const int kind = u.kind;
        if (kind == K_SMAX) {
            LAS f32x2* XS = (LAS f32x2*)(lds + LDS_XS);
            int rls = wr * 64 + fr; asm volatile("" : "+v"(rls));
            bf16_t* P = (bf16_t*)(ws + WS_SC); const float* RS = (const float*)(ws + WS_RS1);
            int rbs = u.orow + wr * 64 + fr; asm volatile("" : "+v"(rbs));
            float rsv[2][4];
#pragma unroll
            for (int ai = 0; ai < 2; ++ai)
#pragma unroll
                for (int m = 0; m < 4; ++m) rsv[ai][m] = RS[rbs + ai * HALF + m * 16] * 1.4426950408889634f;
#pragma unroll
            for (int ai = 0; ai < 2; ++ai)
#pragma unroll
                for (int m = 0; m < 4; ++m) {
                    const float rs = rsv[ai][m];
                    float mx = -3.0e38f;
#pragma unroll
                    for (int bj = 0; bj < 2; ++bj)
#pragma unroll
                        for (int n = 0; n < 2; ++n)
#pragma unroll
                            for (int j = 0; j < 4; ++j) mx = fmaxf(mx, acc[ai][bj][m][n][j]);
                    mx = fmaxf(mx, shx(mx, fr + 16 * fq, 16)); mx = fmaxf(mx, shx(mx, fr + 16 * fq, 32));
                    float s = 0.f;
#pragma unroll
                    for (int bj = 0; bj < 2; ++bj)
#pragma unroll
                        for (int n = 0; n < 2; ++n)
#pragma unroll
                            for (int j = 0; j < 4; ++j) s += __builtin_amdgcn_exp2f((acc[ai][bj][m][n][j] - mx) * rs);
                    s += shx(s, fr + 16 * fq, 16); s += shx(s, fr + 16 * fq, 32);
                    if (fq == 0) XS[(rls + ai * HALF + m * 16) * 4 + wc] = (f32x2){mx * rs, s};
                }
            asm volatile("s_waitcnt lgkmcnt(0)" ::: "memory"); __builtin_amdgcn_s_barrier(); asm volatile("" ::: "memory");
#pragma unroll
            for (int ai = 0; ai < 2; ++ai)
#pragma unroll
                for (int m = 0; m < 4; ++m) {
                    const int rl = rls + ai * HALF + m * 16;
                    const f32x2 p0 = XS[rl * 4 + 0], p1 = XS[rl * 4 + 1], p2 = XS[rl * 4 + 2], p3 = XS[rl * 4 + 3];
                    const f32x2 me = XS[rl * 4 + wc];
                    const float MX = fmaxf(fmaxf(p0.x, p1.x), fmaxf(p2.x, p3.x));
                    const float L = p0.y * __builtin_amdgcn_exp2f(p0.x - MX) + p1.y * __builtin_amdgcn_exp2f(p1.x - MX) + p2.y * __builtin_amdgcn_exp2f(p2.x - MX) + p3.y * __builtin_amdgcn_exp2f(p3.x - MX);
                    const float f = 1.0f / L; (void)me;
                    const size_t row = (size_t)(u.orow + rl);
                    const float rs = rsv[ai][m];
#pragma unroll
                    for (int bj = 0; bj < 2; ++bj) {
                        float v[8]; get8(acc, ai, bj, m, v);
#pragma unroll
                        for (int j = 0; j < 8; ++j) v[j] = __builtin_amdgcn_exp2f(v[j] * rs - MX) * f;
                        *(u32x4*)(P + row * DM + u.ocol + bj * HALF + wc * 32 + 8 * fq) = pack8(v);
                    }
                }
            asm volatile("s_waitcnt lgkmcnt(0)" ::: "memory"); __builtin_amdgcn_s_barrier(); asm volatile("" ::: "memory");
            return;
        }
        if (kind == K_GU) {
            bf16_t* ACT = (bf16_t*)(ws + WS_ACT);
            int rb = u.orow + wr * 64 + fr; asm volatile("" : "+v"(rb));
            float rsv[2][4];
#pragma unroll
            for (int ai = 0; ai < 2; ++ai)
#pragma unroll
                for (int m = 0; m < 4; ++m) rsv[ai][m] = ((const float*)(ws + WS_RS2))[rb + ai * HALF + m * 16];
#pragma unroll
            for (int ai = 0; ai < 2; ++ai)
#pragma unroll
                for (int m = 0; m < 4; ++m) {
                    const size_t row = (size_t)(rb + ai * HALF + m * 16);
                    const float rs = rsv[ai][m];
                    float g[8], w[8]; get8(acc, ai, 0, m, g); get8(acc, ai, 1, m, w);
#pragma unroll
                    for (int j = 0; j < 8; ++j) { const float gg = g[j] * rs; g[j] = gg * fsigmoid(gg) * (w[j] * rs); }
                    *(u32x4*)(ACT + row * FF + u.pn * HALF + wc * 32 + 8 * fq) = pack8(g);
                }
            return;
        }
        if (kind == K_S5E) {
            float* E = (float*)(ws + WS_EBUF);
            int rb = u.orow + wr * 64 + fr; asm volatile("" : "+v"(rb));
            int cb = wc * 32 + 8 * fq; asm volatile("" : "+v"(cb));
#pragma unroll
            for (int ai = 0; ai < 2; ++ai)
#pragma unroll
                for (int m = 0; m < 4; ++m) {
                    const size_t row = (size_t)(rb + ai * HALF + m * 16);
                    float* p = E + row * 128 + cb;
                    *(f32x4*)p = acc[ai][0][m][0]; *(f32x4*)(p + 4) = acc[ai][0][m][1];
                }
            return;
        }
        if (kind == K_IN) {
            const int pn = u.pn;
            if (pn < 4) tiles<1>(acc, u.orow, wr, wc, fr, fq, (bf16_t*)(ws + WS_U), DM, pn * BM, nullptr);
            else if (pn < 8) tiles<7>(acc, u.orow, wr, wc, fr, fq, (bf16_t*)(ws + WS_V), DM, (pn & 3) * BM, (const bf16_t*)(ws + WS_VST));
            else if (pn < 10) tiles<3>(acc, u.orow, wr, wc, fr, fq, (bf16_t*)(ws + WS_UC), 0, (pn - 8) * BM, nullptr);
            else tiles<2>(acc, u.orow, wr, wc, fr, fq, (bf16_t*)(ws + (pn < 14 ? WS_SC : WS_SD)), DM, ((pn - 10) & 3) * BM, nullptr);
        } else if (kind == K_KVPROJ) tiles<0>(acc, u.orow, wr, wc, fr, fq, (bf16_t*)(ws + (u.pn < 4 ? WS_KB : WS_VB)), DM, (u.pn & 3) * BM, nullptr);
        else if (kind == K_MB) tiles<6>(acc, u.orow, wr, wc, fr, fq, (bf16_t*)(ws + WS_MB), DM, u.ocol, nullptr);
        else if (kind == K_NB) tiles<0>(acc, u.orow, wr, wc, fr, fq, (bf16_t*)(ws + WS_NB), DM, u.ocol, nullptr);
        else if (kind == K_S5Y) tiles<1>(acc, u.orow, wr, wc, fr, fq, (bf16_t*)(ws + WS_U), 1024, u.ocol, nullptr);
        else if (kind == K_GLU) tiles<4>(acc, u.orow, wr, wc, fr, fq, (bf16_t*)(ws + WS_SB), DM, u.ocol, (const bf16_t*)(ws + WS_U));
        else if (kind == K_BR) tiles<5>(acc, u.orow, wr, wc, fr, fq, (bf16_t*)(ws + WS_SC), DM, u.ocol, (const bf16_t*)(ws + WS_SD));
        else if (kind == K_MIX) tiles<0>(acc, u.orow, wr, wc, fr, fq, (bf16_t*)(ws + WS_SA), DM, u.ocol, nullptr);
        else if (kind == K_OPROJ) tiles<0>(acc, u.orow, wr, wc, fr, fq, (bf16_t*)(ws + WS_SD), DM, u.ocol, nullptr);
        else tiles<0>(acc, u.orow, wr, wc, fr, fq, (bf16_t*)(ws + WS_SC), DM, u.ocol, nullptr);
    }
    template <int MODE>
    __device__ __forceinline__ void tiles(const f32x4 (&acc)[2][2][4][2], int orow, int wr, int wc, int fr, int fq, bf16_t* base, int ld, int colbase, const bf16_t* aux) const {
        int rb = orow + wr * 64 + fr; asm volatile("" : "+v"(rb));
        int cb = colbase + wc * 32 + 8 * fq; asm volatile("" : "+v"(cb));
#pragma unroll
        for (int ai = 0; ai < 2; ++ai) {
            u32x4 ax[4][2];
            if (MODE == 4 || MODE == 5) {
#pragma unroll
                for (int m = 0; m < 4; ++m)
#pragma unroll
                    for (int bj = 0; bj < 2; ++bj) {
                        const size_t row = (size_t)(rb + ai * HALF + m * 16); const int col = cb + bj * HALF;
                        if (MODE == 4) ax[m][bj] = *(const u32x4*)(aux + ((size_t)(col >> 4) * M_TOK + row) * 16 + (col & 15));
                        else ax[m][bj] = *(const u32x4*)(aux + row * DM + col);
                    }
            }
#pragma unroll
            for (int m = 0; m < 4; ++m) {
                const int rowi = rb + ai * HALF + m * 16; const size_t row = (size_t)rowi;
                float st1 = 0.f, st2 = 0.f;
#pragma unroll
                for (int bj = 0; bj < 2; ++bj) {
                    const int col = cb + bj * HALF;
                    float v[8]; get8(acc, ai, bj, m, v);
                    bf16_t* dst = base + row * ld + col;
                    if (MODE == 1 || MODE == 7) {
#pragma unroll
                        for (int j = 0; j < 8; ++j) v[j] = gelu_t(v[j]);
                        if (MODE == 7) {
#pragma unroll
                            for (int j = 0; j < 8; ++j) { st1 += v[j]; st2 += v[j] * v[j]; }
                        }
                    } else if (MODE == 2) {
#pragma unroll
                        for (int j = 0; j < 8; ++j) v[j] = fsigmoid(v[j]);
                    } else if (MODE == 3) {
                        const int g = col >> 4, h0 = col & 15;
                        dst = base + ((size_t)(g * 1024 + (rowi >> 6))) * 1152 + 128 + (rowi & 63) * 16 + h0;
                    } else if (MODE == 4) {
                        float y[8]; unpack8(ax[m][bj], y);
#pragma unroll
                        for (int j = 0; j < 8; ++j) v[j] = y[j] * fsigmoid(v[j]);
                    } else if (MODE == 5) {
                        float b[8]; unpack8(ax[m][bj], b);
#pragma unroll
                        for (int j = 0; j < 8; ++j) v[j] *= b[j];
                    } else if (MODE == 6) {
#pragma unroll
                        for (int j = 0; j < 8; ++j) v[j] *= 0.0625f;
                    }
                    *(u32x4*)dst = pack8(v);
                }
                if (MODE == 7) {
                    st1 += shx(st1, fr + 16 * fq, 16); st1 += shx(st1, fr + 16 * fq, 32); st2 += shx(st2, fr + 16 * fq, 16); st2 += shx(st2, fr + 16 * fq, 32);
                    if (fq == 0) ((f32x2*)aux)[row * 16 + (colbase >> 8) * 4 + wc] = (f32x2){st1, st2};
                }
                if (MODE != 4 && MODE != 5) asm volatile("" ::: "memory");
            }
            asm volatile("" ::: "memory");
        }
    }
};

__device__ __forceinline__ void gemm_phase(LAS unsigned char* lds, const Sched& S, const Epi& E, const int tid) {
    const int wid = __builtin_amdgcn_readfirstlane(tid >> 6), lane = tid & 63, wr = wid >> 2, wc = wid & 3, fr = lane & 15, fq = lane >> 4;
    const unsigned ldsw = (unsigned)wid * 1024u;
    const int aoff = lds_byte(wr * 64 + fr, fq * 8), boff = lds_byte(wc * 32 + fr, fq * 8);
#define PG8_SA(b, h) (((b) * 2 + (h)) * HTB)
#define PG8_SB(b, h) ((4 + (b) * 2 + (h)) * HTB)
#define PG8_STAGE(bufoff, gbase, v0, v1) do { \
        __builtin_amdgcn_global_load_lds((const unsigned*)((const char*)(gbase) + (v0)), (LAS unsigned*)(lds + (bufoff) + ldsw), 16, 0, 0); \
        __builtin_amdgcn_global_load_lds((const unsigned*)((const char*)(gbase) + (v1)), (LAS unsigned*)(lds + (bufoff) + ldsw + 8192), 16, 0, 0); } while (0)
#define PG8_LDA(dst, b, h) do { _Pragma("unroll") for (int m = 0; m < 4; ++m) _Pragma("unroll") for (int k = 0; k < 2; ++k) dst[m][k] = *(const LAS bf16x8*)(lds + PG8_SA(b, h) + aoff + m * 2048 + k * 1024); } while (0)
#define PG8_LDB(dst, b, h) do { _Pragma("unroll") for (int n = 0; n < 2; ++n) _Pragma("unroll") for (int k = 0; k < 2; ++k) dst[n][k] = *(const LAS bf16x8*)(lds + PG8_SB(b, h) + boff + n * 2048 + k * 1024); } while (0)
#define PG8_MMA(ai, bj, At, Bt) do { __builtin_amdgcn_s_setprio(1); _Pragma("unroll") for (int m = 0; m < 4; ++m) _Pragma("unroll") for (int n = 0; n < 2; ++n) _Pragma("unroll") for (int k = 0; k < 2; ++k) \
        acc[ai][bj][m][n] = __builtin_amdgcn_mfma_f32_16x16x32_bf16(Bt[n][k], At[m][k], acc[ai][bj][m][n], 0, 0, 0); __builtin_amdgcn_s_setprio(0); } while (0)
#define PG8_WAIT_V(n) asm volatile("s_waitcnt vmcnt(" #n ")" ::: "memory")
#define PG8_WAIT_L(n) asm volatile("s_waitcnt lgkmcnt(" #n ")" ::: "memory")
#define PG8_BAR __builtin_amdgcn_s_barrier()
#define PG8_SCHED __builtin_amdgcn_sched_barrier(0)
    Unit cur, nxt; int ui = 0;
    if (!S.next(0, cur)) return;
    nxt = cur;
    f32x4 acc[2][2][4][2];
#pragma unroll
    for (int a = 0; a < 2; ++a)
#pragma unroll
        for (int b = 0; b < 2; ++b)
#pragma unroll
            for (int m = 0; m < 4; ++m)
#pragma unroll
                for (int n = 0; n < 2; ++n) acc[a][b][m][n] = (f32x4){0.f, 0.f, 0.f, 0.f};
    bf16x8 At[4][2], B0[2][2], B1[2][2];
    const Drv dc = derive(cur, tid);
    const char* cA = cur.A; const char* cB = cur.B;
    PG8_STAGE(PG8_SB(0, 0), cB, dc.vB0, dc.vB1); PG8_STAGE(PG8_SB(0, 1), cB + dc.hB, dc.vB0, dc.vB1); PG8_STAGE(PG8_SA(0, 0), cA, dc.vA0, dc.vA1); PG8_STAGE(PG8_SA(0, 1), cA + dc.hA, dc.vA0, dc.vA1);
    if (wr == 1) PG8_BAR;
    PG8_WAIT_V(2); PG8_BAR;
    PG8_STAGE(PG8_SB(1, 0), cB + 128, dc.vB0, dc.vB1); PG8_STAGE(PG8_SA(1, 0), cA + dc.kA, dc.vA0, dc.vA1); PG8_STAGE(PG8_SB(1, 1), cB + dc.hB + 128, dc.vB0, dc.vB1);
    PG8_WAIT_V(6); PG8_BAR;
    for (;;) {
        const bool has_next = S.next(ui + 1, nxt);
        const char* nA = cA; const char* nB = cB;
        if (has_next) { nA = nxt.A; nB = nxt.B; }
        const int nt = cur.nt;
        for (int t = 0; t < nt; t += 2) {
            const bool last = (t == nt - 2);
            if (cur.kind == K_BR && t == 16) E.mid(acc, cur, wr, wc, fr, fq);
            const size_t aj = (cur.kind == K_BR) ? (size_t)(WS_SB - WS_SA) - 16 * 128 : 0;
            const char* a1 = cA + (size_t)(t + 1) * dc.kA + (t >= 16 ? aj : 0);
            const char* a2 = last ? nA : cA + (size_t)(t + 2) * dc.kA + (t >= 14 ? aj : 0); const char* b2 = last ? nB : cB + (size_t)(t + 2) * 128;
            const unsigned xA0 = dc.vA0, xA1 = dc.vA1, xB0 = dc.vB0, xB1 = dc.vB1, xk = dc.kA, xhA = dc.hA, xhB = dc.hB;
            const char* a3 = a2 + xk; const char* b3 = b2 + 128;
            PG8_LDB(B0, 0, 0); PG8_LDB(B1, 0, 1); PG8_SCHED; PG8_LDA(At, 0, 0); PG8_STAGE(PG8_SA(1, 1), a1 + dc.hA, dc.vA0, dc.vA1);
            PG8_WAIT_V(8); PG8_WAIT_L(0); PG8_BAR; PG8_MMA(0, 0, At, B0); PG8_MMA(0, 1, At, B1); PG8_BAR; PG8_SCHED;
            PG8_LDA(At, 0, 1); PG8_STAGE(PG8_SB(0, 0), b2, xB0, xB1); PG8_STAGE(PG8_SB(0, 1), b2 + xhB, xB0, xB1); PG8_STAGE(PG8_SA(0, 0), a2, xA0, xA1);
            PG8_WAIT_V(8); PG8_WAIT_L(0); PG8_BAR; PG8_MMA(1, 0, At, B0); PG8_MMA(1, 1, At, B1); PG8_BAR; PG8_SCHED;
            PG8_LDB(B0, 1, 0); PG8_LDB(B1, 1, 1); PG8_SCHED; PG8_LDA(At, 1, 0); PG8_STAGE(PG8_SA(0, 1), a2 + xhA, xA0, xA1);
            PG8_WAIT_V(8); PG8_WAIT_L(0); PG8_BAR; PG8_MMA(0, 0, At, B0); PG8_MMA(0, 1, At, B1); PG8_BAR; PG8_SCHED;
            PG8_LDA(At, 1, 1); PG8_STAGE(PG8_SB(1, 0), b3, xB0, xB1); PG8_STAGE(PG8_SB(1, 1), b3 + xhB, xB0, xB1); PG8_STAGE(PG8_SA(1, 0), a3, xA0, xA1);
            PG8_WAIT_V(8); PG8_WAIT_L(0); PG8_BAR; PG8_MMA(1, 0, At, B0); PG8_MMA(1, 1, At, B1); PG8_BAR; PG8_SCHED;
        }
        if (wr == 0) PG8_BAR;
        E(acc, cur, wr, wc, fr, fq);
        if (!has_next) break;
#pragma unroll
        for (int a = 0; a < 2; ++a)
#pragma unroll
            for (int b = 0; b < 2; ++b)
#pragma unroll
                for (int m = 0; m < 4; ++m)
#pragma unroll
                    for (int n = 0; n < 2; ++n) acc[a][b][m][n] = (f32x4){0.f, 0.f, 0.f, 0.f};
        cur = nxt; cA = nA; cB = nB; ++ui;
        if (wr == 1) PG8_BAR;
    }
    PG8_WAIT_V(0);
    PG8_BAR;
#undef PG8_SA
#undef PG8_SB
#undef PG8_STAGE
#undef PG8_LDA
#undef PG8_LDB
#undef PG8_MMA
#undef PG8_WAIT_V
#undef PG8_WAIT_L
#undef PG8_BAR
#undef PG8_SCHED
}
}

__device__ __forceinline__ void transpose_item(const float* W, int N, bf16_t* WT, int ldt, int col_off, int rmode, LAS float* scr, int item, int lane, const float* kscale = nullptr) {
    const int nblk = N / 32, kb = item / nblk, nb = item % nblk, k0 = 64 * kb, n0 = 32 * nb;
    f32x4 wv[8];
#pragma unroll
    for (int i = 0; i < 8; ++i) { wv[i] = *(const f32x4*)(W + (size_t)(k0 + 8 * i + (lane >> 3)) * N + n0 + 4 * (lane & 7)); if (kscale) wv[i] = wv[i] * kscale[k0 + 8 * i + (lane >> 3)]; }
#pragma unroll
    for (int i = 0; i < 8; ++i) { LAS float* d = scr + (8 * i + (lane >> 3)) * 33 + 4 * (lane & 7); d[0] = wv[i][0]; d[1] = wv[i][1]; d[2] = wv[i][2]; d[3] = wv[i][3]; }
    asm volatile("s_waitcnt lgkmcnt(0)" ::: "memory");
    int r0 = n0;
    if (rmode == 1) { const int isu = n0 >= FF, nn = isu ? n0 - FF : n0; r0 = 256 * (nn >> 7) + (nn & 127) + (isu ? 128 : 0); }
    const int c = lane & 7;
#pragma unroll
    for (int j = 0; j < 4; ++j) { const int n = (lane >> 3) + 8 * j; const LAS float* s = scr + (8 * c) * 33 + n;
        u32x4 o; o.x = cvt_pk_bf16(s[0 * 33], s[1 * 33]); o.y = cvt_pk_bf16(s[2 * 33], s[3 * 33]); o.z = cvt_pk_bf16(s[4 * 33], s[5 * 33]); o.w = cvt_pk_bf16(s[6 * 33], s[7 * 33]);
        *(u32x4*)(WT + (size_t)(r0 + n) * ldt + col_off + k0 + 8 * c) = o; }
    asm volatile("s_waitcnt lgkmcnt(0)" ::: "memory");
}
template <int R>
__device__ __forceinline__ void rms_rows_to_bf16(const float* x0, size_t xstride, const float* g, bf16_t* o0, size_t ostride, int lane) {
    f32x4 v[R][4]; float s[R];
#pragma unroll
    for (int r = 0; r < R; ++r)
#pragma unroll
        for (int j = 0; j < 2; ++j) { v[r][2 * j] = *(const f32x4*)(x0 + r * xstride + 512 * j + 8 * lane); v[r][2 * j + 1] = *(const f32x4*)(x0 + r * xstride + 512 * j + 8 * lane + 4); }
#pragma unroll
    for (int r = 0; r < R; ++r) { s[r] = 0.f;
#pragma unroll
        for (int j = 0; j < 4; ++j) s[r] += (v[r][j][0] * v[r][j][0] + v[r][j][1] * v[r][j][1]) + (v[r][j][2] * v[r][j][2] + v[r][j][3] * v[r][j][3]); }
#pragma unroll
    for (int o = 1; o < 64; o <<= 1)
#pragma unroll
        for (int r = 0; r < R; ++r) s[r] += shx(s[r], lane, o);
    f32x4 gg[4];
#pragma unroll
    for (int j = 0; j < 2; ++j) { gg[2 * j] = *(const f32x4*)(g + 512 * j + 8 * lane); gg[2 * j + 1] = *(const f32x4*)(g + 512 * j + 8 * lane + 4); }
#pragma unroll
    for (int r = 0; r < R; ++r) {
        const float rstd = 1.f / sqrtf(s[r] * (1.f / DM) + EPS);
#pragma unroll
        for (int j = 0; j < 2; ++j) {
            const f32x4 a = v[r][2 * j] * rstd * gg[2 * j], b = v[r][2 * j + 1] * rstd * gg[2 * j + 1];
            u32x4 w; w.x = cvt_pk_bf16(a[0], a[1]); w.y = cvt_pk_bf16(a[2], a[3]); w.z = cvt_pk_bf16(b[0], b[1]); w.w = cvt_pk_bf16(b[2], b[3]);
            *(u32x4*)(o0 + r * ostride + 512 * j + 8 * lane) = w;
        }
    }
}
template <bool XIN_BF, bool XOUT_BF>
__device__ __forceinline__ void rowpass(const bf16_t* m, const float* gpost, const void* xin_, void* xout_, const float* gpre, bf16_t* hout, float* rsout, int gw, int NGW, int lane, int row_end) {
    constexpr int R = 4;
    const float* xin = (const float*)xin_; const bf16_t* xinb = (const bf16_t*)xin_; float* xout = (float*)xout_; bf16_t* xoutb = (bf16_t*)xout_;
    for (int row0 = gw; row0 < row_end; row0 += R * NGW) {
        u32x4 mw[R][2]; f32x4 xv[R][4]; u32x4 xw[R][2];
#pragma unroll
        for (int r = 0; r < R; ++r) { const size_t ro = (size_t)(row0 + r * NGW) * DM;
#pragma unroll
            for (int j = 0; j < 2; ++j) { mw[r][j] = *(const u32x4*)(m + ro + 512 * j + 8 * lane);
                if (XIN_BF) xw[r][j] = *(const u32x4*)(xinb + ro + 512 * j + 8 * lane);
                else { xv[r][2 * j] = *(const f32x4*)(xin + ro + 512 * j + 8 * lane); xv[r][2 * j + 1] = *(const f32x4*)(xin + ro + 512 * j + 8 * lane + 4); } } }
        f32x4 gp[4];
#pragma unroll
        for (int j = 0; j < 2; ++j) { gp[2 * j] = *(const f32x4*)(gpost + 512 * j + 8 * lane); gp[2 * j + 1] = *(const f32x4*)(gpost + 512 * j + 8 * lane + 4); }
        float mv[R][2][8]; float ss[R];
#pragma unroll
        for (int r = 0; r < R; ++r) { ss[r] = 0.f;
#pragma unroll
            for (int j = 0; j < 2; ++j) { unpack8(mw[r][j], mv[r][j]);
#pragma unroll
                for (int i = 0; i < 8; ++i) ss[r] += mv[r][j][i] * mv[r][j][i]; } }
#pragma unroll
        for (int o = 1; o < 64; o <<= 1)
#pragma unroll
            for (int r = 0; r < R; ++r) ss[r] += shx(ss[r], lane, o);
        float x1[R][2][8]; float s2[R];
#pragma unroll
        for (int r = 0; r < R; ++r) {
            const size_t ro = (size_t)(row0 + r * NGW) * DM;
            const float rstd = 1.f / sqrtf(ss[r] * (1.f / DM) + EPS); s2[r] = 0.f;
#pragma unroll
            for (int j = 0; j < 2; ++j) {
                const int c = 512 * j + 8 * lane;
                float xi[8];
                if (XIN_BF) unpack8(xw[r][j], xi);
                else {
#pragma unroll
                    for (int i = 0; i < 4; ++i) { xi[i] = xv[r][2 * j][i]; xi[4 + i] = xv[r][2 * j + 1][i]; }
                }
#pragma unroll
                for (int i = 0; i < 4; ++i) { x1[r][j][i] = xi[i] + mv[r][j][i] * rstd * gp[2 * j][i]; x1[r][j][4 + i] = xi[4 + i] + mv[r][j][4 + i] * rstd * gp[2 * j + 1][i]; }
#pragma unroll
                for (int i = 0; i < 8; ++i) s2[r] += x1[r][j][i] * x1[r][j][i];
                if (XOUT_BF) *(u32x4*)(xoutb + ro + c) = pack8(x1[r][j]);
                else { *(f32x4*)(xout + ro + c) = (f32x4){x1[r][j][0], x1[r][j][1], x1[r][j][2], x1[r][j][3]}; *(f32x4*)(xout + ro + c + 4) = (f32x4){x1[r][j][4], x1[r][j][5], x1[r][j][6], x1[r][j][7]}; }
            }
        }
        if (hout || rsout) {
#pragma unroll
            for (int o = 1; o < 64; o <<= 1)
#pragma unroll
                for (int r = 0; r < R; ++r) s2[r] += shx(s2[r], lane, o);
        }
        if (rsout) {
#pragma unroll
            for (int r = 0; r < R; ++r) if (lane == 0) rsout[row0 + r * NGW] = 1.f / sqrtf(s2[r] * (1.f / DM) + EPS);
        }
        if (hout) {
#pragma unroll
            for (int j = 0; j < 2; ++j) { gp[2 * j] = *(const f32x4*)(gpre + 512 * j + 8 * lane); gp[2 * j + 1] = *(const f32x4*)(gpre + 512 * j + 8 * lane + 4); }
#pragma unroll
            for (int r = 0; r < R; ++r) {
                const size_t ro = (size_t)(row0 + r * NGW) * DM;
                const float r2 = 1.f / sqrtf(s2[r] * (1.f / DM) + EPS);
#pragma unroll
                for (int j = 0; j < 2; ++j) {
                    float h[8];
#pragma unroll
                    for (int i = 0; i < 4; ++i) { h[i] = x1[r][j][i] * r2 * gp[2 * j][i]; h[4 + i] = x1[r][j][4 + i] * r2 * gp[2 * j + 1][i]; }
                    *(u32x4*)(hout + ro + 512 * j + 8 * lane) = pack8(h);
                }
            }
        }
    }
}

__device__ __forceinline__ void s5_build(LAS unsigned char* lds, unsigned char* ws, const float* lam_re, const float* lam_im, const float* log_step, const float* b_re,
                                         const float* b_im, const float* c_re, const float* c_im, const float* dvec, int g, int tid) {
    LAS f32x2* AP = (LAS f32x2*)lds;
    LAS f32x2* BB = (LAS f32x2*)(lds + 33280);
    LAS f32x2* CC = (LAS f32x2*)(lds + 41472);
    LAS float* KT = (LAS float*)(lds + 49664);
    const float step = expf(log_step[g]);
    for (int i = tid; i < 64 * 65; i += 512) {
        const int p = i / 65, tau = i % 65;
        const float lr = lam_re[g * 64 + p], li = lam_im[g * 64 + p];
        const float mag = expf(lr * step * (float)tau);
        const double ang = (double)li * (double)step * (double)tau;
        const double kq = rint(ang * 0.15915494309189535);
        const float r = (float)(ang - kq * 6.283185307179586);
        AP[p * 65 + tau] = (f32x2){mag * cosf(r), mag * sinf(r)};
    }
    for (int i = tid; i < 64 * 16; i += 512) {
        const int p = i >> 4, h = i & 15;
        const float lr = lam_re[g * 64 + p], li = lam_im[g * 64 + p];
        const float x = lr * step, mag = expf(x), em1 = expm1f(x);
        const double ang = (double)li * (double)step; const double kq = rint(ang * 0.15915494309189535);
        const float r = (float)(ang - kq * 6.283185307179586);
        const float sh = sinf(0.5f * r), cm1 = -2.f * sh * sh, sn = sinf(r), cs = 1.f + cm1;
        const float nr = em1 * cs + cm1, ni = mag * sn;
        const float den = lr * lr + li * li;
        const float co_re = (nr * lr + ni * li) / den, co_im = (ni * lr - nr * li) / den;
        const float br = b_re[(g * 64 + p) * 16 + h], bi = b_im[(g * 64 + p) * 16 + h];
        BB[p * 16 + h] = (f32x2){co_re * br - co_im * bi, co_re * bi + co_im * br};
        const int hh = i >> 6, pp = i & 63;
        CC[hh * 64 + pp] = (f32x2){c_re[(g * 16 + hh) * 64 + pp], c_im[(g * 16 + hh) * 64 + pp]};
    }
    __syncthreads();
    for (int it = 0; it < 2; ++it) {
        const int tau = tid & 63, hp = (tid >> 6) + 8 * it;
        float a[16];
#pragma unroll
        for (int h = 0; h < 16; ++h) a[h] = 0.f;
        for (int p = 0; p < 64; ++p) {
            const f32x2 c = CC[hp * 64 + p], ap = AP[p * 65 + tau];
            const float xr = c.x * ap.x - c.y * ap.y, xi = c.x * ap.y + c.y * ap.x;
#pragma unroll
            for (int h = 0; h < 16; ++h) { const f32x2 b = BB[p * 16 + h]; a[h] += xr * b.x - xi * b.y; }
        }
        if (tau == 0) {
#pragma unroll
            for (int h = 0; h < 16; ++h) if (h == hp) a[h] += dvec[g * 16 + hp];
        }
#pragma unroll
        for (int h = 0; h < 16; ++h) KT[tau * KTS + hp * 16 + h] = a[h];
    }
    __syncthreads();
    { const LAS f32x4* src = (const LAS f32x4*)lds; f32x4* dst = (f32x4*)(ws + WS_S5T + (size_t)g * S5T_BYTES);
      for (int i = tid; i < S5T_BYTES / 16; i += 512) dst[i] = src[i]; }
    if (tid < 64) ((f32x2*)(ws + WS_A64))[g * 64 + tid] = AP[tid * 65 + 64];
    __syncthreads();
}
__device__ __forceinline__ void s5_expand(LAS unsigned char* lds, unsigned char* ws, int g, int part, int tid) {
    LAS f32x2* AP = (LAS f32x2*)lds; LAS f32x2* BB = (LAS f32x2*)(lds + 33280); LAS f32x2* CC = (LAS f32x2*)(lds + 41472); LAS float* KT = (LAS float*)(lds + 49664);
    { const f32x4* src = (const f32x4*)(ws + WS_S5T + (size_t)g * S5T_BYTES); LAS f32x4* dst = (LAS f32x4*)lds;
      for (int i = tid; i < S5T_BYTES / 16; i += 512) dst[i] = src[i]; }
    __syncthreads();
    bf16_t* BT2 = (bf16_t*)(ws + WS_BT2) + (size_t)g * 1024 * 1152;
    for (int i = tid; i < 128 * 144; i += 512) {
        const int rl = i / 144, cc = i % 144, t = 8 * part + (rl >> 4), hp = rl & 15;
        float v[8];
        if (cc >= 16) {
            const int s = (cc - 16) >> 1, h0 = (cc & 1) * 8;
            if (s >= 16 * ((t >> 4) + 1)) continue;
            if (s <= t) {
#pragma unroll
                for (int j = 0; j < 8; ++j) v[j] = KT[(t - s) * KTS + hp * 16 + h0 + j];
            } else {
#pragma unroll
                for (int j = 0; j < 8; ++j) v[j] = 0.f;
            }
        } else {
            const int p0 = cc * 4;
#pragma unroll
            for (int j = 0; j < 4; ++j) { const f32x2 c = CC[hp * 64 + p0 + j], ap = AP[(p0 + j) * 65 + t + 1];
                v[2 * j] = c.x * ap.x - c.y * ap.y; v[2 * j + 1] = -(c.x * ap.y + c.y * ap.x); }
        }
        *(u32x4*)(BT2 + (size_t)(t * 16 + hp) * 1152 + cc * 8) = pack8(v);
    }
    bf16_t* BT1 = (bf16_t*)(ws + WS_BT1) + (size_t)g * 128 * 1152;
    for (int i = tid; i < 16 * 128; i += 512) {
        const int rl = i >> 7, cc = i & 127, p = 8 * part + (rl >> 1), ri = rl & 1, s = cc >> 1, h0 = (cc & 1) * 8;
        const f32x2 ap = AP[p * 65 + 63 - s];
        float v[8];
#pragma unroll
        for (int j = 0; j < 8; ++j) { const f32x2 b = BB[p * 16 + h0 + j]; v[j] = ri ? (ap.x * b.y + ap.y * b.x) : (ap.x * b.x - ap.y * b.y); }
        *(u32x4*)(BT1 + (size_t)(2 * p + ri) * 1152 + cc * 8) = pack8(v);
    }
    __syncthreads();
}

__device__ __forceinline__ void spatial_phase(LAS unsigned char* lds, unsigned char* ws, const float* ln_g, const float* ln_b, const float* b_s, int vcu, int G, const int tid) {
    __syncthreads();
    const int wid = __builtin_amdgcn_readfirstlane(tid >> 6), lane = tid & 63, fr = lane & 15, fq = lane >> 4;
    LAS f32x2* ST = (LAS f32x2*)lds;
    LAS bf16_t* VT = (LAS bf16_t*)(lds + 1024);
    LAS float* LG = (LAS float*)(lds + 36864);
    LAS float* LB = (LAS float*)(lds + 40960);
    const bf16_t* U = (const bf16_t*)(ws + WS_U); const bf16_t* V = (const bf16_t*)(ws + WS_V); bf16_t* YC = (bf16_t*)(ws + WS_SA);
    const bf16_t* WSP = (const bf16_t*)(ws + WS_WSP);
    for (int i = tid; i < 1024; i += 512) { LG[i] = ln_g[i]; LB[i] = ln_b[i]; }
    const int kmax = (16 * wid + 15) >> 5, t = 16 * wid + fr;
    for (int unit = vcu; unit < M_TOK / 128; unit += G) {
        const size_t r0 = (size_t)unit * 128;
        u32x4 vreg[4];
#pragma unroll
        for (int it = 0; it < 4; ++it) { const int idx = wid * 4 + it, s = (idx & 1) * 64 + lane, c0 = (idx >> 1) * 8; vreg[it] = *(const u32x4*)(V + (r0 + s) * DM + c0); }
        {
            const f32x4* pv = (const f32x4*)((const float*)(ws + WS_VST) + ((r0 + 16 * wid + (lane >> 2)) * 16 + 4 * (lane & 3)) * 2);
            const f32x4 p0 = pv[0], p1 = pv[1];
            float s1 = (p0[0] + p0[2]) + (p1[0] + p1[2]), s2 = (p0[1] + p0[3]) + (p1[1] + p1[3]);
            s1 += shx(s1, lane, 1); s1 += shx(s1, lane, 2); s2 += shx(s2, lane, 1); s2 += shx(s2, lane, 2);
            const float mean = s1 * (1.f / DM), var = fmaxf(s2 * (1.f / DM) - mean * mean, 0.f);
            if ((lane & 3) == 0) ST[16 * wid + (lane >> 2)] = (f32x2){mean, 1.f / sqrtf(var + EPS)};
        }
        __syncthreads();
        for (int g = 0; g < 8; ++g) {
#pragma unroll
            for (int it = 0; it < 4; ++it) {
                const int idx = wid * 4 + it, s = (idx & 1) * 64 + lane, c0 = (idx >> 1) * 8;
                float v[8]; unpack8(vreg[it], v);
                const f32x2 st = ST[s];
                const f32x4 g0 = *(const LAS f32x4*)(LG + g * 128 + c0), g1 = *(const LAS f32x4*)(LG + g * 128 + c0 + 4), e0 = *(const LAS f32x4*)(LB + g * 128 + c0), e1 = *(const LAS f32x4*)(LB + g * 128 + c0 + 4);
#pragma unroll
                for (int i = 0; i < 8; ++i) {
                    const int c = c0 + i, rho = (c & ~31) + 16 * ((c >> 2) & 1) + 4 * ((c & 31) >> 3) + (c & 3);
                    const float gm = i < 4 ? g0[i] : g1[i - 4], be = i < 4 ? e0[i] : e1[i - 4];
                    const float val = (v[i] - st.x) * st.y * gm + be;
                    VT[rho * 136 + s] = (bf16_t)(cvt_pk_bf16(val, 0.f) & 0xffffu);
                }
            }
            bf16x8 wf[4];
#pragma unroll
            for (int kk = 0; kk < 4; ++kk) if (kk <= kmax) wf[kk] = *(const bf16x8*)(WSP + ((size_t)(g * 128 + t)) * 128 + 32 * kk + 8 * fq);
            const float bias = b_s[g * 128 + t];
            u32x4 ureg[4];
#pragma unroll
            for (int b = 0; b < 4; ++b) ureg[b] = *(const u32x4*)(U + (r0 + t) * DM + g * 128 + b * 32 + 8 * fq);
            if (g < 7) {
#pragma unroll
                for (int it = 0; it < 4; ++it) { const int idx = wid * 4 + it, s = (idx & 1) * 64 + lane, c0 = (idx >> 1) * 8; vreg[it] = *(const u32x4*)(V + (r0 + s) * DM + (g + 1) * 128 + c0); }
            }
            __syncthreads();
            f32x4 acc[4][2];
#pragma unroll
            for (int b = 0; b < 4; ++b) { acc[b][0] = (f32x4){0.f, 0.f, 0.f, 0.f}; acc[b][1] = (f32x4){0.f, 0.f, 0.f, 0.f}; }
#pragma unroll
            for (int kk = 0; kk < 4; ++kk) if (kk <= kmax) {
#pragma unroll
                for (int b = 0; b < 4; ++b)
#pragma unroll
                    for (int n = 0; n < 2; ++n) {
                        const bf16x8 vf = *(const LAS bf16x8*)(VT + (b * 32 + 16 * n + fr) * 136 + 32 * kk + 8 * fq);
                        acc[b][n] = __builtin_amdgcn_mfma_f32_16x16x32_bf16(vf, wf[kk], acc[b][n], 0, 0, 0);
                    }
            }
#pragma unroll
            for (int b = 0; b < 4; ++b) {
                float u8[8]; unpack8(ureg[b], u8);
                float o[8];
#pragma unroll
                for (int j = 0; j < 4; ++j) { o[j] = (acc[b][0][j] + bias) * u8[j]; o[4 + j] = (acc[b][1][j] + bias) * u8[4 + j]; }
                *(u32x4*)(YC + (r0 + t) * DM + g * 128 + b * 32 + 8 * fq) = pack8(o);
            }
            __syncthreads();
        }
    }
}


#define XB_TMO      128
#define XB_XCNT(j)  (256  + 64 * (j))
#define XB_XSUB(j)  (1280 + 64 * (j))
#define XB_XGEN(j)  (2304 + 64 * (j))
#define XB_TOP      3328
#define XB_TOPGEN   3392
#define XB_SPIN_CAP (1u << 20)
__device__ __forceinline__ unsigned xb_ld(unsigned* p)              { return __hip_atomic_load(p, __ATOMIC_RELAXED, __HIP_MEMORY_SCOPE_AGENT); }
__device__ __forceinline__ unsigned xb_add(unsigned* p, unsigned v) { return __hip_atomic_fetch_add(p, v, __ATOMIC_RELAXED, __HIP_MEMORY_SCOPE_AGENT); }
__device__ __forceinline__ unsigned xb_xcc_id() { return (unsigned)__builtin_amdgcn_s_getreg((3 << 11) | 20) & 0xFu; }
#define XB_SPIN(cond, bar) do { unsigned _sp = 0; while (cond) { __builtin_amdgcn_s_sleep(1); \
    if ((++_sp & 255u) == 0u) { if (xb_ld(&(bar)[XB_TMO])) break; if (_sp > XB_SPIN_CAP) { atomicAdd(&(bar)[XB_TMO], 1u); break; } } } } while (0)
struct XcdBarrier { unsigned* bar; unsigned x; volatile LAS unsigned* st; };
__device__ __forceinline__ void xcd_barrier_post(unsigned* bar, int tid) { if (tid == 0) (void)xb_add(&bar[XB_XCNT(xb_xcc_id())], 1u); }
__device__ __forceinline__ void xcd_barrier_complete(unsigned* bar, unsigned x, unsigned& nloc, unsigned& nx) {
    const unsigned G = gridDim.x * gridDim.y * gridDim.z;
    unsigned sum, cnt, mine, sp = 0u;
    for (;;) {
        sum = 0u; cnt = 0u; mine = 0u;
#pragma unroll
        for (unsigned j = 0; j < 16; ++j) { const unsigned c = xb_ld(&bar[XB_XCNT(j)]); sum += c; cnt += (c > 0u) ? 1u : 0u; mine = (j == x) ? c : mine; }
        if (sum == G) break;
        __builtin_amdgcn_s_sleep(1);
        if ((++sp & 255u) == 0u) { if (xb_ld(&bar[XB_TMO])) break; if (sp > XB_SPIN_CAP) { atomicAdd(&bar[XB_TMO], 1u); break; } }
    }
    nloc = mine > 0u ? mine : 1u; nx = cnt > 0u ? cnt : 1u;
}
__device__ __forceinline__ void xcd_barrier(const XcdBarrier& b, int tid) {
    asm volatile("s_waitcnt vmcnt(0)" ::: "memory");
    __syncthreads();
    if (tid == 0) {
        unsigned* bar = b.bar;
        __builtin_amdgcn_s_waitcnt(0);
        unsigned nloc = b.st[0], nx = b.st[1];
        if (nloc == 0u) { xcd_barrier_complete(bar, b.x, nloc, nx); b.st[0] = nloc; b.st[1] = nx; }
        const unsigned old = xb_add(&bar[XB_XSUB(b.x)], 1u);
        const unsigned gen = old / nloc;
        if (old + 1u == (gen + 1u) * nloc) {
            __builtin_amdgcn_fence(__ATOMIC_RELEASE, "agent");
            asm volatile("s_waitcnt vmcnt(0)" ::: "memory");
            const unsigned og = xb_add(&bar[XB_TOP], 1u);
            const unsigned tg = og / nx;
            if (og + 1u == (tg + 1u) * nx) xb_add(&bar[XB_TOPGEN], 1u);
            else XB_SPIN(xb_ld(&bar[XB_TOPGEN]) == tg, bar);
            __builtin_amdgcn_fence(__ATOMIC_ACQUIRE, "agent");
            xb_add(&bar[XB_XGEN(b.x)], 1u);
            asm volatile("s_waitcnt vmcnt(0)" ::: "memory");
        } else {
            XB_SPIN(xb_ld(&bar[XB_XGEN(b.x)]) == gen, bar);
            __builtin_amdgcn_fence(__ATOMIC_ACQUIRE, "agent");
            asm volatile("s_waitcnt vmcnt(0)" ::: "memory");
        }
    }
    __syncthreads();
}

struct Args { const float* in[31]; float* out; unsigned char* ws; int ph_lo, ph_hi; };

__global__ void __launch_bounds__(512, 2) mk_fwd(Args args) {
    extern __shared__ __attribute__((aligned(16))) unsigned char lds_raw[];
    LAS unsigned char* lds = (LAS unsigned char*)lds_raw;
    const int G = gridDim.x, bx = blockIdx.x;
    const int vcu = (G % 8 == 0) ? (bx % 8) * (G / 8) + bx / 8 : bx;
    volatile LAS unsigned* xst = (volatile LAS unsigned*)(lds + LDS_XS + 8192);
    const bool multi = args.ph_hi - args.ph_lo > 1;
    if (multi) { if (threadIdx.x < 2) xst[threadIdx.x] = 0u; __syncthreads(); xcd_barrier_post((unsigned*)args.ws, (int)threadIdx.x); }

    for (int pi = args.ph_lo; pi < args.ph_hi; ++pi) {
        const int ph = pi;
        if (ph == 11 || ph == 12) continue;
        int tid = threadIdx.x; asm volatile("" : "+v"(tid));
        size_t wz = 0; asm volatile("" : "+s"(wz)); unsigned char* ws = args.ws + wz;
        const __attribute__((address_space(4))) char* kp = (const __attribute__((address_space(4))) char*)__builtin_amdgcn_kernarg_segment_ptr() + wz;
#define IN(i) ((const float*)(*(const __attribute__((address_space(1))) float* const __attribute__((address_space(4)))*)(kp + 8 * (i))))
        const int lane = tid & 63, wave = __builtin_amdgcn_readfirstlane(tid >> 6);
        const int gw = vcu * 8 + wave, NGW = G * 8;
        const bool panel_mode = false && (G == M_TOK / 256); const int panel = vcu;
        pg8::Epi E; E.ws = ws; E.lds = lds;
        bool is_gemm = false;
        if (ph == 0) {
            const bool split = (G % 32 == 0) && (G >= 128);
            const int nc = split ? (G / 32) * 12 : G, nm = split ? G - nc : G;
            const int ci = split ? (vcu % 32) * (G / 32) + (vcu / 32) : vcu, mi = split ? (vcu / 32) * 20 + (vcu % 32) - 12 : vcu;
            const bool do_c = !split || (vcu % 32) < 12, do_m = !split || (vcu % 32) >= 12;
            const int gwc = ci * 8 + wave, NGWC = nc * 8, gwm = mi * 8 + wave, NGWM = nm * 8;
            if (do_c) {
            for (int g = ci; g < 32; g += nc) s5_build(lds, ws, IN(8), IN(9), IN(10), IN(11), IN(12), IN(13), IN(14), IN(15), g, tid);
            LAS float* scr = (LAS float*)(lds + wave * 16384);
            constexpr int I_IN = 16 * (NIN / 32), I_BG = 16 * 32, I_BS = 8 * 32, I_MX = 16 * 32, I_GL = 8 * 16, I_Q = 16 * 32, I_KV = 16 * 64, I_O = 16 * 32, I_GU = 16 * (2 * FF / 32), I_DN = (FF / 64) * 32;
            constexpr int NIT = I_IN + I_BG + I_BS + I_MX + I_GL + I_KV + I_O + I_GU + I_DN;
            for (int it = gwc; it < NIT; it += NGWC) {
                int r = it;
                if (r < I_IN) { transpose_item(IN(3), NIN, (bf16_t*)(ws + WS_WIN), 1024, 0, 0, scr, r, lane); continue; } r -= I_IN;
                if (r < I_BG) { transpose_item(IN(17), 1024, (bf16_t*)(ws + WS_WBR), 1536, 0, 0, scr, r, lane); continue; } r -= I_BG;
                if (r < I_BS) { transpose_item(IN(18), 1024, (bf16_t*)(ws + WS_WBR), 1536, 1024, 0, scr, r, lane); continue; } r -= I_BS;
                if (r < I_MX) { transpose_item(IN(19), 1024, (bf16_t*)(ws + WS_WMIX), 1024, 0, 0, scr, r, lane); continue; } r -= I_MX;
                if (r < I_GL) { transpose_item(IN(16), 512, (bf16_t*)(ws + WS_WGLU), 512, 0, 0, scr, r, lane); continue; } r -= I_GL;
                if (r < I_KV) { transpose_item(IN(24), 2048, (bf16_t*)(ws + WS_WKV), 1152, 0, 0, scr, r, lane); continue; } r -= I_KV;
                if (r < I_O) { transpose_item(IN(25), 1024, (bf16_t*)(ws + WS_WO), 1024, 0, 0, scr, r, lane); continue; } r -= I_O;
                if (r < I_GU) { transpose_item(IN(28), 2 * FF, (bf16_t*)(ws + WS_WGU), 1024, 0, 1, scr, r, lane, IN(27)); continue; } r -= I_GU;
                transpose_item(IN(29), 1024, (bf16_t*)(ws + WS_WDN), FF, 0, 0, scr, r, lane);
            }
            {
                const float* w = IN(23); const float* gq = IN(21); bf16_t* o = (bf16_t*)(ws + WS_WQ);
                for (int i = ci * 512 + tid; i < 1024 * 1024 / 8; i += nc * 512) {
                    const int e = i * 8; const float gsc = gq[e >> 10];
                    const f32x4 a = *(const f32x4*)(w + e) * gsc, b = *(const f32x4*)(w + e + 4) * gsc;
                    float v[8] = {a[0], a[1], a[2], a[3], b[0], b[1], b[2], b[3]};
                    *(u32x4*)(o + e) = pack8(v);
                }
            }
            {
                const float* w = IN(6); bf16_t* o = (bf16_t*)(ws + WS_WSP);
                for (int i = ci * 512 + tid; i < 8 * 128 * 128 / 8; i += nc * 512) {
                    const int e = i * 8, s0 = e & 127, t = (e >> 7) & 127;
                    const f32x4 a = *(const f32x4*)(w + e), b = *(const f32x4*)(w + e + 4);
                    float v[8] = {a[0], a[1], a[2], a[3], b[0], b[1], b[2], b[3]};
#pragma unroll
                    for (int j = 0; j < 8; ++j) if (s0 + j > t) v[j] = 0.f;
                    *(u32x4*)(o + e) = pack8(v);
                }
            }
            }
            if (do_m) {
                int m = gwm;
                for (; m + 3 * NGWM < M_TOK; m += 4 * NGWM) rms_rows_to_bf16<4>(IN(0) + (size_t)m * DM, (size_t)NGWM * DM, IN(2), (bf16_t*)(ws + WS_SA) + (size_t)m * DM, (size_t)NGWM * DM, lane);
                for (; m < M_TOK; m += NGWM) rms_rows_to_bf16<1>(IN(0) + (size_t)m * DM, 0, IN(2), (bf16_t*)(ws + WS_SA) + (size_t)m * DM, 0, lane);
                for (m = gwm; m < NMEM; m += NGWM) rms_rows_to_bf16<1>(IN(1) + (size_t)m * DM, 0, IN(22), (bf16_t*)(ws + WS_MEMN) + (size_t)m * 1152, 0, lane);
            }
        } else if (ph == 1 || ph == 2) { is_gemm = true;
        } else if (ph == 3) { is_gemm = true;
        } else if (ph == 4 || ph == 5 || ph == 6 || ph == 7) { is_gemm = true;
        } else if (ph == 8) {
            if (panel_mode) rowpass<false, true>((const bf16_t*)(ws + WS_SA), IN(20), IN(0), ws + WS_X1B, nullptr, nullptr, (float*)(ws + WS_RS1), panel * 256 + wave, 8, lane, panel * 256 + 256);
            else rowpass<false, true>((const bf16_t*)(ws + WS_SA), IN(20), IN(0), ws + WS_X1B, nullptr, nullptr, (float*)(ws + WS_RS1), gw, NGW, lane, M_TOK);
        } else if (ph == 9 || ph == 10) { is_gemm = true;
        } else if (ph == 13) {
            if (panel_mode) rowpass<true, true>((const bf16_t*)(ws + WS_SD), IN(26), ws + WS_X1B, ws + WS_X2B, nullptr, nullptr, (float*)(ws + WS_RS2), panel * 256 + wave, 8, lane, panel * 256 + 256);
            else rowpass<true, true>((const bf16_t*)(ws + WS_SD), IN(26), ws + WS_X1B, ws + WS_X2B, nullptr, nullptr, (float*)(ws + WS_RS2), gw, NGW, lane, M_TOK);
        } else if (ph == 14 || ph == 15) { is_gemm = true;
        } else if (ph == 16) {
            if (panel_mode) rowpass<true, false>((const bf16_t*)(ws + WS_SC), IN(30), ws + WS_X2B, args.out, nullptr, nullptr, nullptr, panel * 256 + wave, 8, lane, panel * 256 + 256);
            else rowpass<true, false>((const bf16_t*)(ws + WS_SC), IN(30), ws + WS_X2B, args.out, nullptr, nullptr, nullptr, gw, NGW, lane, M_TOK);
        }
        if (is_gemm) {
            pg8::Sched S; S.ws = ws; S.ph = ph; S.G = G; S.c = bx; S.panel = (panel_mode && ph >= 6 && !FFN_GRID(ph)) ? panel : -1;
            const bool scan_wg = (ph == 3) && (G > 128) && (vcu < 64);
            if (ph == 3 && G > 128) { S.G = G - 64; S.c = vcu - 64; }
            S.n0 = pg8::phase_units(ph, 0); S.n1 = (ph == 2 || ph == 3) ? pg8::phase_units(ph, 1) : 0; S.total = S.n0 + S.n1;
            if (S.panel >= 0) S.total = (ph == 14) ? 2 * FF / 256 : 4;
            if (ph == 1) { for (int u = vcu; u < 256; u += G) s5_expand(lds, ws, u >> 3, u & 7, tid); }
            const bool sp_first = (ph == 2) && ((vcu >> 0) & 1);
            if (sp_first) spatial_phase(lds, ws, IN(4), IN(5), IN(7), vcu, G, tid);
            if (!scan_wg) pg8::gemm_phase(lds, S, E, tid);
            if (ph == 2 && !sp_first) spatial_phase(lds, ws, IN(4), IN(5), IN(7), vcu, G, tid);
            if (ph == 3) {
            const int gt = vcu * 512 + tid;
                if (gt < 16 * 32 * 64) {
                    const int p = gt & 63, g = (gt >> 6) & 31, b = gt >> 11;
                    const f32x2 a = ((const f32x2*)(ws + WS_A64))[g * 64 + p];
                    const float* Eb = (const float*)(ws + WS_EBUF); bf16_t* UC = (bf16_t*)(ws + WS_UC);
                    float cr = 0.f, ci = 0.f;
    #pragma unroll 8
                    for (int k = 0; k < 64; ++k) {
                        const size_t row = (size_t)g * 1024 + b * 64 + k;
                        const f32x2 e = *(const f32x2*)(Eb + row * 128 + 2 * p);
                        *(unsigned*)(UC + row * 1152 + 2 * p) = cvt_pk_bf16(cr, ci);
                        const float nr = a.x * cr - a.y * ci + e.x, ni = a.x * ci + a.y * cr + e.y; cr = nr; ci = ni;
                    }
                }

            }
        }
        if (pi + 1 < args.ph_hi) {
            if (panel_mode && ph >= 6 && ph != 16 && !FFN_GRID(ph) && !FFN_GRID(ph + 1)) {
                asm volatile("s_waitcnt vmcnt(0) lgkmcnt(0)" ::: "memory");
                __syncthreads();
                __builtin_amdgcn_fence(__ATOMIC_ACQUIRE, "agent");
                asm volatile("s_waitcnt vmcnt(0)" ::: "memory");
                __syncthreads();
            } else if (args.ph_hi > 4096) cg::this_grid().sync();
            else { XcdBarrier xb; xb.bar = (unsigned*)ws; xb.x = xb_xcc_id(); xb.st = xst; xcd_barrier(xb, tid); }
        }
    }
}

extern "C" void kernel_launch(void* const* d_in, const int* in_sizes, int n_in, void* d_out, int out_size, void* d_ws, size_t ws_size, hipStream_t stream) {
    static int grid = 0;
    if (grid == 0) {
        if (n_in != 31 || in_sizes[0] != M_TOK * DM || out_size != M_TOK * DM || ws_size < WS_END) { fprintf(stderr, "kernel_launch: unexpected problem (n_in %d, ws %zu)\n", n_in, ws_size); grid = -1; return; }
        int dev = 0, cus = 0, per_cu = 0;
        hipGetDevice(&dev); hipDeviceGetAttribute(&cus, hipDeviceAttributeMultiprocessorCount, dev);
        hipFuncSetAttribute((const void*)mk_fwd, hipFuncAttributeMaxDynamicSharedMemorySize, LDS_BYTES);
        hipOccupancyMaxActiveBlocksPerMultiprocessor(&per_cu, (const void*)mk_fwd, 512, LDS_BYTES);
        if (per_cu < 1) { fprintf(stderr, "kernel_launch: occupancy query says %d blocks per CU\n", per_cu); per_cu = 1; }
        (void)hipGetLastError();
        grid = cus;
    }
    if (grid < 0) return;
    Args a{};
    for (int i = 0; i < 31; ++i) a.in[i] = (const float*)d_in[i];
    a.out = (float*)d_out; a.ws = (unsigned char*)d_ws;
#if MK_ONE_LAUNCH
    (void)hipMemsetAsync(d_ws, 0, 65536, stream);
    a.ph_lo = 0; a.ph_hi = NPHASE;
    void* kargs[] = {&a};
    hipError_t e = hipLaunchCooperativeKernel((const void*)mk_fwd, dim3(grid), dim3(512), kargs, LDS_BYTES, stream);
    if (e != hipSuccess) fprintf(stderr, "cooperative launch failed: %s (grid %d)\n", hipGetErrorString(e), grid);

#else
    for (int ph = 0; ph < NPHASE; ++ph) {
        a.ph_lo = ph; a.ph_hi = ph + 1;
        hipLaunchKernelGGL(mk_fwd, dim3(grid), dim3(512), LDS_BYTES, stream, a);
    }
#endif
}
```

```cpp
#include <hip/hip_runtime.h>
#include <hip/hip_cooperative_groups.h>
#include <cstdint>
#include <cstdio>
namespace cg = cooperative_groups;

#define FFN_GRID(p) ((p) == 6 || (p) == 7 || (p) == 9 || (p) == 10 || (p) == 14 || (p) == 15)
#ifndef MK_ONE_LAUNCH
#define MK_ONE_LAUNCH 1
#endif

#define LAS __attribute__((address_space(3)))
typedef unsigned short bf16_t;
typedef short bf16x8 __attribute__((ext_vector_type(8)));
typedef float f32x4 __attribute__((ext_vector_type(4)));
typedef float f32x2 __attribute__((ext_vector_type(2)));
typedef unsigned u32x4 __attribute__((ext_vector_type(4)));
typedef unsigned u32x2 __attribute__((ext_vector_type(2)));

constexpr int M_TOK = 65536, DM = 1024, NIN = 4608, FF = 2816, NMEM = 4096, SEQ = 4096;
constexpr float EPS = 1e-6f;
constexpr int NPHASE = 17;
constexpr size_t MiB = 1u << 20;
constexpr size_t WS_WIN = 1 * MiB, WS_WBR = 10 * MiB, WS_WMIX = 13 * MiB, WS_WGLU = 15 * MiB, WS_WQ = 16 * MiB, WS_WKV = 18 * MiB  , WS_WO = 23 * MiB,
                 WS_WGU = 25 * MiB, WS_WDN = 36 * MiB, WS_WSP = 42 * MiB, WS_A64 = 42 * MiB + 256 * 1024, WS_RS1 = 42 * MiB + 320 * 1024  , WS_RS2 = 42 * MiB + 576 * 1024  , WS_KB = 43 * MiB, WS_VB = 51 * MiB  ;
constexpr size_t WS_SA = 59 * MiB, WS_SB = 187 * MiB, WS_SC = 315 * MiB, WS_SD = 443 * MiB;
constexpr size_t WS_ACT = 571 * MiB;
constexpr size_t WS_BT1 = 571 * MiB  , WS_BT2 = 581 * MiB, WS_EBUF = 653 * MiB, WS_MEMN = 669 * MiB  , WS_UC = 678 * MiB,
                 WS_U = 750 * MiB  , WS_V = 878 * MiB, WS_S5T = 1006 * MiB  , WS_END = 1010 * MiB;
constexpr size_t WS_X1B = WS_SB, WS_X2B = WS_SA;
constexpr size_t WS_VST = WS_SB;
constexpr size_t WS_MB = 942 * MiB, WS_NB = 974 * MiB;
constexpr int KTS = 257;
constexpr int S5T_BYTES = 49664 + 64 * KTS * 4;
constexpr int LDS_RING = 131072, LDS_XS = 131072, LDS_BYTES = 147456;

typedef __bf16 bf16v2 __attribute__((ext_vector_type(2)));
__device__ __forceinline__ unsigned cvt_pk_bf16(float lo, float hi) { const f32x2 f = {lo, hi}; const bf16v2 v = __builtin_convertvector(f, bf16v2); return __builtin_bit_cast(unsigned, v); }
__device__ __forceinline__ float bf_lo(unsigned w) { return __uint_as_float(w << 16); }
__device__ __forceinline__ float bf_hi(unsigned w) { return __uint_as_float(w & 0xffff0000u); }
__device__ __forceinline__ float fsigmoid(float x) { return __builtin_amdgcn_rcpf(1.f + __builtin_amdgcn_exp2f(-1.4426950408889634f * x)); }
__device__ __forceinline__ float gelu_t(float x) { const float y = 1.5957691216057308f * (x + 0.044715f * x * x * x); return x * fsigmoid(y); }
__device__ __forceinline__ float shx(float v, int lane, int o) { return __int_as_float(__builtin_amdgcn_ds_bpermute((lane ^ o) << 2, __float_as_int(v))); }
__device__ __forceinline__ float wave_sum(float v, int lane) {
#pragma unroll
    for (int o = 1; o < 64; o <<= 1) v += shx(v, lane, o);
    return v;
}
__device__ __forceinline__ void unpack8(const u32x4 w, float (&v)[8]) {
    v[0] = bf_lo(w.x); v[1] = bf_hi(w.x); v[2] = bf_lo(w.y); v[3] = bf_hi(w.y); v[4] = bf_lo(w.z); v[5] = bf_hi(w.z); v[6] = bf_lo(w.w); v[7] = bf_hi(w.w);
}
__device__ __forceinline__ u32x4 pack8(const float (&v)[8]) {
    u32x4 w; w.x = cvt_pk_bf16(v[0], v[1]); w.y = cvt_pk_bf16(v[2], v[3]); w.z = cvt_pk_bf16(v[4], v[5]); w.w = cvt_pk_bf16(v[6], v[7]); return w;
}

namespace pg8 {
constexpr int BM = 256, BK = 64, HALF = 128, HTB = HALF * BK * 2, NXCD = 8, WGM = 4;
static_assert(WGM == 4, "the phase-4 unit mirroring assumes groups of 4 row tiles x 4 column tiles");
__host__ __device__ __forceinline__ int lds_byte(int r, int c) { const int st = (r >> 4) * 2 + (c >> 5), rr = r & 15, cc = c & 31, ob = rr * 64 + cc * 2; return st * 1024 + (ob ^ (((ob >> 9) & 1) << 5)); }
__host__ __device__ __forceinline__ void stage_rc(int b, int& R, int& C) { const int st = b / 1024, sb = b % 1024, swz = sb ^ (((sb >> 9) & 1) << 5); R = (st >> 1) * 16 + swz / 64; C = (st & 1) * 32 + (swz % 64) / 2; }
__host__ __device__ __forceinline__ int perm32(int rho) { const int n = rho >> 4, i = rho & 15; return 8 * (i >> 2) + 4 * n + (i & 3); }

enum Kind { K_IN = 0, K_KVPROJ, K_MB, K_NB, K_S5E, K_S5Y, K_GLU, K_BR, K_MIX, K_SMAX, K_OPROJ, K_GU, K_DOWN };

struct Unit { const char* A; const char* B; int lda, cha, ldb, nt, pn, kind, orow, ocol; };
struct Desc {
    const char* A; const char* B; int lda, cha, ldb, nt, nM, nN, nZ0; long zsA0, zsA1, zsB0, zsB1; int kind, orz0, orz1, ocz0;
    __device__ __forceinline__ void fill(int w, Unit& u) const {
        const int per = nM * nN, z = w / per, r = w % per;
        const int nig = WGM * nN, gid = r / nig, fm = gid * WGM, gsz = (nM - fm) < WGM ? (nM - fm) : WGM;
        const int pm = fm + ((r % nig) % gsz), pn = (r % nig) / gsz;
        const int z0 = z % nZ0, z1 = z / nZ0;
        fill_pz(pm, pn, z0, z1, u);
    }
    __device__ __forceinline__ void fill_pz(int pm, int pn, int z0, int z1, Unit& u) const {
        u.pn = pn;
        u.A = A + z0 * zsA0 + z1 * zsA1 + (long)pm * BM * lda * 2;
        u.B = B + z0 * zsB0 + z1 * zsB1 + (long)pn * BM * ldb * 2;
        u.lda = lda; u.cha = cha; u.ldb = ldb; u.nt = (kind == K_S5Y) ? 2 + 4 * (pn + 1) : nt; u.kind = kind;
        u.orow = pm * BM + z0 * orz0 + z1 * orz1; u.ocol = pn * BM + z0 * ocz0;
    }
};
__device__ __forceinline__ Desc mk_desc(const void* A, const void* B, int lda, int ldb, int K, int Mrows, int Ncols, int kind) {
    Desc d; d.A = (const char*)A; d.B = (const char*)B; d.lda = lda; d.cha = 16; d.ldb = ldb; d.nt = K / BK; d.nM = Mrows / BM; d.nN = Ncols / BM; d.nZ0 = 1;
    d.zsA0 = d.zsA1 = d.zsB0 = d.zsB1 = 0; d.kind = kind; d.orz0 = d.orz1 = d.ocz0 = 0; return d;
}
__device__ __forceinline__ Desc phase_desc(int ph, int sub, unsigned char* ws) {
    Desc d;
    if (ph == 1) { d = mk_desc(ws + WS_SA, ws + WS_WIN, 1024, 1024, 1024, M_TOK, NIN, K_IN);
    } else if (ph == 2) {
        if (sub == 0) { d = mk_desc(ws + WS_UC + 128 * 2, ws + WS_BT1, 1152, 1152, 1024, 1024, 256, K_S5E); d.nZ0 = 32; d.zsA0 = 1024L * 1152 * 2; d.zsB0 = 128L * 1152 * 2; d.orz0 = 1024; }
        else d = mk_desc(ws + WS_MEMN, ws + WS_WKV, 1152, 1152, 1024, NMEM, 2048, K_KVPROJ);
    } else if (ph == 3) {
        if (sub == 0) { d = mk_desc(ws + WS_KB, ws + WS_WQ, 1024, 1024, 256, 256, 1024, K_MB); d.nZ0 = 4; d.zsA0 = 256 * 2; d.zsA1 = 256L * 1024 * 2; d.zsB0 = 256 * 2; d.orz0 = 256; d.orz1 = 1024; }
        else { d = mk_desc(ws + WS_WO, ws + WS_VB, 1024, 1024, 256, 1024, 256, K_NB); d.nZ0 = 4; d.zsA0 = 256 * 2; d.zsB0 = 256 * 2; d.zsB1 = 256L * 1024 * 2; d.orz1 = 1024; d.ocz0 = 256; }
    } else if (ph == 4) { d = mk_desc(ws + WS_UC, ws + WS_BT2, 1152, 1152, 1152, 1024, 1024, K_S5Y); d.nZ0 = 32; d.zsA0 = 1024L * 1152 * 2; d.zsB0 = 1024L * 1152 * 2; d.orz0 = 1024;
    } else if (ph == 5) { d = mk_desc(ws + WS_U, ws + WS_WGLU, 16, 512, 512, M_TOK, 512, K_GLU); d.cha = M_TOK * 16;
    } else if (ph == 6) { d = mk_desc(ws + WS_SA, ws + WS_WBR, 1024, 1536, 1536, M_TOK, 1024, K_BR);
    } else if (ph == 7) { d = mk_desc(ws + WS_SC, ws + WS_WMIX, 1024, 1024, 1024, M_TOK, 1024, K_MIX);
    } else if (ph == 9) {
        d = mk_desc(ws + WS_SB, ws + WS_MB, 1024, 1024, 1024, SEQ, 1024, K_SMAX); d.zsA1 = (long)SEQ * 1024 * 2; d.zsB1 = 1024L * 1024 * 2; d.orz1 = SEQ;
    } else if (ph == 10) {
        d = mk_desc(ws + WS_SC, ws + WS_NB, 1024, 1024, 1024, SEQ, 1024, K_OPROJ); d.zsA1 = (long)SEQ * 1024 * 2; d.zsB1 = 1024L * 1024 * 2; d.orz1 = SEQ;
    } else if (ph == 14) { d = mk_desc(ws + WS_SA, ws + WS_WGU, 1024, 1024, 1024, M_TOK, 2 * FF, K_GU);
    } else { d = mk_desc(ws + WS_ACT, ws + WS_WDN, FF, FF, FF, M_TOK, 1024, K_DOWN); }
    return d;
}
__device__ __forceinline__ int phase_units(int ph, int sub) {
    switch (ph) {
        case 1: return (M_TOK / BM) * (NIN / BM);
        case 2: return sub == 0 ? 32 * 4 : (sub == 1 ? 128 : 0);
        case 3: return sub < 2 ? 256 : 0;
        case 4: return 32 * 16;
        case 5: return (M_TOK / BM) * 2;
        case 14: return (M_TOK / BM) * (2 * FF / BM);
        default: return (M_TOK / BM) * 4;
    }
}
struct Sched {
    unsigned char* ws; int ph, n0, n1, total, G, c, panel;
    __device__ __forceinline__ bool next(int i, Unit& u) const {
        if (panel >= 0) {
            if (i >= total) return false;
            const Desc d = phase_desc(ph, 0, ws);
            if (ph == 9 || ph == 10) d.fill_pz(panel & 15, i, 0, panel >> 4, u); else d.fill_pz(panel, i, 0, 0, u);
            return true;
        }
        const long L = (long)i * G + c; if (L >= total) return false;
        int wgid = (int)L; { const int q = total / NXCD, r = total % NXCD, xcd = wgid % NXCD, off = wgid / NXCD; wgid = (xcd < r ? xcd * (q + 1) : r * (q + 1) + (xcd - r) * q) + off; }
        int sub = 0; if (wgid >= n0) { sub = 1; wgid -= n0; if (wgid >= n1) { sub = 2; wgid -= n1; } }
        if (ph == 4 && (i & 1)) { const int r = wgid & 15; wgid += ((r & 3) + 4 * (3 - (r >> 2))) - r; }
        const Desc d = phase_desc(ph, sub, ws); d.fill(wgid, u);
        return true;
    }
};
struct Drv { unsigned vA0, vA1, vB0, vB1, kA, hA, hB; };
__device__ __forceinline__ Drv derive(const Unit& u, int tid) {
    int R0, C0, R1, C1; stage_rc(tid * 16, R0, C0); stage_rc(tid * 16 + 8192, R1, C1);
    const int Rb0 = (R0 & ~31) + perm32(R0 & 31), Rb1 = (R1 & ~31) + perm32(R1 & 31);
    Drv d;
    d.vA0 = (unsigned)(R0 * u.lda + (C0 >> 4) * u.cha + (C0 & 15)) * 2u; d.vA1 = (unsigned)(R1 * u.lda + (C1 >> 4) * u.cha + (C1 & 15)) * 2u;
    d.vB0 = (unsigned)(Rb0 * u.ldb + C0) * 2u; d.vB1 = (unsigned)(Rb1 * u.ldb + C1) * 2u;
    d.kA = (unsigned)(8 * u.cha); d.hA = (unsigned)(HALF * 2 * u.lda); d.hB = (unsigned)(HALF * 2 * u.ldb);
    return d;
}

struct Epi {
    unsigned char* ws; LAS unsigned char* lds;
    __device__ __forceinline__ void get8(const f32x4 (&acc)[2][2][4][2], int ai, int bj, int m, float (&v)[8]) const {
        const f32x4 a = acc[ai][bj][m][0], b = acc[ai][bj][m][1];
        v[0] = a[0]; v[1] = a[1]; v[2] = a[2]; v[3] = a[3]; v[4] = b[0]; v[5] = b[1]; v[6] = b[2]; v[7] = b[3];
    }
    __device__ __forceinline__ void mid(f32x4 (&acc)[2][2][4][2], const Unit& u, int wr, int wc, int fr, int fq) const {
        const bf16_t* RG = (const bf16_t*)(ws + WS_SC);
        int rb = u.orow + wr * 64 + fr; asm volatile("" : "+v"(rb));
        int cb = u.ocol + wc * 32 + 8 * fq; asm volatile("" : "+v"(cb));
        u32x4 rg[2][4][2];
#pragma unroll
        for (int ai = 0; ai < 2; ++ai)
#pragma unroll
            for (int m = 0; m < 4; ++m)
#pragma unroll
                for (int bj = 0; bj < 2; ++bj) rg[ai][m][bj] = *(const u32x4*)(RG + (size_t)(rb + ai * HALF + m * 16) * DM + cb + bj * HALF);
#pragma unroll
        for (int ai = 0; ai < 2; ++ai)
#pragma unroll
            for (int m = 0; m < 4; ++m)
#pragma unroll
                for (int bj = 0; bj < 2; ++bj) {
                    float a[8]; unpack8(rg[ai][m][bj], a);
#pragma unroll
                    for (int j = 0; j < 8; ++j) { const float r = a[j] * 1.0f; asm volatile("v_mul_f32 %0, %0, %1" : "+v"(acc[ai][bj][m][j >> 2][j & 3]) : "v"(r)); }
                }
        asm volatile("" ::: "memory");
    }
    __device__ __forceinline__ void operator()(const f32x4 (&acc)[2][2][4][2], const Unit& u, int wr, int wc, int fr, int fq) const {
        const int kind = u.kind;
        if (kind == K_SMAX) {
            LAS f32x2* XS = (LAS f32x2*)(lds + LDS_XS);
            int rls = wr * 64 + fr; asm volatile("" : "+v"(rls));
            bf16_t* P = (bf16_t*)(ws + WS_SC); const float* RS = (const float*)(ws + WS_RS1);
            int rbs = u.orow + wr * 64 + fr; asm volatile("" : "+v"(rbs));
            float rsv[2][4];
#pragma unroll
            for (int ai = 0; ai < 2; ++ai)
#pragma unroll
                for (int m = 0; m < 4; ++m) rsv[ai][m] = RS[rbs + ai * HALF + m * 16] * 1.4426950408889634f;
#pragma unroll
            for (int ai = 0; ai < 2; ++ai)
#pragma unroll
                for (int m = 0; m < 4; ++m) {
                    const float rs = rsv[ai][m];
                    float mx = -3.0e38f;
#pragma unroll
                    for (int bj = 0; bj < 2; ++bj)
#pragma unroll
                        for (int n = 0; n < 2; ++n)
#pragma unroll
                            for (int j = 0; j < 4; ++j) mx = fmaxf(mx, acc[ai][bj][m][n][j]);
                    mx = fmaxf(mx, shx(mx, fr + 16 * fq, 16)); mx = fmaxf(mx, shx(mx, fr + 16 * fq, 32));
                    float s = 0.f;
#pragma unroll
                    for (int bj = 0; bj < 2; ++bj)
#pragma unroll
                        for (int n = 0; n < 2; ++n)
#pragma unroll
                            for (int j = 0; j < 4; ++j) s += __builtin_amdgcn_exp2f((acc[ai][bj][m][n][j] - mx) * rs);
                    s += shx(s, fr + 16 * fq, 16); s += shx(s, fr + 16 * fq, 32);
                    if (fq == 0) XS[(rls + ai * HALF + m * 16) * 4 + wc] = (f32x2){mx * rs, s};
                }
            asm volatile("s_waitcnt lgkmcnt(0)" ::: "memory"); __builtin_amdgcn_s_barrier(); asm volatile("" ::: "memory");
#pragma unroll
            for (int ai = 0; ai < 2; ++ai)
#pragma unroll
                for (int m = 0; m < 4; ++m) {
                    const int rl = rls + ai * HALF + m * 16;
                    const f32x2 p0 = XS[rl * 4 + 0], p1 = XS[rl * 4 + 1], p2 = XS[rl * 4 + 2], p3 = XS[rl * 4 + 3];
                    const f32x2 me = XS[rl * 4 + wc];
                    const float MX = fmaxf(fmaxf(p0.x, p1.x), fmaxf(p2.x, p3.x));
                    const float L = p0.y * __builtin_amdgcn_exp2f(p0.x - MX) + p1.y * __builtin_amdgcn_exp2f(p1.x - MX) + p2.y * __builtin_amdgcn_exp2f(p2.x - MX) + p3.y * __builtin_amdgcn_exp2f(p3.x - MX);
                    const float f = 1.0f / L; (void)me;
                    const size_t row = (size_t)(u.orow + rl);
                    const float rs = rsv[ai][m];
#pragma unroll
                    for (int bj = 0; bj < 2; ++bj) {
                        float v[8]; get8(acc, ai, bj, m, v);
#pragma unroll
                        for (int j = 0; j < 8; ++j) v[j] = __builtin_amdgcn_exp2f(v[j] * rs - MX) * f;
                        *(u32x4*)(P + row * DM + u.ocol + bj * HALF + wc * 32 + 8 * fq) = pack8(v);
                    }
                }
            asm volatile("s_waitcnt lgkmcnt(0)" ::: "memory"); __builtin_amdgcn_s_barrier(); asm volatile("" ::: "memory");
            return;
        }
        if (kind == K_GU) {
            bf16_t* ACT = (bf16_t*)(ws + WS_ACT);
            int rb = u.orow + wr * 64 + fr; asm volatile("" : "+v"(rb));
            float rsv[2][4];
#pragma unroll
            for (int ai = 0; ai < 2; ++ai)
#pragma unroll
                for (int m = 0; m < 4; ++m) rsv[ai][m] = ((const float*)(ws + WS_RS2))[rb + ai * HALF + m * 16];
#pragma unroll
            for (int ai = 0; ai < 2; ++ai)
#pragma unroll
                for (int m = 0; m < 4; ++m) {
                    const size_t row = (size_t)(rb + ai * HALF + m * 16);
                    const float rs = rsv[ai][m];
                    float g[8], w[8]; get8(acc, ai, 0, m, g); get8(acc, ai, 1, m, w);
#pragma unroll
                    for (int j = 0; j < 8; ++j) { const float gg = g[j] * rs; g[j] = gg * fsigmoid(gg) * (w[j] * rs); }
                    *(u32x4*)(ACT + row * FF + u.pn * HALF + wc * 32 + 8 * fq) = pack8(g);
                }
            return;
        }
        if (kind == K_S5E) {
            float* E = (float*)(ws + WS_EBUF);
            int rb = u.orow + wr * 64 + fr; asm volatile("" : "+v"(rb));
            int cb = wc * 32 + 8 * fq; asm volatile("" : "+v"(cb));
#pragma unroll
            for (int ai = 0; ai < 2; ++ai)
#pragma unroll
                for (int m = 0; m < 4; ++m) {
                    const size_t row = (size_t)(rb + ai * HALF + m * 16);
                    float* p = E + row * 128 + cb;
                    *(f32x4*)p = acc[ai][0][m][0]; *(f32x4*)(p + 4) = acc[ai][0][m][1];
                }
            return;
        }
        if (kind == K_IN) {
            const int pn = u.pn;
            if (pn < 4) tiles<1>(acc, u.orow, wr, wc, fr, fq, (bf16_t*)(ws + WS_U), DM, pn * BM, nullptr);
            else if (pn < 8) tiles<7>(acc, u.orow, wr, wc, fr, fq, (bf16_t*)(ws + WS_V), DM, (pn & 3) * BM, (const bf16_t*)(ws + WS_VST));
            else if (pn < 10) tiles<3>(acc, u.orow, wr, wc, fr, fq, (bf16_t*)(ws + WS_UC), 0, (pn - 8) * BM, nullptr);
            else {
                bf16_t* RG = (bf16_t*)(ws + WS_SC); bf16_t* SB = (bf16_t*)(ws + WS_SD);
                int rb = u.orow + wr * 64 + fr; asm volatile("" : "+v"(rb));
                int cb = (pn - 10) * HALF + wc * 32 + 8 * fq; asm volatile("" : "+v"(cb));
#pragma unroll
                for (int ai = 0; ai < 2; ++ai)
#pragma unroll
                    for (int m = 0; m < 4; ++m) {
                        const size_t row = (size_t)(rb + ai * HALF + m * 16);
                        float a[8], b[8]; get8(acc, ai, 0, m, a); get8(acc, ai, 1, m, b);
#pragma unroll
                        for (int j = 0; j < 8; ++j) {
                            const float ea = __builtin_amdgcn_exp2f(-1.4426950408889634f * a[j]), eb = __builtin_amdgcn_exp2f(-1.4426950408889634f * b[j]);
                            a[j] = (1.f + eb) * __builtin_amdgcn_rcpf(1.f + ea);
                            b[j] = 1.f * __builtin_amdgcn_rcpf(1.f + eb);
                        }
                        *(u32x4*)(RG + row * DM + cb) = pack8(a); *(u32x4*)(SB + row * DM + cb) = pack8(b);
                        asm volatile("" ::: "memory");
                    }
            }
        } else if (kind == K_KVPROJ) tiles<0>(acc, u.orow, wr, wc, fr, fq, (bf16_t*)(ws + (u.pn < 4 ? WS_KB : WS_VB)), DM, (u.pn & 3) * BM, nullptr);
        else if (kind == K_MB) tiles<6>(acc, u.orow, wr, wc, fr, fq, (bf16_t*)(ws + WS_MB), DM, u.ocol, nullptr);
        else if (kind == K_NB) tiles<0>(acc, u.orow, wr, wc, fr, fq, (bf16_t*)(ws + WS_NB), DM, u.ocol, nullptr);
        else if (kind == K_S5Y) tiles<1>(acc, u.orow, wr, wc, fr, fq, (bf16_t*)(ws + WS_U), 1024, u.ocol, nullptr);
        else if (kind == K_GLU) tiles<4>(acc, u.orow, wr, wc, fr, fq, (bf16_t*)(ws + WS_SB), DM, u.ocol, (const bf16_t*)(ws + WS_U));
        else if (kind == K_BR) tiles<5>(acc, u.orow, wr, wc, fr, fq, (bf16_t*)(ws + WS_SC), DM, u.ocol, (const bf16_t*)(ws + WS_SD));
        else if (kind == K_MIX) tiles<0>(acc, u.orow, wr, wc, fr, fq, (bf16_t*)(ws + WS_SA), DM, u.ocol, nullptr);
        else if (kind == K_OPROJ) tiles<0>(acc, u.orow, wr, wc, fr, fq, (bf16_t*)(ws + WS_SD), DM, u.ocol, nullptr);
        else tiles<0>(acc, u.orow, wr, wc, fr, fq, (bf16_t*)(ws + WS_SC), DM, u.ocol, nullptr);
    }
    template <int MODE>
    __device__ __forceinline__ void tiles(const f32x4 (&acc)[2][2][4][2], int orow, int wr, int wc, int fr, int fq, bf16_t* base, int ld, int colbase, const bf16_t* aux) const {
        int rb = orow + wr * 64 + fr; asm volatile("" : "+v"(rb));
        int cb = colbase + wc * 32 + 8 * fq; asm volatile("" : "+v"(cb));
#pragma unroll
        for (int ai = 0; ai < 2; ++ai) {
            u32x4 ax[4][2];
            if (MODE == 4 || MODE == 5) {
#pragma unroll
                for (int m = 0; m < 4; ++m)
#pragma unroll
                    for (int bj = 0; bj < 2; ++bj) {
                        const size_t row = (size_t)(rb + ai * HALF + m * 16); const int col = cb + bj * HALF;
                        if (MODE == 4) ax[m][bj] = *(const u32x4*)(aux + ((size_t)(col >> 4) * M_TOK + row) * 16 + (col & 15));
                        else ax[m][bj] = *(const u32x4*)(aux + row * DM + col);
                    }
            }
#pragma unroll
            for (int m = 0; m < 4; ++m) {
                const int rowi = rb + ai * HALF + m * 16; const size_t row = (size_t)rowi;
                float st1 = 0.f, st2 = 0.f;
#pragma unroll
                for (int bj = 0; bj < 2; ++bj) {
                    const int col = cb + bj * HALF;
                    float v[8]; get8(acc, ai, bj, m, v);
                    bf16_t* dst = base + row * ld + col;
                    if (MODE == 1 || MODE == 7) {
#pragma unroll
                        for (int j = 0; j < 8; ++j) v[j] = gelu_t(v[j]);
                        if (MODE == 7) {
#pragma unroll
                            for (int j = 0; j < 8; ++j) { st1 += v[j]; st2 += v[j] * v[j]; }
                        }
                    } else if (MODE == 2) {
#pragma unroll
                        for (int j = 0; j < 8; ++j) v[j] = fsigmoid(v[j]);
                    } else if (MODE == 3) {
                        const int g = col >> 4, h0 = col & 15;
                        dst = base + ((size_t)(g * 1024 + (rowi >> 6))) * 1152 + 128 + (rowi & 63) * 16 + h0;
                    } else if (MODE == 4) {
                        float y[8]; unpack8(ax[m][bj], y);
#pragma unroll
                        for (int j = 0; j < 8; ++j) v[j] = y[j] * fsigmoid(v[j]);
                    } else if (MODE == 5) {
                        float b[8]; unpack8(ax[m][bj], b);
#pragma unroll
                        for (int j = 0; j < 8; ++j) v[j] *= b[j];
                    } else if (MODE == 6) {
#pragma unroll
                        for (int j = 0; j < 8; ++j) v[j] *= 0.0625f;
                    }
                    *(u32x4*)dst = pack8(v);
                }
                if (MODE == 7) {
                    st1 += shx(st1, fr + 16 * fq, 16); st1 += shx(st1, fr + 16 * fq, 32); st2 += shx(st2, fr + 16 * fq, 16); st2 += shx(st2, fr + 16 * fq, 32);
                    if (fq == 0) ((f32x2*)aux)[row * 16 + (colbase >> 8) * 4 + wc] = (f32x2){st1, st2};
                }
                if (MODE != 4 && MODE != 5) asm volatile("" ::: "memory");
            }
            asm volatile("" ::: "memory");
        }
    }
};

__device__ __forceinline__ void gemm_phase(LAS unsigned char* lds, const Sched& S, const Epi& E, const int tid) {
    const int wid = __builtin_amdgcn_readfirstlane(tid >> 6), lane = tid & 63, wr = wid >> 2, wc = wid & 3, fr = lane & 15, fq = lane >> 4;
    const unsigned ldsw = (unsigned)wid * 1024u;
    const int aoff = lds_byte(wr * 64 + fr, fq * 8), boff = lds_byte(wc * 32 + fr, fq * 8);
#define PG8_SA(b, h) (((b) * 2 + (h)) * HTB)
#define PG8_SB(b, h) ((4 + (b) * 2 + (h)) * HTB)
#define PG8_STAGE(bufoff, gbase, v0, v1) do { \
        __builtin_amdgcn_global_load_lds((const unsigned*)((const char*)(gbase) + (v0)), (LAS unsigned*)(lds + (bufoff) + ldsw), 16, 0, 0); \
        __builtin_amdgcn_global_load_lds((const unsigned*)((const char*)(gbase) + (v1)), (LAS unsigned*)(lds + (bufoff) + ldsw + 8192), 16, 0, 0); } while (0)
#define PG8_LDA(dst, b, h) do { _Pragma("unroll") for (int m = 0; m < 4; ++m) _Pragma("unroll") for (int k = 0; k < 2; ++k) dst[m][k] = *(const LAS bf16x8*)(lds + PG8_SA(b, h) + aoff + m * 2048 + k * 1024); } while (0)
#define PG8_LDB(dst, b, h) do { _Pragma("unroll") for (int n = 0; n < 2; ++n) _Pragma("unroll") for (int k = 0; k < 2; ++k) dst[n][k] = *(const LAS bf16x8*)(lds + PG8_SB(b, h) + boff + n * 2048 + k * 1024); } while (0)
#define PG8_MMA(ai, bj, At, Bt) do { __builtin_amdgcn_s_setprio(1); _Pragma("unroll") for (int m = 0; m < 4; ++m) _Pragma("unroll") for (int n = 0; n < 2; ++n) _Pragma("unroll") for (int k = 0; k < 2; ++k) \
        acc[ai][bj][m][n] = __builtin_amdgcn_mfma_f32_16x16x32_bf16(Bt[n][k], At[m][k], acc[ai][bj][m][n], 0, 0, 0); __builtin_amdgcn_s_setprio(0); } while (0)
#define PG8_WAIT_V(n) asm volatile("s_waitcnt vmcnt(" #n ")" ::: "memory")
#define PG8_WAIT_L(n) asm volatile("s_waitcnt lgkmcnt(" #n ")" ::: "memory")
#define PG8_BAR __builtin_amdgcn_s_barrier()
#define PG8_SCHED __builtin_amdgcn_sched_barrier(0)
    Unit cur, nxt; int ui = 0;
    if (!S.next(0, cur)) return;
    nxt = cur;
    f32x4 acc[2][2][4][2];
#pragma unroll
    for (int a = 0; a < 2; ++a)
#pragma unroll
        for (int b = 0; b < 2; ++b)
#pragma unroll
            for (int m = 0; m < 4; ++m)
#pragma unroll
                for (int n = 0; n < 2; ++n) acc[a][b][m][n] = (f32x4){0.f, 0.f, 0.f, 0.f};
    bf16x8 At[4][2], B0[2][2], B1[2][2];
    const Drv dc = derive(cur, tid);
    const char* cA = cur.A; const char* cB = cur.B;
    PG8_STAGE(PG8_SB(0, 0), cB, dc.vB0, dc.vB1); PG8_STAGE(PG8_SB(0, 1), cB + dc.hB, dc.vB0, dc.vB1); PG8_STAGE(PG8_SA(0, 0), cA, dc.vA0, dc.vA1); PG8_STAGE(PG8_SA(0, 1), cA + dc.hA, dc.vA0, dc.vA1);
    if (wr == 1) PG8_BAR;
    PG8_WAIT_V(2); PG8_BAR;
    PG8_STAGE(PG8_SB(1, 0), cB + 128, dc.vB0, dc.vB1); PG8_STAGE(PG8_SA(1, 0), cA + dc.kA, dc.vA0, dc.vA1); PG8_STAGE(PG8_SB(1, 1), cB + dc.hB + 128, dc.vB0, dc.vB1);
    PG8_WAIT_V(6); PG8_BAR;
    for (;;) {
        const bool has_next = S.next(ui + 1, nxt);
        const char* nA = cA; const char* nB = cB;
        if (has_next) { nA = nxt.A; nB = nxt.B; }
        const int nt = cur.nt;
        for (int t = 0; t < nt; t += 2) {
            const bool last = (t == nt - 2);
            if (cur.kind == K_BR && t == 16) E.mid(acc, cur, wr, wc, fr, fq);
            const size_t aj = (cur.kind == K_BR) ? (size_t)(WS_SB - WS_SA) - 16 * 128 : 0;
            const char* a1 = cA + (size_t)(t + 1) * dc.kA + (t >= 16 ? aj : 0);
            const char* a2 = last ? nA : cA + (size_t)(t + 2) * dc.kA + (t >= 14 ? aj : 0); const char* b2 = last ? nB : cB + (size_t)(t + 2) * 128;
            const unsigned xA0 = dc.vA0, xA1 = dc.vA1, xB0 = dc.vB0, xB1 = dc.vB1, xk = dc.kA, xhA = dc.hA, xhB = dc.hB;
            const char* a3 = a2 + xk; const char* b3 = b2 + 128;
            PG8_LDB(B0, 0, 0); PG8_LDB(B1, 0, 1); PG8_SCHED; PG8_LDA(At, 0, 0); PG8_STAGE(PG8_SA(1, 1), a1 + dc.hA, dc.vA0, dc.vA1);
            PG8_WAIT_V(8); PG8_WAIT_L(0); PG8_BAR; PG8_MMA(0, 0, At, B0); PG8_MMA(0, 1, At, B1); PG8_BAR; PG8_SCHED;
            PG8_LDA(At, 0, 1); PG8_STAGE(PG8_SB(0, 0), b2, xB0, xB1); PG8_STAGE(PG8_SB(0, 1), b2 + xhB, xB0, xB1); PG8_STAGE(PG8_SA(0, 0), a2, xA0, xA1);
            PG8_WAIT_V(8); PG8_WAIT_L(0); PG8_BAR; PG8_MMA(1, 0, At, B0); PG8_MMA(1, 1, At, B1); PG8_BAR; PG8_SCHED;
            PG8_LDB(B0, 1, 0); PG8_LDB(B1, 1, 1); PG8_SCHED; PG8_LDA(At, 1, 0); PG8_STAGE(PG8_SA(0, 1), a2 + xhA, xA0, xA1);
            PG8_WAIT_V(8); PG8_WAIT_L(0); PG8_BAR; PG8_MMA(0, 0, At, B0); PG8_MMA(0, 1, At, B1); PG8_BAR; PG8_SCHED;
            PG8_LDA(At, 1, 1); PG8_STAGE(PG8_SB(1, 0), b3, xB0, xB1); PG8_STAGE(PG8_SB(1, 1), b3 + xhB, xB0, xB1); PG8_STAGE(PG8_SA(1, 0), a3, xA0, xA1);
            PG8_WAIT_V(8); PG8_WAIT_L(0); PG8_BAR; PG8_MMA(1, 0, At, B0); PG8_MMA(1, 1, At, B1); PG8_BAR; PG8_SCHED;
        }
        if (wr == 0) PG8_BAR;
        E(acc, cur, wr, wc, fr, fq);
        if (!has_next) break;
#pragma unroll
        for (int a = 0; a < 2; ++a)
#pragma unroll
            for (int b = 0; b < 2; ++b)
#pragma unroll
                for (int m = 0; m < 4; ++m)
#pragma unroll
                    for (int n = 0; n < 2; ++n) acc[a][b][m][n] = (f32x4){0.f, 0.f, 0.f, 0.f};
        cur = nxt; cA = nA; cB = nB; ++ui;
        if (wr == 1) PG8_BAR;
    }
    PG8_WAIT_V(0);
    PG8_BAR;
#undef PG8_SA
#undef PG8_SB
#undef PG8_STAGE
#undef PG8_LDA
#undef PG8_LDB
#undef PG8_MMA
#undef PG8_WAIT_V
#undef PG8_WAIT_L
#undef PG8_BAR
#undef PG8_SCHED
}
}

__device__ __forceinline__ void transpose_item(const float* W, int N, bf16_t* WT, int ldt, int col_off, int rmode, LAS float* scr, int item, int lane, const float* kscale = nullptr) {
    const int nblk = N / 32, kb = item / nblk, nb = item % nblk, k0 = 64 * kb, n0 = 32 * nb;
    f32x4 wv[8];
#pragma unroll
    for (int i = 0; i < 8; ++i) { wv[i] = *(const f32x4*)(W + (size_t)(k0 + 8 * i + (lane >> 3)) * N + n0 + 4 * (lane & 7)); if (kscale) wv[i] = wv[i] * kscale[k0 + 8 * i + (lane >> 3)]; }
#pragma unroll
    for (int i = 0; i < 8; ++i) { LAS float* d = scr + (8 * i + (lane >> 3)) * 33 + 4 * (lane & 7); d[0] = wv[i][0]; d[1] = wv[i][1]; d[2] = wv[i][2]; d[3] = wv[i][3]; }
    asm volatile("s_waitcnt lgkmcnt(0)" ::: "memory");
    int r0 = n0;
    if (rmode == 1) { const int isu = n0 >= FF, nn = isu ? n0 - FF : n0; r0 = 256 * (nn >> 7) + (nn & 127) + (isu ? 128 : 0); }
    if (rmode == 2 && n0 >= 2560) { const int nn = n0 - 2560, isb = nn >= 1024, c = nn & 1023; r0 = 2560 + 256 * (c >> 7) + (c & 127) + (isb ? 128 : 0); }
    const int c = lane & 7;
#pragma unroll
    for (int j = 0; j < 4; ++j) { const int n = (lane >> 3) + 8 * j; const LAS float* s = scr + (8 * c) * 33 + n;
        u32x4 o; o.x = cvt_pk_bf16(s[0 * 33], s[1 * 33]); o.y = cvt_pk_bf16(s[2 * 33], s[3 * 33]); o.z = cvt_pk_bf16(s[4 * 33], s[5 * 33]); o.w = cvt_pk_bf16(s[6 * 33], s[7 * 33]);
        *(u32x4*)(WT + (size_t)(r0 + n) * ldt + col_off + k0 + 8 * c) = o; }
    asm volatile("s_waitcnt lgkmcnt(0)" ::: "memory");
}
template <int R>
__device__ __forceinline__ void rms_rows_to_bf16(const float* x0, size_t xstride, const float* g, bf16_t* o0, size_t ostride, int lane) {
    f32x4 v[R][4]; float s[R];
#pragma unroll
    for (int r = 0; r < R; ++r)
#pragma unroll
        for (int j = 0; j < 2; ++j) { v[r][2 * j] = *(const f32x4*)(x0 + r * xstride + 512 * j + 8 * lane); v[r][2 * j + 1] = *(const f32x4*)(x0 + r * xstride + 512 * j + 8 * lane + 4); }
#pragma unroll
    for (int r = 0; r < R; ++r) { s[r] = 0.f;
#pragma unroll
        for (int j = 0; j < 4; ++j) s[r] += (v[r][j][0] * v[r][j][0] + v[r][j][1] * v[r][j][1]) + (v[r][j][2] * v[r][j][2] + v[r][j][3] * v[r][j][3]); }
#pragma unroll
    for (int o = 1; o < 64; o <<= 1)
#pragma unroll
        for (int r = 0; r < R; ++r) s[r] += shx(s[r], lane, o);
    f32x4 gg[4];
#pragma unroll
    for (int j = 0; j < 2; ++j) { gg[2 * j] = *(const f32x4*)(g + 512 * j + 8 * lane); gg[2 * j + 1] = *(const f32x4*)(g + 512 * j + 8 * lane + 4); }
#pragma unroll
    for (int r = 0; r < R; ++r) {
        const float rstd = 1.f / sqrtf(s[r] * (1.f / DM) + EPS);
#pragma unroll
        for (int j = 0; j < 2; ++j) {
            const f32x4 a = v[r][2 * j] * rstd * gg[2 * j], b = v[r][2 * j + 1] * rstd * gg[2 * j + 1];
            u32x4 w; w.x = cvt_pk_bf16(a[0], a[1]); w.y = cvt_pk_bf16(a[2], a[3]); w.z = cvt_pk_bf16(b[0], b[1]); w.w = cvt_pk_bf16(b[2], b[3]);
            *(u32x4*)(o0 + r * ostride + 512 * j + 8 * lane) = w;
        }
    }
}
template <bool XIN_BF, bool XOUT_BF>
__device__ __forceinline__ void rowpass(const bf16_t* m, const float* gpost, const void* xin_, void* xout_, const float* gpre, bf16_t* hout, float* rsout, int gw, int NGW, int lane, int row_end) {
    constexpr int R = 4;
    const float* xin = (const float*)xin_; const bf16_t* xinb = (const bf16_t*)xin_; float* xout = (float*)xout_; bf16_t* xoutb = (bf16_t*)xout_;
    for (int row0 = gw; row0 < row_end; row0 += R * NGW) {
        u32x4 mw[R][2]; f32x4 xv[R][4]; u32x4 xw[R][2];
#pragma unroll
        for (int r = 0; r < R; ++r) { const size_t ro = (size_t)(row0 + r * NGW) * DM;
#pragma unroll
            for (int j = 0; j < 2; ++j) { mw[r][j] = *(const u32x4*)(m + ro + 512 * j + 8 * lane);
                if (XIN_BF) xw[r][j] = *(const u32x4*)(xinb + ro + 512 * j + 8 * lane);
                else { xv[r][2 * j] = *(const f32x4*)(xin + ro + 512 * j + 8 * lane); xv[r][2 * j + 1] = *(const f32x4*)(xin + ro + 512 * j + 8 * lane + 4); } } }
        f32x4 gp[4];
#pragma unroll
        for (int j = 0; j < 2; ++j) { gp[2 * j] = *(const f32x4*)(gpost + 512 * j + 8 * lane); gp[2 * j + 1] = *(const f32x4*)(gpost + 512 * j + 8 * lane + 4); }
        float mv[R][2][8]; float ss[R];
#pragma unroll
        for (int r = 0; r < R; ++r) { ss[r] = 0.f;
#pragma unroll
            for (int j = 0; j < 2; ++j) { unpack8(mw[r][j], mv[r][j]);
#pragma unroll
                for (int i = 0; i < 8; ++i) ss[r] += mv[r][j][i] * mv[r][j][i]; } }
#pragma unroll
        for (int o = 1; o < 64; o <<= 1)
#pragma unroll
            for (int r = 0; r < R; ++r) ss[r] += shx(ss[r], lane, o);
        float x1[R][2][8]; float s2[R];
#pragma unroll
        for (int r = 0; r < R; ++r) {
            const size_t ro = (size_t)(row0 + r * NGW) * DM;
            const float rstd = 1.f / sqrtf(ss[r] * (1.f / DM) + EPS); s2[r] = 0.f;
#pragma unroll
            for (int j = 0; j < 2; ++j) {
                const int c = 512 * j + 8 * lane;
                float xi[8];
                if (XIN_BF) unpack8(xw[r][j], xi);
                else {
#pragma unroll
                    for (int i = 0; i < 4; ++i) { xi[i] = xv[r][2 * j][i]; xi[4 + i] = xv[r][2 * j + 1][i]; }
                }
#pragma unroll
                for (int i = 0; i < 4; ++i) { x1[r][j][i] = xi[i] + mv[r][j][i] * rstd * gp[2 * j][i]; x1[r][j][4 + i] = xi[4 + i] + mv[r][j][4 + i] * rstd * gp[2 * j + 1][i]; }
#pragma unroll
                for (int i = 0; i < 8; ++i) s2[r] += x1[r][j][i] * x1[r][j][i];
                if (XOUT_BF) *(u32x4*)(xoutb + ro + c) = pack8(x1[r][j]);
                else { *(f32x4*)(xout + ro + c) = (f32x4){x1[r][j][0], x1[r][j][1], x1[r][j][2], x1[r][j][3]}; *(f32x4*)(xout + ro + c + 4) = (f32x4){x1[r][j][4], x1[r][j][5], x1[r][j][6], x1[r][j][7]}; }
            }
        }
        if (hout || rsout) {
#pragma unroll
            for (int o = 1; o < 64; o <<= 1)
#pragma unroll
                for (int r = 0; r < R; ++r) s2[r] += shx(s2[r], lane, o);
        }
        if (rsout) {
#pragma unroll
            for (int r = 0; r < R; ++r) if (lane == 0) rsout[row0 + r * NGW] = 1.f / sqrtf(s2[r] * (1.f / DM) + EPS);
        }
        if (hout) {
#pragma unroll
            for (int j = 0; j < 2; ++j) { gp[2 * j] = *(const f32x4*)(gpre + 512 * j + 8 * lane); gp[2 * j + 1] = *(const f32x4*)(gpre + 512 * j + 8 * lane + 4); }
#pragma unroll
            for (int r = 0; r < R; ++r) {
                const size_t ro = (size_t)(row0 + r * NGW) * DM;
                const float r2 = 1.f / sqrtf(s2[r] * (1.f / DM) + EPS);
#pragma unroll
                for (int j = 0; j < 2; ++j) {
                    float h[8];
#pragma unroll
                    for (int i = 0; i < 4; ++i) { h[i] = x1[r][j][i] * r2 * gp[2 * j][i]; h[4 + i] = x1[r][j][4 + i] * r2 * gp[2 * j + 1][i]; }
                    *(u32x4*)(hout + ro + 512 * j + 8 * lane) = pack8(h);
                }
            }
        }
    }
}

__device__ __forceinline__ void s5_build(LAS unsigned char* lds, unsigned char* ws, const float* lam_re, const float* lam_im, const float* log_step, const float* b_re,
                                         const float* b_im, const float* c_re, const float* c_im, const float* dvec, int g, int tid) {
    LAS f32x2* AP = (LAS f32x2*)lds;
    LAS f32x2* BB = (LAS f32x2*)(lds + 33280);
    LAS f32x2* CC = (LAS f32x2*)(lds + 41472);
    LAS float* KT = (LAS float*)(lds + 49664);
    const float step = expf(log_step[g]);
    for (int i = tid; i < 64 * 65; i += 512) {
        const int p = i / 65, tau = i % 65;
        const float lr = lam_re[g * 64 + p], li = lam_im[g * 64 + p];
        const float mag = expf(lr * step * (float)tau);
        const double ang = (double)li * (double)step * (double)tau;
        const double kq = rint(ang * 0.15915494309189535);
        const float r = (float)(ang - kq * 6.283185307179586);
        AP[p * 65 + tau] = (f32x2){mag * cosf(r), mag * sinf(r)};
    }
    for (int i = tid; i < 64 * 16; i += 512) {
        const int p = i >> 4, h = i & 15;
        const float lr = lam_re[g * 64 + p], li = lam_im[g * 64 + p];
        const float x = lr * step, mag = expf(x), em1 = expm1f(x);
        const double ang = (double)li * (double)step; const double kq = rint(ang * 0.15915494309189535);
        const float r = (float)(ang - kq * 6.283185307179586);
        const float sh = sinf(0.5f * r), cm1 = -2.f * sh * sh, sn = sinf(r), cs = 1.f + cm1;
        const float nr = em1 * cs + cm1, ni = mag * sn;
        const float den = lr * lr + li * li;
        const float co_re = (nr * lr + ni * li) / den, co_im = (ni * lr - nr * li) / den;
        const float br = b_re[(g * 64 + p) * 16 + h], bi = b_im[(g * 64 + p) * 16 + h];
        BB[p * 16 + h] = (f32x2){co_re * br - co_im * bi, co_re * bi + co_im * br};
        const int hh = i >> 6, pp = i & 63;
        CC[hh * 64 + pp] = (f32x2){c_re[(g * 16 + hh) * 64 + pp], c_im[(g * 16 + hh) * 64 + pp]};
    }
    __syncthreads();
    for (int it = 0; it < 2; ++it) {
        const int tau = tid & 63, hp = (tid >> 6) + 8 * it;
        float a[16];
#pragma unroll
        for (int h = 0; h < 16; ++h) a[h] = 0.f;
        for (int p = 0; p < 64; ++p) {
            const f32x2 c = CC[hp * 64 + p], ap = AP[p * 65 + tau];
            const float xr = c.x * ap.x - c.y * ap.y, xi = c.x * ap.y + c.y * ap.x;
#pragma unroll
            for (int h = 0; h < 16; ++h) { const f32x2 b = BB[p * 16 + h]; a[h] += xr * b.x - xi * b.y; }
        }
        if (tau == 0) {
#pragma unroll
            for (int h = 0; h < 16; ++h) if (h == hp) a[h] += dvec[g * 16 + hp];
        }
#pragma unroll
        for (int h = 0; h < 16; ++h) KT[tau * KTS + hp * 16 + h] = a[h];
    }
    __syncthreads();
    { const LAS f32x4* src = (const LAS f32x4*)lds; f32x4* dst = (f32x4*)(ws + WS_S5T + (size_t)g * S5T_BYTES);
      for (int i = tid; i < S5T_BYTES / 16; i += 512) dst[i] = src[i]; }
    if (tid < 64) ((f32x2*)(ws + WS_A64))[g * 64 + tid] = AP[tid * 65 + 64];
    __syncthreads();
}
__device__ __forceinline__ void s5_expand(LAS unsigned char* lds, unsigned char* ws, int g, int part, int tid) {
    LAS f32x2* AP = (LAS f32x2*)lds; LAS f32x2* BB = (LAS f32x2*)(lds + 33280); LAS f32x2* CC = (LAS f32x2*)(lds + 41472); LAS float* KT = (LAS float*)(lds + 49664);
    { const f32x4* src = (const f32x4*)(ws + WS_S5T + (size_t)g * S5T_BYTES); LAS f32x4* dst = (LAS f32x4*)lds;
      for (int i = tid; i < S5T_BYTES / 16; i += 512) dst[i] = src[i]; }
    __syncthreads();
    bf16_t* BT2 = (bf16_t*)(ws + WS_BT2) + (size_t)g * 1024 * 1152;
    for (int i = tid; i < 128 * 144; i += 512) {
        const int rl = i / 144, cc = i % 144, t = 8 * part + (rl >> 4), hp = rl & 15;
        float v[8];
        if (cc >= 16) {
            const int s = (cc - 16) >> 1, h0 = (cc & 1) * 8;
            if (s >= 16 * ((t >> 4) + 1)) continue;
            if (s <= t) {
#pragma unroll
                for (int j = 0; j < 8; ++j) v[j] = KT[(t - s) * KTS + hp * 16 + h0 + j];
            } else {
#pragma unroll
                for (int j = 0; j < 8; ++j) v[j] = 0.f;
            }
        } else {
            const int p0 = cc * 4;
#pragma unroll
            for (int j = 0; j < 4; ++j) { const f32x2 c = CC[hp * 64 + p0 + j], ap = AP[(p0 + j) * 65 + t + 1];
                v[2 * j] = c.x * ap.x - c.y * ap.y; v[2 * j + 1] = -(c.x * ap.y + c.y * ap.x); }
        }
        *(u32x4*)(BT2 + (size_t)(t * 16 + hp) * 1152 + cc * 8) = pack8(v);
    }
    bf16_t* BT1 = (bf16_t*)(ws + WS_BT1) + (size_t)g * 128 * 1152;
    for (int i = tid; i < 16 * 128; i += 512) {
        const int rl = i >> 7, cc = i & 127, p = 8 * part + (rl >> 1), ri = rl & 1, s = cc >> 1, h0 = (cc & 1) * 8;
        const f32x2 ap = AP[p * 65 + 63 - s];
        float v[8];
#pragma unroll
        for (int j = 0; j < 8; ++j) { const f32x2 b = BB[p * 16 + h0 + j]; v[j] = ri ? (ap.x * b.y + ap.y * b.x) : (ap.x * b.x - ap.y * b.y); }
        *(u32x4*)(BT1 + (size_t)(2 * p + ri) * 1152 + cc * 8) = pack8(v);
    }
    __syncthreads();
}

__device__ __forceinline__ void spatial_phase(LAS unsigned char* lds, unsigned char* ws, const float* ln_g, const float* ln_b, const float* b_s, int vcu, int G, const int tid) {
    __syncthreads();
    const int wid = __builtin_amdgcn_readfirstlane(tid >> 6), lane = tid & 63, fr = lane & 15, fq = lane >> 4;
    LAS f32x2* ST = (LAS f32x2*)lds;
    LAS bf16_t* VT = (LAS bf16_t*)(lds + 1024);
    LAS float* LG = (LAS float*)(lds + 36864);
    LAS float* LB = (LAS float*)(lds + 40960);
    const bf16_t* U = (const bf16_t*)(ws + WS_U); const bf16_t* V = (const bf16_t*)(ws + WS_V); bf16_t* YC = (bf16_t*)(ws + WS_SA);
    const bf16_t* WSP = (const bf16_t*)(ws + WS_WSP);
    for (int i = tid; i < 1024; i += 512) { LG[i] = ln_g[i]; LB[i] = ln_b[i]; }
    const int kmax = (16 * wid + 15) >> 5, t = 16 * wid + fr;
    for (int unit = vcu; unit < M_TOK / 128; unit += G) {
        const size_t r0 = (size_t)unit * 128;
        u32x4 vreg[4];
#pragma unroll
        for (int it = 0; it < 4; ++it) { const int idx = wid * 4 + it, s = (idx & 1) * 64 + lane, c0 = (idx >> 1) * 8; vreg[it] = *(const u32x4*)(V + (r0 + s) * DM + c0); }
        {
            const f32x4* pv = (const f32x4*)((const float*)(ws + WS_VST) + ((r0 + 16 * wid + (lane >> 2)) * 16 + 4 * (lane & 3)) * 2);
            const f32x4 p0 = pv[0], p1 = pv[1];
            float s1 = (p0[0] + p0[2]) + (p1[0] + p1[2]), s2 = (p0[1] + p0[3]) + (p1[1] + p1[3]);
            s1 += shx(s1, lane, 1); s1 += shx(s1, lane, 2); s2 += shx(s2, lane, 1); s2 += shx(s2, lane, 2);
            const float mean = s1 * (1.f / DM), var = fmaxf(s2 * (1.f / DM) - mean * mean, 0.f);
            if ((lane & 3) == 0) ST[16 * wid + (lane >> 2)] = (f32x2){mean, 1.f / sqrtf(var + EPS)};
        }
        __syncthreads();
        for (int g = 0; g < 8; ++g) {
#pragma unroll
            for (int it = 0; it < 4; ++it) {
                const int idx = wid * 4 + it, s = (idx & 1) * 64 + lane, c0 = (idx >> 1) * 8;
                float v[8]; unpack8(vreg[it], v);
                const f32x2 st = ST[s];
                const f32x4 g0 = *(const LAS f32x4*)(LG + g * 128 + c0), g1 = *(const LAS f32x4*)(LG + g * 128 + c0 + 4), e0 = *(const LAS f32x4*)(LB + g * 128 + c0), e1 = *(const LAS f32x4*)(LB + g * 128 + c0 + 4);
#pragma unroll
                for (int i = 0; i < 8; ++i) {
                    const int c = c0 + i, rho = (c & ~31) + 16 * ((c >> 2) & 1) + 4 * ((c & 31) >> 3) + (c & 3);
                    const float gm = i < 4 ? g0[i] : g1[i - 4], be = i < 4 ? e0[i] : e1[i - 4];
                    const float val = (v[i] - st.x) * st.y * gm + be;
                    VT[rho * 136 + s] = (bf16_t)(cvt_pk_bf16(val, 0.f) & 0xffffu);
                }
            }
            bf16x8 wf[4];
#pragma unroll
            for (int kk = 0; kk < 4; ++kk) if (kk <= kmax) wf[kk] = *(const bf16x8*)(WSP + ((size_t)(g * 128 + t)) * 128 + 32 * kk + 8 * fq);
            const float bias = b_s[g * 128 + t];
            u32x4 ureg[4];
#pragma unroll
            for (int b = 0; b < 4; ++b) ureg[b] = *(const u32x4*)(U + (r0 + t) * DM + g * 128 + b * 32 + 8 * fq);
            if (g < 7) {
#pragma unroll
                for (int it = 0; it < 4; ++it) { const int idx = wid * 4 + it, s = (idx & 1) * 64 + lane, c0 = (idx >> 1) * 8; vreg[it] = *(const u32x4*)(V + (r0 + s) * DM + (g + 1) * 128 + c0); }
            }
            __syncthreads();
            f32x4 acc[4][2];
#pragma unroll
            for (int b = 0; b < 4; ++b) { acc[b][0] = (f32x4){0.f, 0.f, 0.f, 0.f}; acc[b][1] = (f32x4){0.f, 0.f, 0.f, 0.f}; }
#pragma unroll
            for (int kk = 0; kk < 4; ++kk) if (kk <= kmax) {
#pragma unroll
                for (int b = 0; b < 4; ++b)
#pragma unroll
                    for (int n = 0; n < 2; ++n) {
                        const bf16x8 vf = *(const LAS bf16x8*)(VT + (b * 32 + 16 * n + fr) * 136 + 32 * kk + 8 * fq);
                        acc[b][n] = __builtin_amdgcn_mfma_f32_16x16x32_bf16(vf, wf[kk], acc[b][n], 0, 0, 0);
                    }
            }
#pragma unroll
            for (int b = 0; b < 4; ++b) {
                float u8[8]; unpack8(ureg[b], u8);
                float o[8];
#pragma unroll
                for (int j = 0; j < 4; ++j) { o[j] = (acc[b][0][j] + bias) * u8[j]; o[4 + j] = (acc[b][1][j] + bias) * u8[4 + j]; }
                *(u32x4*)(YC + (r0 + t) * DM + g * 128 + b * 32 + 8 * fq) = pack8(o);
            }
            __syncthreads();
        }
    }
}


#define XB_TMO      128
#define XB_XCNT(j)  (256  + 64 * (j))
#define XB_XSUB(j)  (1280 + 64 * (j))
#define XB_XGEN(j)  (2304 + 64 * (j))
#define XB_TOP      3328
#define XB_TOPGEN   3392
#define XB_SPIN_CAP (1u << 20)
__device__ __forceinline__ unsigned xb_ld(unsigned* p)              { return __hip_atomic_load(p, __ATOMIC_RELAXED, __HIP_MEMORY_SCOPE_AGENT); }
__device__ __forceinline__ unsigned xb_add(unsigned* p, unsigned v) { return __hip_atomic_fetch_add(p, v, __ATOMIC_RELAXED, __HIP_MEMORY_SCOPE_AGENT); }
__device__ __forceinline__ unsigned xb_xcc_id() { return (unsigned)__builtin_amdgcn_s_getreg((3 << 11) | 20) & 0xFu; }
#define XB_SPIN(cond, bar) do { unsigned _sp = 0; while (cond) { __builtin_amdgcn_s_sleep(1); \
    if ((++_sp & 255u) == 0u) { if (xb_ld(&(bar)[XB_TMO])) break; if (_sp > XB_SPIN_CAP) { atomicAdd(&(bar)[XB_TMO], 1u); break; } } } } while (0)
struct XcdBarrier { unsigned* bar; unsigned x; volatile LAS unsigned* st; };
__device__ __forceinline__ void xcd_barrier_post(unsigned* bar, int tid) { if (tid == 0) (void)xb_add(&bar[XB_XCNT(xb_xcc_id())], 1u); }
__device__ __forceinline__ void xcd_barrier_complete(unsigned* bar, unsigned x, unsigned& nloc, unsigned& nx) {
    const unsigned G = gridDim.x * gridDim.y * gridDim.z;
    unsigned sum, cnt, mine, sp = 0u;
    for (;;) {
        sum = 0u; cnt = 0u; mine = 0u;
#pragma unroll
        for (unsigned j = 0; j < 16; ++j) { const unsigned c = xb_ld(&bar[XB_XCNT(j)]); sum += c; cnt += (c > 0u) ? 1u : 0u; mine = (j == x) ? c : mine; }
        if (sum == G) break;
        __builtin_amdgcn_s_sleep(1);
        if ((++sp & 255u) == 0u) { if (xb_ld(&bar[XB_TMO])) break; if (sp > XB_SPIN_CAP) { atomicAdd(&bar[XB_TMO], 1u); break; } }
    }
    nloc = mine > 0u ? mine : 1u; nx = cnt > 0u ? cnt : 1u;
}
__device__ __forceinline__ void xcd_barrier(const XcdBarrier& b, int tid) {
    asm volatile("s_waitcnt vmcnt(0)" ::: "memory");
    __syncthreads();
    if (tid == 0) {
        unsigned* bar = b.bar;
        __builtin_amdgcn_s_waitcnt(0);
        unsigned nloc = b.st[0], nx = b.st[1];
        if (nloc == 0u) { xcd_barrier_complete(bar, b.x, nloc, nx); b.st[0] = nloc; b.st[1] = nx; }
        const unsigned old = xb_add(&bar[XB_XSUB(b.x)], 1u);
        const unsigned gen = old / nloc;
        if (old + 1u == (gen + 1u) * nloc) {
            __builtin_amdgcn_fence(__ATOMIC_RELEASE, "agent");
            asm volatile("s_waitcnt vmcnt(0)" ::: "memory");
            const unsigned og = xb_add(&bar[XB_TOP], 1u);
            const unsigned tg = og / nx;
            if (og + 1u == (tg + 1u) * nx) xb_add(&bar[XB_TOPGEN], 1u);
            else XB_SPIN(xb_ld(&bar[XB_TOPGEN]) == tg, bar);
            __builtin_amdgcn_fence(__ATOMIC_ACQUIRE, "agent");
            xb_add(&bar[XB_XGEN(b.x)], 1u);
            asm volatile("s_waitcnt vmcnt(0)" ::: "memory");
        } else {
            XB_SPIN(xb_ld(&bar[XB_XGEN(b.x)]) == gen, bar);
            __builtin_amdgcn_fence(__ATOMIC_ACQUIRE, "agent");
            asm volatile("s_waitcnt vmcnt(0)" ::: "memory");
        }
    }
    __syncthreads();
}

struct Args { const float* in[31]; float* out; unsigned char* ws; int ph_lo, ph_hi; };

__global__ void __launch_bounds__(512, 2) mk_fwd(Args args) {
    extern __shared__ __attribute__((aligned(16))) unsigned char lds_raw[];
    LAS unsigned char* lds = (LAS unsigned char*)lds_raw;
    const int G = gridDim.x, bx = blockIdx.x;
    const int vcu = (G % 8 == 0) ? (bx % 8) * (G / 8) + bx / 8 : bx;
    volatile LAS unsigned* xst = (volatile LAS unsigned*)(lds + LDS_XS + 8192);
    const bool multi = args.ph_hi - args.ph_lo > 1;
    if (multi) { if (threadIdx.x < 2) xst[threadIdx.x] = 0u; __syncthreads(); xcd_barrier_post((unsigned*)args.ws, (int)threadIdx.x); }

    for (int pi = args.ph_lo; pi < args.ph_hi; ++pi) {
        const int ph = pi;
        if (ph == 11 || ph == 12) continue;
        int tid = threadIdx.x; asm volatile("" : "+v"(tid));
        size_t wz = 0; asm volatile("" : "+s"(wz)); unsigned char* ws = args.ws + wz;
        const __attribute__((address_space(4))) char* kp = (const __attribute__((address_space(4))) char*)__builtin_amdgcn_kernarg_segment_ptr() + wz;
#define IN(i) ((const float*)(*(const __attribute__((address_space(1))) float* const __attribute__((address_space(4)))*)(kp + 8 * (i))))
        const int lane = tid & 63, wave = __builtin_amdgcn_readfirstlane(tid >> 6);
        const int gw = vcu * 8 + wave, NGW = G * 8;
        const bool panel_mode = false && (G == M_TOK / 256); const int panel = vcu;
        pg8::Epi E; E.ws = ws; E.lds = lds;
        bool is_gemm = false;
        if (ph == 0) {
            const bool split = (G % 32 == 0) && (G >= 128);
            const int nc = split ? (G / 32) * 12 : G, nm = split ? G - nc : G;
            const int ci = split ? (vcu % 32) * (G / 32) + (vcu / 32) : vcu, mi = split ? (vcu / 32) * 20 + (vcu % 32) - 12 : vcu;
            const bool do_c = !split || (vcu % 32) < 12, do_m = !split || (vcu % 32) >= 12;
            const int gwc = ci * 8 + wave, NGWC = nc * 8, gwm = mi * 8 + wave, NGWM = nm * 8;
            if (do_c) {
            for (int g = ci; g < 32; g += nc) s5_build(lds, ws, IN(8), IN(9), IN(10), IN(11), IN(12), IN(13), IN(14), IN(15), g, tid);
            LAS float* scr = (LAS float*)(lds + wave * 16384);
            constexpr int I_IN = 16 * (NIN / 32), I_BG = 16 * 32, I_BS = 8 * 32, I_MX = 16 * 32, I_GL = 8 * 16, I_Q = 16 * 32, I_KV = 16 * 64, I_O = 16 * 32, I_GU = 16 * (2 * FF / 32), I_DN = (FF / 64) * 32;
            constexpr int NIT = I_IN + I_BG + I_BS + I_MX + I_GL + I_KV + I_O + I_GU + I_DN;
            for (int it = gwc; it < NIT; it += NGWC) {
                int r = it;
                if (r < I_IN) { transpose_item(IN(3), NIN, (bf16_t*)(ws + WS_WIN), 1024, 0, 2, scr, r, lane); continue; } r -= I_IN;
                if (r < I_BG) { transpose_item(IN(17), 1024, (bf16_t*)(ws + WS_WBR), 1536, 0, 0, scr, r, lane); continue; } r -= I_BG;
                if (r < I_BS) { transpose_item(IN(18), 1024, (bf16_t*)(ws + WS_WBR), 1536, 1024, 0, scr, r, lane); continue; } r -= I_BS;
                if (r < I_MX) { transpose_item(IN(19), 1024, (bf16_t*)(ws + WS_WMIX), 1024, 0, 0, scr, r, lane); continue; } r -= I_MX;
                if (r < I_GL) { transpose_item(IN(16), 512, (bf16_t*)(ws + WS_WGLU), 512, 0, 0, scr, r, lane); continue; } r -= I_GL;
                if (r < I_KV) { transpose_item(IN(24), 2048, (bf16_t*)(ws + WS_WKV), 1152, 0, 0, scr, r, lane); continue; } r -= I_KV;
                if (r < I_O) { transpose_item(IN(25), 1024, (bf16_t*)(ws + WS_WO), 1024, 0, 0, scr, r, lane); continue; } r -= I_O;
                if (r < I_GU) { transpose_item(IN(28), 2 * FF, (bf16_t*)(ws + WS_WGU), 1024, 0, 1, scr, r, lane, IN(27)); continue; } r -= I_GU;
                transpose_item(IN(29), 1024, (bf16_t*)(ws + WS_WDN), FF, 0, 0, scr, r, lane);
            }
            {
                const float* w = IN(23); const float* gq = IN(21); bf16_t* o = (bf16_t*)(ws + WS_WQ);
                for (int i = ci * 512 + tid; i < 1024 * 1024 / 8; i += nc * 512) {
                    const int e = i * 8; const float gsc = gq[e >> 10];
                    const f32x4 a = *(const f32x4*)(w + e) * gsc, b = *(const f32x4*)(w + e + 4) * gsc;
                    float v[8] = {a[0], a[1], a[2], a[3], b[0], b[1], b[2], b[3]};
                    *(u32x4*)(o + e) = pack8(v);
                }
            }
            {
                const float* w = IN(6); bf16_t* o = (bf16_t*)(ws + WS_WSP);
                for (int i = ci * 512 + tid; i < 8 * 128 * 128 / 8; i += nc * 512) {
                    const int e = i * 8, s0 = e & 127, t = (e >> 7) & 127;
                    const f32x4 a = *(const f32x4*)(w + e), b = *(const f32x4*)(w + e + 4);
                    float v[8] = {a[0], a[1], a[2], a[3], b[0], b[1], b[2], b[3]};
#pragma unroll
                    for (int j = 0; j < 8; ++j) if (s0 + j > t) v[j] = 0.f;
                    *(u32x4*)(o + e) = pack8(v);
                }
            }
            }
            if (do_m) {
                int m = gwm;
                for (; m + 3 * NGWM < M_TOK; m += 4 * NGWM) rms_rows_to_bf16<4>(IN(0) + (size_t)m * DM, (size_t)NGWM * DM, IN(2), (bf16_t*)(ws + WS_SA) + (size_t)m * DM, (size_t)NGWM * DM, lane);
                for (; m < M_TOK; m += NGWM) rms_rows_to_bf16<1>(IN(0) + (size_t)m * DM, 0, IN(2), (bf16_t*)(ws + WS_SA) + (size_t)m * DM, 0, lane);
                for (m = gwm; m < NMEM; m += NGWM) rms_rows_to_bf16<1>(IN(1) + (size_t)m * DM, 0, IN(22), (bf16_t*)(ws + WS_MEMN) + (size_t)m * 1152, 0, lane);
            }
        } else if (ph == 1 || ph == 2) { is_gemm = true;
        } else if (ph == 3) { is_gemm = true;
        } else if (ph == 4 || ph == 5 || ph == 6 || ph == 7) { is_gemm = true;
        } else if (ph == 8) {
            if (panel_mode) rowpass<false, true>((const bf16_t*)(ws + WS_SA), IN(20), IN(0), ws + WS_X1B, nullptr, nullptr, (float*)(ws + WS_RS1), panel * 256 + wave, 8, lane, panel * 256 + 256);
            else rowpass<false, true>((const bf16_t*)(ws + WS_SA), IN(20), IN(0), ws + WS_X1B, nullptr, nullptr, (float*)(ws + WS_RS1), gw, NGW, lane, M_TOK);
        } else if (ph == 9 || ph == 10) { is_gemm = true;
        } else if (ph == 13) {
            if (panel_mode) rowpass<true, true>((const bf16_t*)(ws + WS_SD), IN(26), ws + WS_X1B, ws + WS_X2B, nullptr, nullptr, (float*)(ws + WS_RS2), panel * 256 + wave, 8, lane, panel * 256 + 256);
            else rowpass<true, true>((const bf16_t*)(ws + WS_SD), IN(26), ws + WS_X1B, ws + WS_X2B, nullptr, nullptr, (float*)(ws + WS_RS2), gw, NGW, lane, M_TOK);
        } else if (ph == 14 || ph == 15) { is_gemm = true;
        } else if (ph == 16) {
            if (panel_mode) rowpass<true, false>((const bf16_t*)(ws + WS_SC), IN(30), ws + WS_X2B, args.out, nullptr, nullptr, nullptr, panel * 256 + wave, 8, lane, panel * 256 + 256);
            else rowpass<true, false>((const bf16_t*)(ws + WS_SC), IN(30), ws + WS_X2B, args.out, nullptr, nullptr, nullptr, gw, NGW, lane, M_TOK);
        }
        if (is_gemm) {
            pg8::Sched S; S.ws = ws; S.ph = ph; S.G = G; S.c = bx; S.panel = (panel_mode && ph >= 6 && !FFN_GRID(ph)) ? panel : -1;
            const bool scan_wg = (ph == 3) && (G > 128) && (vcu < 64);
            if (ph == 3 && G > 128) { S.G = G - 64; S.c = vcu - 64; }
            S.n0 = pg8::phase_units(ph, 0); S.n1 = (ph == 2 || ph == 3) ? pg8::phase_units(ph, 1) : 0; S.total = S.n0 + S.n1;
            if (S.panel >= 0) S.total = (ph == 14) ? 2 * FF / 256 : 4;
            if (ph == 1) { for (int u = vcu; u < 256; u += G) s5_expand(lds, ws, u >> 3, u & 7, tid); }
            const bool sp_first = (ph == 2) && ((vcu >> 0) & 1);
            if (sp_first) spatial_phase(lds, ws, IN(4), IN(5), IN(7), vcu, G, tid);
            if (!scan_wg) pg8::gemm_phase(lds, S, E, tid);
            if (ph == 2 && !sp_first) spatial_phase(lds, ws, IN(4), IN(5), IN(7), vcu, G, tid);
            if (ph == 3) {
            const int gt = vcu * 512 + tid;
                if (gt < 16 * 32 * 64) {
                    const int p = gt & 63, g = (gt >> 6) & 31, b = gt >> 11;
                    const f32x2 a = ((const f32x2*)(ws + WS_A64))[g * 64 + p];
                    const float* Eb = (const float*)(ws + WS_EBUF); bf16_t* UC = (bf16_t*)(ws + WS_UC);
                    float cr = 0.f, ci = 0.f;
    #pragma unroll 8
                    for (int k = 0; k < 64; ++k) {
                        const size_t row = (size_t)g * 1024 + b * 64 + k;
                        const f32x2 e = *(const f32x2*)(Eb + row * 128 + 2 * p);
                        *(unsigned*)(UC + row * 1152 + 2 * p) = cvt_pk_bf16(cr, ci);
                        const float nr = a.x * cr - a.y * ci + e.x, ni = a.x * ci + a.y * cr + e.y; cr = nr; ci = ni;
                    }
                }

            }
        }
        if (pi + 1 < args.ph_hi) {
            if (panel_mode && ph >= 6 && ph != 16 && !FFN_GRID(ph) && !FFN_GRID(ph + 1)) {
                asm volatile("s_waitcnt vmcnt(0) lgkmcnt(0)" ::: "memory");
                __syncthreads();
                __builtin_amdgcn_fence(__ATOMIC_ACQUIRE, "agent");
                asm volatile("s_waitcnt vmcnt(0)" ::: "memory");
                __syncthreads();
            } else if (args.ph_hi > 4096) cg::this_grid().sync();
            else { XcdBarrier xb; xb.bar = (unsigned*)ws; xb.x = xb_xcc_id(); xb.st = xst; xcd_barrier(xb, tid); }
        }
    }
}

extern "C" void kernel_launch(void* const* d_in, const int* in_sizes, int n_in, void* d_out, int out_size, void* d_ws, size_t ws_size, hipStream_t stream) {
    static int grid = 0;
    if (grid == 0) {
        if (n_in != 31 || in_sizes[0] != M_TOK * DM || out_size != M_TOK * DM || ws_size < WS_END) { fprintf(stderr, "kernel_launch: unexpected problem (n_in %d, ws %zu)\n", n_in, ws_size); grid = -1; return; }
        int dev = 0, cus = 0, per_cu = 0;
        hipGetDevice(&dev); hipDeviceGetAttribute(&cus, hipDeviceAttributeMultiprocessorCount, dev);
        hipFuncSetAttribute((const void*)mk_fwd, hipFuncAttributeMaxDynamicSharedMemorySize, LDS_BYTES);
        hipOccupancyMaxActiveBlocksPerMultiprocessor(&per_cu, (const void*)mk_fwd, 512, LDS_BYTES);
        if (per_cu < 1) { fprintf(stderr, "kernel_launch: occupancy query says %d blocks per CU\n", per_cu); per_cu = 1; }
        (void)hipGetLastError();
        grid = cus;
    }
    if (grid < 0) return;
    Args a{};
    for (int i = 0; i < 31; ++i) a.in[i] = (const float*)d_in[i];
    a.out = (float*)d_out; a.ws = (unsigned char*)d_ws;
#if MK_ONE_LAUNCH
    (void)hipMemsetAsync(d_ws, 0, 65536, stream);
    a.ph_lo = 0; a.ph_hi = NPHASE;
    void* kargs[] = {&a};
    hipError_t e = hipLaunchCooperativeKernel((const void*)mk_fwd, dim3(grid), dim3(512), kargs, LDS_BYTES, stream);
    if (e != hipSuccess) fprintf(stderr, "cooperative launch failed: %s (grid %d)\n", hipGetErrorString(e), grid);

#else
    for (int ph = 0; ph < NPHASE; ++ph) {
        a.ph_lo = ph; a.ph_hi = ph + 1;
        hipLaunchKernelGGL(mk_fwd, dim3(grid), dim3(512), LDS_BYTES, stream, a);
    }
#endif
}
```
